# Optimizing an MI355X kernel written in HIP

```python
import math
import jax, jax.numpy as jnp
from jax import lax
import numpy as np

D_MODEL = 2048
BATCH = 2
SEQ = 4096
DEPTH = 2

HEAD_DIM = 128
NORM_EPS = 1e-6
ROPE_THETA = 500000.0
ROPE_FRACTION = 4
Q_BLOCK = 128
A_HEADS = 6
A_QK = 64
A_V = 2 * A_QK
A_WIDTH = A_HEADS * A_V
B_HEADS = 5
B_WIDTH = B_HEADS * HEAD_DIM
MOBA_BLOCK = 256
MOBA_TOPK = 3
MOBA_Q_BLOCK = 64
C_HEADS = 5
C_WIDTH = C_HEADS * HEAD_DIM
N_BRANCH = 3
SPLIT_SIZES = (A_HEADS * 2 * A_QK, A_HEADS * 2 * A_QK, A_WIDTH,
               B_WIDTH, B_WIDTH, B_WIDTH,
               C_WIDTH, C_WIDTH, C_WIDTH, C_HEADS,
               N_BRANCH * D_MODEL)
IN_COLS = 3 * A_WIDTH + 3 * B_WIDTH + 3 * C_WIDTH + C_HEADS + N_BRANCH * D_MODEL
PEER_HEADS = 8
PEER_KEYS = 128
PEER_EXPERTS = PEER_KEYS * PEER_KEYS
PEER_QDIM = 256
PEER_TOPK = 16
PEER_TOKEN_BLOCK = 128

kernel_name = "hybrid_gated_diff_moba_fox_peer"


def rmsnorm(x, g):
    xf = x.astype(jnp.float32)
    y = xf * lax.rsqrt(jnp.mean(xf * xf, axis=-1, keepdims=True) + NORM_EPS)
    return y.astype(x.dtype) * g


def rope_partial(x, pos):
    dh = x.shape[-1]
    rd = dh // ROPE_FRACTION
    half = rd // 2
    inv = ROPE_THETA ** (-(jnp.arange(half, dtype=jnp.float32) * 2.0) / rd)
    ang = pos.astype(jnp.float32)[:, None] * inv[None, :]
    cos = jnp.cos(ang).astype(x.dtype)
    sin = jnp.sin(ang).astype(x.dtype)
    x1 = x[..., :half]
    x2 = x[..., half:rd]
    return jnp.concatenate([x1 * cos - x2 * sin, x2 * cos + x1 * sin, x[..., rd:]], axis=-1)


def _blocks_to_seq(o):
    nc, b, h, qb, d = o.shape
    return jnp.moveaxis(o, 0, 2).reshape(b, h, nc * qb, d)


def diff_attention(q, k, v, lam, out_g, lam_init):
    seq = q.shape[3]
    scale = A_QK ** -0.5
    kpos = jnp.arange(seq)

    def block(c):
        start = c * Q_BLOCK
        qc = lax.dynamic_slice_in_dim(q, start, Q_BLOCK, axis=3)
        logits = jnp.einsum('bhcqd,bhcsd->bhcqs', qc, k).astype(jnp.float32) * scale
        qpos = start + jnp.arange(Q_BLOCK)
        logits = jnp.where(kpos[None, :] <= qpos[:, None], logits, -jnp.inf)
        p = jax.nn.softmax(logits, axis=-1)
        w = p[:, :, 0] - lam * p[:, :, 1]
        return jnp.einsum('bhqs,bhsd->bhqd', w.astype(v.dtype), v)

    o = _blocks_to_seq(lax.map(block, jnp.arange(seq // Q_BLOCK)))
    return rmsnorm(o, out_g) * (1.0 - lam_init)


def moba_attention(q, k, v):
    bsz, nh, seq, dh = q.shape
    scale = dh ** -0.5
    pad = (-seq) % MOBA_BLOCK
    k_p = jnp.pad(k, ((0, 0), (0, 0), (0, pad), (0, 0)))
    v_p = jnp.pad(v, ((0, 0), (0, 0), (0, pad), (0, 0)))
    nb = (seq + pad) // MOBA_BLOCK
    k_blk = k_p.reshape(bsz, nh, nb, MOBA_BLOCK, dh)
    v_blk = v_p.reshape(bsz, nh, nb, MOBA_BLOCK, dh)
    k_mean = jnp.mean(k_blk.astype(jnp.float32), axis=3).astype(k.dtype)
    topk = min(MOBA_TOPK, nb)
    blocks = jnp.arange(nb)
    b_idx = jnp.arange(bsz)[:, None, None, None]
    h_idx = jnp.arange(nh)[None, :, None, None]

    def block(c):
        start = c * MOBA_Q_BLOCK
        own = start // MOBA_BLOCK
        qc = lax.dynamic_slice_in_dim(q, start, MOBA_Q_BLOCK, axis=2)
        qpos = start + jnp.arange(MOBA_Q_BLOCK)
        gate = jnp.einsum('bhqd,bhnd->bhqn', qc, k_mean).astype(jnp.float32)
        gate = jnp.where(blocks < own, gate, -jnp.inf)
        _, sel = lax.top_k(gate, topk)
        valid = sel < own
        k_sel = k_blk[b_idx, h_idx, sel]
        v_sel = v_blk[b_idx, h_idx, sel]
        l_sel = jnp.einsum('bhqd,bhqnsd->bhqns', qc, k_sel).astype(jnp.float32) * scale
        l_sel = jnp.where(valid[..., None], l_sel, -jnp.inf)
        l_sel = l_sel.reshape(bsz, nh, MOBA_Q_BLOCK, topk * MOBA_BLOCK)
        k_own = lax.dynamic_slice_in_dim(k_p, own * MOBA_BLOCK, MOBA_BLOCK, axis=2)
        v_own = lax.dynamic_slice_in_dim(v_p, own * MOBA_BLOCK, MOBA_BLOCK, axis=2)
        l_own = jnp.einsum('bhqd,bhsd->bhqs', qc, k_own).astype(jnp.float32) * scale
        opos = own * MOBA_BLOCK + jnp.arange(MOBA_BLOCK)
        l_own = jnp.where(opos[None, :] <= qpos[:, None], l_own, -jnp.inf)
        p = jax.nn.softmax(jnp.concatenate([l_sel, l_own], axis=-1), axis=-1).astype(v.dtype)
        p_sel = p[..., :topk * MOBA_BLOCK].reshape(bsz, nh, MOBA_Q_BLOCK, topk, MOBA_BLOCK)
        p_own = p[..., topk * MOBA_BLOCK:]
        return (jnp.einsum('bhqns,bhqnsd->bhqd', p_sel, v_sel)
                + jnp.einsum('bhqs,bhsd->bhqd', p_own, v_own))

    return _blocks_to_seq(lax.map(block, jnp.arange(seq // MOBA_Q_BLOCK)))


def forgetting_attention(q, k, v, log_f):
    seq = q.shape[2]
    scale = q.shape[-1] ** -0.5
    cum = jnp.cumsum(log_f, axis=-1)
    kpos = jnp.arange(seq)

    def block(c):
        start = c * Q_BLOCK
        qc = lax.dynamic_slice_in_dim(q, start, Q_BLOCK, axis=2)
        cq = lax.dynamic_slice_in_dim(cum, start, Q_BLOCK, axis=2)
        logits = jnp.einsum('bhqd,bhsd->bhqs', qc, k).astype(jnp.float32) * scale
        logits = logits + cq[..., :, None] - cum[..., None, :]
        qpos = start + jnp.arange(Q_BLOCK)
        logits = jnp.where(kpos[None, :] <= qpos[:, None], logits, -jnp.inf)
        p = jax.nn.softmax(logits, axis=-1).astype(v.dtype)
        return jnp.einsum('bhqs,bhsd->bhqd', p, v)

    return _blocks_to_seq(lax.map(block, jnp.arange(seq // Q_BLOCK)))


def hybrid_mixer(x, layer_idx, norm_g, w_in, b_gate, b_forget, a_q_norm, a_k_norm,
                 lam_q1, lam_k1, lam_q2, lam_k2, a_out_norm, b_q_norm, b_k_norm,
                 c_q_norm, c_k_norm, w_br_a, w_br_b, w_br_c, w_out):
    bsz, seq, _ = x.shape
    pos = jnp.arange(seq)
    h = rmsnorm(x, norm_g)
    proj = h @ w_in
    offs = np.cumsum(SPLIT_SIZES)[:-1].tolist()
    qa, ka, va, qb, kb, vb, qc, kc, vc, f_logit, g_logit = jnp.split(proj, offs, axis=-1)

    def to_heads(t, n):
        return t.reshape(bsz, seq, n, -1).transpose(0, 2, 1, 3)

    def from_heads(t):
        return t.transpose(0, 2, 1, 3).reshape(bsz, seq, -1)

    def split_a(t):
        return t.reshape(bsz, seq, A_HEADS, 2, A_QK).transpose(0, 2, 3, 1, 4)
    qa = rope_partial(rmsnorm(split_a(qa), a_q_norm), pos)
    ka = rope_partial(rmsnorm(split_a(ka), a_k_norm), pos)
    lam_init = 0.8 - 0.6 * math.exp(-0.3 * layer_idx)
    f32 = jnp.float32
    lam = (jnp.exp(jnp.sum(lam_q1.astype(f32) * lam_k1.astype(f32)))
           - jnp.exp(jnp.sum(lam_q2.astype(f32) * lam_k2.astype(f32))) + lam_init)
    ya = from_heads(diff_attention(qa, ka, to_heads(va, A_HEADS), lam, a_out_norm, lam_init))

    qb = rope_partial(rmsnorm(to_heads(qb, B_HEADS), b_q_norm), pos)
    kb = rope_partial(rmsnorm(to_heads(kb, B_HEADS), b_k_norm), pos)
    yb = from_heads(moba_attention(qb, kb, to_heads(vb, B_HEADS)))

    qc = rmsnorm(to_heads(qc, C_HEADS), c_q_norm)
    kc = rmsnorm(to_heads(kc, C_HEADS), c_k_norm)
    log_f = jax.nn.log_sigmoid((f_logit + b_forget).astype(f32)).transpose(0, 2, 1)
    yc = from_heads(forgetting_attention(qc, kc, to_heads(vc, C_HEADS), log_f))

    gates = jax.nn.sigmoid(g_logit.reshape(bsz, seq, N_BRANCH, D_MODEL) + b_gate)
    merged = (gates[:, :, 0] * (ya @ w_br_a)
              + gates[:, :, 1] * (yb @ w_br_b)
              + gates[:, :, 2] * (yc @ w_br_c))
    return merged @ w_out


def peer_ffn(h, w_q, sub_keys, u_tab, v_tab):
    bsz, seq, dm = h.shape
    tokens = bsz * seq
    hf = h.reshape(tokens, dm)
    q = (hf @ w_q).reshape(tokens, PEER_HEADS, 2, PEER_QDIM // 2)
    s = jnp.einsum('thpd,hpnd->thpn', q, sub_keys).astype(jnp.float32)
    sv, si = lax.top_k(s, PEER_TOPK)
    cand = sv[:, :, 0, :, None] + sv[:, :, 1, None, :]
    cand_idx = si[:, :, 0, :, None] * PEER_KEYS + si[:, :, 1, None, :]
    top_s, top_pos = lax.top_k(cand.reshape(tokens, PEER_HEADS, PEER_TOPK * PEER_TOPK), PEER_TOPK)
    expert = jnp.take_along_axis(cand_idx.reshape(tokens, PEER_HEADS, PEER_TOPK * PEER_TOPK),
                                 top_pos, axis=-1)
    gate = jax.nn.softmax(top_s, axis=-1).astype(h.dtype)
    nch = tokens // PEER_TOKEN_BLOCK

    def block(args):
        xb, eb, gb = args
        u = u_tab[eb]
        act = jax.nn.gelu(jnp.einsum('td,thkd->thk', xb, u), approximate=False)
        return jnp.einsum('thk,thkd->td', gb * act, v_tab[eb])

    y = lax.map(block, (hf.reshape(nch, PEER_TOKEN_BLOCK, dm),
                        expert.reshape(nch, PEER_TOKEN_BLOCK, PEER_HEADS, PEER_TOPK),
                        gate.reshape(nch, PEER_TOKEN_BLOCK, PEER_HEADS, PEER_TOPK)))
    return y.reshape(bsz, seq, dm)


def setup_inputs(seed: int = 0) -> dict:
    key = jax.random.key(seed)
    ks = jax.random.split(key, 25)
    f32 = jnp.float32
    L = DEPTH
    D = D_MODEL

    def nrm(k, shape, scale):
        return jax.random.normal(k, shape, f32) * scale

    def gain(k, shape):
        return 1.0 + 0.1 * jax.random.normal(k, shape, f32)

    return {
        "x": nrm(ks[0], (BATCH, SEQ, D), 1.0),
        "norm1_g": gain(ks[1], (L, D)),
        "w_in": nrm(ks[2], (L, D, IN_COLS), D ** -0.5),
        "b_gate": nrm(ks[3], (L, N_BRANCH, D), 0.1),
        "b_forget": nrm(ks[4], (L, C_HEADS), 0.1),
        "a_q_norm": gain(ks[5], (L, A_QK)),
        "a_k_norm": gain(ks[6], (L, A_QK)),
        "lambda_q1": nrm(ks[7], (L, A_QK), 0.1),
        "lambda_k1": nrm(ks[8], (L, A_QK), 0.1),
        "lambda_q2": nrm(ks[9], (L, A_QK), 0.1),
        "lambda_k2": nrm(ks[10], (L, A_QK), 0.1),
        "a_out_norm": gain(ks[11], (L, A_V)),
        "b_q_norm": gain(ks[12], (L, HEAD_DIM)),
        "b_k_norm": gain(ks[13], (L, HEAD_DIM)),
        "c_q_norm": gain(ks[14], (L, HEAD_DIM)),
        "c_k_norm": gain(ks[15], (L, HEAD_DIM)),
        "w_branch_a": nrm(ks[16], (L, A_WIDTH, D), A_WIDTH ** -0.5),
        "w_branch_b": nrm(ks[17], (L, B_WIDTH, D), B_WIDTH ** -0.5),
        "w_branch_c": nrm(ks[18], (L, C_WIDTH, D), C_WIDTH ** -0.5),
        "w_out": nrm(ks[19], (L, D, D), D ** -0.5),
        "norm2_g": gain(ks[20], (L, D)),
        "w_peer_q": nrm(ks[21], (L, D, PEER_HEADS * PEER_QDIM), D ** -0.5),
        "peer_sub_keys": nrm(ks[22], (L, PEER_HEADS, 2, PEER_KEYS, PEER_QDIM // 2), (PEER_QDIM // 2) ** -0.5),
        "peer_u": nrm(ks[23], (L, PEER_EXPERTS, D), D ** -0.5),
        "peer_v": nrm(ks[24], (L, PEER_EXPERTS, D), PEER_HEADS ** -0.5),
    }


def reference(x, norm1_g, w_in, b_gate, b_forget, a_q_norm, a_k_norm, lambda_q1, lambda_k1,
              lambda_q2, lambda_k2, a_out_norm, b_q_norm, b_k_norm, c_q_norm, c_k_norm,
              w_branch_a, w_branch_b, w_branch_c, w_out, norm2_g, w_peer_q, peer_sub_keys,
              peer_u, peer_v):
    for l in range(DEPTH):
        x = x + hybrid_mixer(x, l, norm1_g[l], w_in[l], b_gate[l], b_forget[l],
                             a_q_norm[l], a_k_norm[l], lambda_q1[l], lambda_k1[l],
                             lambda_q2[l], lambda_k2[l], a_out_norm[l], b_q_norm[l], b_k_norm[l],
                             c_q_norm[l], c_k_norm[l], w_branch_a[l], w_branch_b[l],
                             w_branch_c[l], w_out[l])
        x = x + peer_ffn(rmsnorm(x, norm2_g[l]), w_peer_q[l], peer_sub_keys[l],
                         peer_u[l], peer_v[l])
    return x
```

```cpp
#define XFMT 4
#define QF8_MASK 2
#include <hip/hip_runtime.h>
#include <hip/hip_cooperative_groups.h>
#include <cstdio>
#include <cstdint>
#include <cmath>
namespace cg = cooperative_groups;

#define LAS __attribute__((address_space(3)))
typedef unsigned short bf16_t;
typedef short bf16x8 __attribute__((ext_vector_type(8)));
typedef short s16x4 __attribute__((ext_vector_type(4)));
typedef float f32x2 __attribute__((ext_vector_type(2)));
typedef float f32x4 __attribute__((ext_vector_type(4)));
typedef float f32x16 __attribute__((ext_vector_type(16)));
typedef unsigned u32x2 __attribute__((ext_vector_type(2)));
typedef unsigned u32x4 __attribute__((ext_vector_type(4)));
typedef __bf16 bf16v2 __attribute__((ext_vector_type(2)));
typedef float f32x32 __attribute__((ext_vector_type(32)));
typedef unsigned u32x6 __attribute__((ext_vector_type(6)));
#ifndef XFMT
#define XFMT 6
#endif
constexpr int XROW = XFMT == 6 ? 1536 : 1024;
constexpr int XLB = XROW / 64;

constexpr int T_TOK = 8192, DM = 2048, SEQ = 4096, NBATCH = 2, DEPTH = 2, INCOLS = 12293;
constexpr int PQ = 6144;
constexpr float NORM_EPS = 1e-6f;
constexpr float LOG2E = 1.4426950408889634f;
#ifndef QF8_MASK
#define QF8_MASK 3
#endif
#define QF8_LAYER(l_) (((QF8_MASK) >> (l_)) & 1)
constexpr float X8_SCALE = 4.0f;
constexpr float M8_SCALE = 16.0f, WO8_SCALE = 128.0f;

constexpr size_t AL(size_t x) { return (x + 255) & ~(size_t)255; }
constexpr size_t WS_CTL = 0;
constexpr size_t WO_WIN_T = 0;
constexpr size_t WO_WBR_T = WO_WIN_T + AL((size_t)12288 * 2048 * 2);
constexpr size_t WO_WOUT_T = WO_WBR_T + AL((size_t)3 * 2048 * 768 * 2);
constexpr size_t WO_WQ_T = WO_WOUT_T + AL((size_t)2048 * 2048 * 2);
constexpr size_t WO_SK = WO_WQ_T + AL((size_t)2048 * 2048 * 2);
constexpr size_t WO_U = WO_SK + AL((size_t)8 * 2 * 128 * 128 * 2);
constexpr size_t WO_V = WO_U + AL((size_t)16384 * 2048);
constexpr size_t WO_WF = WO_V + AL((size_t)16384 * 2048);
constexpr size_t WO_USC = WO_WF + AL((size_t)8 * 2048 * 4);
constexpr size_t WO_VSC = WO_USC + AL((size_t)16384 * 4);
constexpr size_t WO_WIN8 = WO_VSC + AL((size_t)16384 * 4);
constexpr size_t WO_WSC = WO_WIN8 + AL((size_t)12288 * 2048);
constexpr size_t WL_SIZE = WO_WSC + AL((size_t)12288 * 4);
constexpr size_t WS_W0 = 65536;
constexpr size_t WS_XA = WS_W0 + DEPTH * WL_SIZE;
constexpr size_t WS_H8 = WS_XA;
constexpr size_t WS_XB = WS_XA + AL((size_t)T_TOK * DM * 4);
constexpr size_t WS_HG8 = WS_XB;
constexpr size_t WS_H = WS_XB + AL((size_t)T_TOK * DM * 4);
constexpr size_t WS_PROJ = WS_H + AL((size_t)T_TOK * DM * 2);
constexpr size_t WS_MERGED = WS_PROJ;
constexpr size_t WS_QP = WS_MERGED + AL((size_t)T_TOK * DM * 2);
constexpr size_t WS_HG = WS_QP + AL((size_t)T_TOK * DM * 2);
constexpr size_t WS_GATES = WS_PROJ + AL((size_t)T_TOK * PQ * 2);
constexpr size_t WS_LOGF = WS_GATES + AL((size_t)T_TOK * PQ * 2);
constexpr size_t WS_QA = WS_LOGF + AL((size_t)T_TOK * 8 * 4);
constexpr size_t WS_KA = WS_QA + AL((size_t)2 * 12 * 4096 * 128 * 2);
constexpr size_t WS_VA = WS_KA + AL((size_t)2 * 12 * 4096 * 128 * 2);
constexpr size_t WS_QB = WS_VA + AL((size_t)2 * 6 * 4096 * 128 * 2);
constexpr size_t SZ_H5 = AL((size_t)2 * 5 * 4096 * 128 * 2);
constexpr size_t WS_KB = WS_QB + SZ_H5;
constexpr size_t WS_VB = WS_KB + SZ_H5;
constexpr size_t WS_QC = WS_VB + SZ_H5;
constexpr size_t WS_KC = WS_QC + SZ_H5;
constexpr size_t WS_VC = WS_KC + SZ_H5;
constexpr size_t WS_CB = WS_VC + SZ_H5;
constexpr size_t WS_OA = WS_CB + AL((size_t)2 * 5 * 4096 * 4);
constexpr size_t WS_YCAT = WS_OA + AL((size_t)2 * T_TOK * 768 * 2);
constexpr size_t WS_PIDX = WS_YCAT + AL((size_t)T_TOK * DM * 2);
constexpr size_t WS_PGATE = WS_PIDX + AL((size_t)T_TOK * 128 * 4);
constexpr size_t WS_ROWSS = WS_PGATE + AL((size_t)T_TOK * 128 * 4);
constexpr size_t WS_KSUM = WS_ROWSS + AL((size_t)T_TOK * 8);
constexpr size_t WS_END = WS_KSUM + AL((size_t)10 * 16 * 128 * 4);
static_assert(3 * AL((size_t)T_TOK * DM * 2) <= AL((size_t)T_TOK * PQ * 2), "aliases fit in PROJ");

constexpr int LDS_BYTES = 159744 + 1024;

__device__ __forceinline__ int lane_id_() { return (int)__builtin_amdgcn_mbcnt_hi(~0u, __builtin_amdgcn_mbcnt_lo(~0u, 0u)); }
__device__ __forceinline__ int tid_of(int wid) { int t = wid * 64 + lane_id_(); asm volatile("" : "+v"(t)); return t; }
#define GAS __attribute__((address_space(1)))
template <class T> __device__ __forceinline__ T ldg(const void* p) { return *(const GAS T*)p; }
template <class T> __device__ __forceinline__ void stg(void* p, const T v) { *(GAS T*)p = v; }
template <class T> __device__ __forceinline__ T ldg_nt(const void* p) { return __builtin_nontemporal_load((const GAS T*)p); }
template <class T> __device__ __forceinline__ void stg_nt(void* p, const T v) { __builtin_nontemporal_store(v, (GAS T*)p); }
__device__ __forceinline__ u32x4 zero4() { unsigned z = 0u; asm volatile("" : "+v"(z)); return (u32x4){z, z, z, z}; }
__device__ __forceinline__ unsigned cvtpk(float lo, float hi) { unsigned r; asm volatile("v_cvt_pk_bf16_f32 %0, %1, %2" : "=v"(r) : "v"(lo), "v"(hi)); return r; }
__device__ __forceinline__ float bflo(unsigned u) { return __uint_as_float(u << 16); }
__device__ __forceinline__ float bfhi(unsigned u) { return __uint_as_float(u & 0xffff0000u); }
__device__ __forceinline__ bf16x8 pack8(f32x4 a, f32x4 b) {
    u32x4 w = {cvtpk(a[0], a[1]), cvtpk(a[2], a[3]), cvtpk(b[0], b[1]), cvtpk(b[2], b[3])};
    return *reinterpret_cast<bf16x8*>(&w);
}
template <int M> __device__ __forceinline__ float shx(float v) { static_assert(M >= 1 && M < 32, "xor mask"); return __int_as_float(__builtin_amdgcn_ds_swizzle(__float_as_int(v), (M << 10) | 0x1f)); }
__device__ __forceinline__ float shx32(float v, bool upper) { auto rr = __builtin_amdgcn_permlane32_swap(__float_as_uint(v), __float_as_uint(v), false, false); return __uint_as_float(upper ? rr[0] : rr[1]); }
__device__ __forceinline__ float sum32(float v) { auto rr = __builtin_amdgcn_permlane32_swap(__float_as_uint(v), __float_as_uint(v), false, false); return __uint_as_float(rr[0]) + __uint_as_float(rr[1]); }
__device__ __forceinline__ float wave_sum(float v) {
    v += shx<1>(v); v += shx<2>(v); v += shx<4>(v); v += shx<8>(v); v += shx<16>(v);
    return sum32(v);
}
__device__ __forceinline__ float sigmoidf_(float x) { return __builtin_amdgcn_rcpf(1.f + __expf(-x)); }
__device__ __forceinline__ float gelu_exact(float v) {
    const float av = fabsf(v), d = av * 0.2316418882f + 1.0f;
    const float t = __builtin_amdgcn_rcpf(d);
    float q = t * 0.5307027145f + (-0.7265760135f); q = q * t + 0.7107068705f; q = q * t + (-0.142248368f); q = q * t + 0.127414796f; q = q * t;
    const float e = __builtin_amdgcn_exp2f((v * v) * (-0.72134752044f));
    const float m = v * (q * e);
    return v < 0.f ? m : v - m;
}

__device__ __forceinline__ unsigned q8x4(float a, float b, float c, float d, float inv) {
    const unsigned ua = __float_as_uint(fmaf(a, inv, 12582912.0f)), ub = __float_as_uint(fmaf(b, inv, 12582912.0f)), uc = __float_as_uint(fmaf(c, inv, 12582912.0f)), ud = __float_as_uint(fmaf(d, inv, 12582912.0f));
    return __builtin_amdgcn_perm(ub, ua, 0x0c0c0400u) | __builtin_amdgcn_perm(ud, uc, 0x04000c0cu);
}
__device__ __forceinline__ float wave_max(float v) {
    v = fmaxf(v, shx<1>(v)); v = fmaxf(v, shx<2>(v)); v = fmaxf(v, shx<4>(v)); v = fmaxf(v, shx<8>(v)); v = fmaxf(v, shx<16>(v));
    auto rr = __builtin_amdgcn_permlane32_swap(__float_as_uint(v), __float_as_uint(v), false, false); return fmaxf(__uint_as_float(rr[0]), __uint_as_float(rr[1]));
}

namespace pg8 {
constexpr int BM = 256, BK = 64, HALF = 128, HTB = HALF * BK * 2, STAGE_BYTES = 8 * HTB, NXCD = 8, WGM = 8;
__device__ __forceinline__ int lds_byte(int r, int c) { const int st = (r >> 4) * 2 + (c >> 5), rr = r & 15, cc = c & 31, ob = rr * 64 + cc * 2; return st * 1024 + (ob ^ (((ob >> 9) & 1) << 5)); }
__device__ __forceinline__ void stage_rc(int b, int& R, int& C) { const int st = b / 1024, sb = b % 1024, swz = sb ^ (((sb >> 9) & 1) << 5); R = (st >> 1) * 16 + swz / 64; C = (st & 1) * 32 + (swz % 64) / 2; }
__device__ __forceinline__ int perm32(int rho) { const int n = rho >> 4, i = rho & 15; return 8 * (i >> 2) + 4 * n + (i & 3); }

typedef int i32x8 __attribute__((ext_vector_type(8)));
typedef int i32x4 __attribute__((ext_vector_type(4)));
typedef short s16x16 __attribute__((ext_vector_type(16)));
__device__ __forceinline__ i32x8 cat8(bf16x8 lo, bf16x8 hi) { return __builtin_bit_cast(i32x8, __builtin_shufflevector(lo, hi, 0, 1, 2, 3, 4, 5, 6, 7, 8, 9, 10, 11, 12, 13, 14, 15)); }
constexpr int F8SC = 0x7f7f7f7f;
struct Unit { const char* a; const char* b; int pm, pn, aux, nt = 0; };

template <class Epi> __device__ __forceinline__ auto epi_keep(const Epi& e, const Unit& u, int) -> decltype(e.keep(u)) { return e.keep(u); }
template <class Epi> __device__ __forceinline__ bool epi_keep(const Epi&, const Unit&, long) { return false; }
struct TileOrder {
    int nM, nN, nwg, G, c;
    __device__ void init(int M, int N, int G_, int c_) { nM = M / BM; nN = N / BM; nwg = nM * nN; G = G_; c = c_; }
    __device__ bool tile(int i, int& pm, int& pn) const {
        const long L = (long)i * G + c; if (L >= nwg) return false;
        int wgid = (int)L; { const int q = nwg / NXCD, r = nwg % NXCD, xcd = wgid % NXCD, off = wgid / NXCD; wgid = (xcd < r ? xcd * (q + 1) : r * (q + 1) + (xcd - r) * q) + off; }
        const int nig = WGM * nN, gid = wgid / nig, fm = gid * WGM, gsz = (nM - fm) < WGM ? (nM - fm) : WGM;
        pm = fm + ((wgid % nig) % gsz); pn = (wgid % nig) / gsz; return true;
    }
};

template <class Epi, class Sched, int MODE = 0>
__device__ __forceinline__ void gemm_phase(LAS unsigned char* lds, const int lda, const int ldb, const int K, const Sched& S, const Epi& E) {
    int tid = threadIdx.x; asm volatile("" : "+v"(tid));
    const int wid = __builtin_amdgcn_readfirstlane(tid >> 6), lane = tid & 63, wr = wid >> 2, wc = wid & 3, fr = lane & 15, fq = lane >> 4;
    constexpr bool F8 = MODE == 1;
    constexpr int EB = MODE ? 1 : 2;
    const int nt = K / (MODE ? 128 : BK);
    unsigned voffA[2], voffB[2];
#pragma unroll
    for (int i = 0; i < 2; ++i) { int R, C; stage_rc(tid * 16 + i * 8192, R, C); const int Rb = Epi::PERM ? ((R & ~31) + perm32(R & 31)) : R;
        voffA[i] = (unsigned)(R * lda * EB + C * 2); voffB[i] = (unsigned)(Rb * ldb * EB + C * 2); }
    const size_t kstep = (size_t)(BK * 2);
    const size_t hstepA = (size_t)HALF * lda * EB, hstepB = (size_t)HALF * ldb * EB;
    const unsigned ldsw = (unsigned)wid * 1024u;
    const int fcol = F8 ? ((fq >> 1) * 32 + (fq & 1) * 16) : fq * 8;
    constexpr int KOFF = F8 ? 16 : 1024;
    const int aoff = lds_byte(wr * 64 + fr, fcol), boff = lds_byte(wc * 32 + fr, fcol);
#define PG8_SA(b, h) (((b) * 2 + (h)) * HTB)
#define PG8_SB(b, h) ((4 + (b) * 2 + (h)) * HTB)
#define PG8_STAGE(bufoff, gbase, voff) do { _Pragma("unroll") for (int _i = 0; _i < 2; ++_i) \
        __builtin_amdgcn_global_load_lds((const unsigned*)((const char*)(gbase) + (voff)[_i]), (LAS unsigned*)(lds + (bufoff) + ldsw + _i * 8192), 16, 0, 0); } while (0)
#define PG8_LDA(dst, b, h) do { _Pragma("unroll") for (int m = 0; m < 4; ++m) _Pragma("unroll") for (int k = 0; k < 2; ++k) dst[m][k] = *(const LAS bf16x8*)(lds + PG8_SA(b, h) + aoff + m * 2048 + k * KOFF); } while (0)
#define PG8_LDB(dst, b, h) do { _Pragma("unroll") for (int n = 0; n < 2; ++n) _Pragma("unroll") for (int k = 0; k < 2; ++k) dst[n][k] = *(const LAS bf16x8*)(lds + PG8_SB(b, h) + boff + n * 2048 + k * KOFF); } while (0)
#define PG8_MMA(ai, bj, At, Bt) do { __builtin_amdgcn_s_setprio(1); _Pragma("unroll") for (int m = 0; m < 4; ++m) _Pragma("unroll") for (int n = 0; n < 2; ++n) { \
        if constexpr (F8) { const i32x8 b8_ = cat8(Bt[n][0], Bt[n][1]), a8_ = cat8(At[m][0], At[m][1]); \
            asm volatile("s_nop 1\n\tv_mfma_f32_16x16x128_f8f6f4 %0, %1, %2, %0" : "+v"(acc[ai][bj][m][n]) : "v"(b8_), "v"(a8_)); } \
        else if constexpr (MODE == 2) { _Pragma("unroll") for (int k = 0; k < 2; ++k) acc[ai][bj][m][n] = __builtin_bit_cast(f32x4, __builtin_amdgcn_mfma_i32_16x16x64_i8(__builtin_bit_cast(i32x4, Bt[n][k]), __builtin_bit_cast(i32x4, At[m][k]), __builtin_bit_cast(i32x4, acc[ai][bj][m][n]), 0, 0, 0)); } \
        else { _Pragma("unroll") for (int k = 0; k < 2; ++k) acc[ai][bj][m][n] = __builtin_amdgcn_mfma_f32_16x16x32_bf16(Bt[n][k], At[m][k], acc[ai][bj][m][n], 0, 0, 0); } } __builtin_amdgcn_s_setprio(0); } while (0)
#define PG8_WAIT_V(n) asm volatile("s_waitcnt vmcnt(" #n ")" ::: "memory")
#define PG8_WAIT_L(n) asm volatile("s_waitcnt lgkmcnt(" #n ")" ::: "memory")
#define PG8_BAR __builtin_amdgcn_s_barrier()
#define PG8_SCHED __builtin_amdgcn_sched_barrier(0)
    Unit cur, nxt; int ui = 0;
    if (!S.next(0, cur)) return;
    f32x4 acc[2][2][4][2];
#pragma unroll
    for (int a = 0; a < 2; ++a)
#pragma unroll
        for (int b = 0; b < 2; ++b)
#pragma unroll
            for (int m = 0; m < 4; ++m)
#pragma unroll
                for (int n = 0; n < 2; ++n) acc[a][b][m][n] = (f32x4){0.f, 0.f, 0.f, 0.f};
    bf16x8 At[4][2], B0[2][2], B1[2][2];
    const char* cA = cur.a; const char* cB = cur.b;
    PG8_STAGE(PG8_SB(0, 0), cB, voffB); PG8_STAGE(PG8_SA(0, 0), cA, voffA); PG8_STAGE(PG8_SB(0, 1), cB + hstepB, voffB); PG8_STAGE(PG8_SA(0, 1), cA + hstepA, voffA);
    if (wr == 1) PG8_BAR;
    PG8_WAIT_V(4); PG8_BAR;
    PG8_STAGE(PG8_SB(1, 0), cB + kstep, voffB); PG8_STAGE(PG8_SA(1, 0), cA + kstep, voffA); PG8_STAGE(PG8_SB(1, 1), cB + hstepB + kstep, voffB);
    PG8_WAIT_V(6); PG8_BAR;
    for (;;) {
        const bool has_next = S.next(ui + 1, nxt);
        const char* nA = has_next ? nxt.a : cA; const char* nB = has_next ? nxt.b : cB;
        const int ntu = cur.nt ? cur.nt : nt;
        for (int t = 0; t < ntu; t += 2) {
            const bool last = (t == ntu - 2);
            const char* a1 = cA + (size_t)(t + 1) * kstep;
            const char* a2 = last ? nA : cA + (size_t)(t + 2) * kstep; const char* b2 = last ? nB : cB + (size_t)(t + 2) * kstep;
            const char* a3 = a2 + kstep; const char* b3 = b2 + kstep;
            PG8_LDB(B0, 0, 0); PG8_SCHED; PG8_LDA(At, 0, 0); PG8_STAGE(PG8_SA(1, 1), a1 + hstepA, voffA);
            PG8_WAIT_L(8); PG8_BAR; PG8_WAIT_L(0); PG8_MMA(0, 0, At, B0); PG8_BAR; PG8_SCHED;
            PG8_LDB(B1, 0, 1); PG8_STAGE(PG8_SB(0, 0), b2, voffB);
            PG8_BAR; PG8_WAIT_L(0); PG8_MMA(0, 1, At, B1); PG8_BAR;
            PG8_LDA(At, 0, 1); PG8_STAGE(PG8_SA(0, 0), a2, voffA);
            PG8_BAR; PG8_WAIT_L(0); PG8_MMA(1, 0, At, B0); PG8_BAR; PG8_SCHED;
            PG8_STAGE(PG8_SB(0, 1), b2 + hstepB, voffB);
            PG8_WAIT_V(6); PG8_BAR; PG8_MMA(1, 1, At, B1); PG8_BAR;
            PG8_LDB(B0, 1, 0); PG8_SCHED; PG8_LDA(At, 1, 0); PG8_STAGE(PG8_SA(0, 1), a2 + hstepA, voffA);
            PG8_WAIT_L(8); PG8_BAR; PG8_WAIT_L(0); PG8_MMA(0, 0, At, B0); PG8_BAR; PG8_SCHED;
            PG8_LDB(B1, 1, 1); PG8_STAGE(PG8_SB(1, 0), b3, voffB);
            PG8_BAR; PG8_WAIT_L(0); PG8_MMA(0, 1, At, B1); PG8_BAR;
            PG8_LDA(At, 1, 1); PG8_STAGE(PG8_SA(1, 0), a3, voffA);
            PG8_BAR; PG8_WAIT_L(0); PG8_MMA(1, 0, At, B0); PG8_BAR; PG8_SCHED;
            PG8_STAGE(PG8_SB(1, 1), b3 + hstepB, voffB);
            PG8_WAIT_V(6); PG8_BAR; PG8_MMA(1, 1, At, B1); PG8_BAR;
        }
        if constexpr (F8) { asm volatile("s_nop 15\n\ts_nop 15" ::: "memory"); __builtin_amdgcn_sched_barrier(0); }
        E(acc, cur, wr, wc, fr, fq);
        if (!has_next) break;
        if (!epi_keep(E, cur, 0)) {
#pragma unroll
        for (int a = 0; a < 2; ++a)
#pragma unroll
            for (int b = 0; b < 2; ++b)
#pragma unroll
                for (int m = 0; m < 4; ++m)
#pragma unroll
                    for (int n = 0; n < 2; ++n) acc[a][b][m][n] = (f32x4){0.f, 0.f, 0.f, 0.f}; }
        cur = nxt; cA = nA; cB = nB; ++ui;
    }
    PG8_WAIT_V(0);
    if (wr == 0) PG8_BAR;
    PG8_BAR;
#undef PG8_SA
#undef PG8_SB
#undef PG8_STAGE
#undef PG8_LDA
#undef PG8_LDB
#undef PG8_MMA
#undef PG8_WAIT_V
#undef PG8_WAIT_L
#undef PG8_BAR
#undef PG8_SCHED
}
}

struct SchedPlain {
    pg8::TileOrder ord; const char* A; const char* Bt; size_t arow, brow;
    __device__ bool next(int i, pg8::Unit& u) const { int pm, pn; if (!ord.tile(i, pm, pn)) return false; u.pm = pm; u.pn = pn; u.aux = 0; u.a = A + (size_t)pm * arow; u.b = Bt + (size_t)pn * brow; return true; }
};
struct SchedMerge {
    pg8::TileOrder ord; const char* Y; const char* W;
    __device__ bool next(int i, pg8::Unit& u) const {
        const int r = i / 3, br = i - r * 3; int pm, pn; if (!ord.tile(r, pm, pn)) return false;
        u.pm = pm; u.pn = pn; u.aux = br; u.nt = br == 0 ? 12 : 10;
        const int acol = br == 0 ? 0 : (br == 1 ? 768 : 1408);
        u.a = Y + ((size_t)pm * 256 * 2048 + acol) * 2; u.b = W + ((size_t)br * 2048 * 768 + (size_t)pn * 256 * 768) * 2; return true;
    }
};

typedef int i32x4_ __attribute__((ext_vector_type(4)));
struct EpiProj {
    static constexpr bool PERM = true;
    bf16_t* proj; bf16_t* gates; const float* bgate; unsigned char* ws; const float* rstd1; const float* wsc;
    bool dry = false;
    __device__ __forceinline__ void operator()(const f32x4 (&acc)[2][2][4][2], const pg8::Unit& u, int wr, int wc, int fr, int fq) const {
        if (dry) return;
        const bool isg = u.pn >= 24;
        const int row0 = u.pm * 256 + wr * 64 + fr, col0 = (isg ? u.pn - 24 : u.pn) * 256 + wc * 32 + 8 * fq;
        bf16_t* base = isg ? gates : proj;
        f32x4 bv[2][2], cs[2][2];
#pragma unroll
        for (int bj = 0; bj < 2; ++bj)
#pragma unroll
            for (int n = 0; n < 2; ++n) { bv[bj][n] = isg ? ldg<f32x4>(bgate + col0 + bj * 128 + 4 * n) : (f32x4){0.f, 0.f, 0.f, 0.f}; cs[bj][n] = ldg<f32x4>(wsc + u.pn * 256 + wc * 32 + 8 * fq + bj * 128 + 4 * n); }
        bf16_t* vdst[2]; int vH[2]; bool isv[2];
#pragma unroll
        for (int bj = 0; bj < 2; ++bj) { const int un = 2 * u.pn + bj; isv[bj] = false; vdst[bj] = nullptr; vH[bj] = 1;
            if (!isg) {
                if (un >= 12 && un < 18) { isv[bj] = true; vH[bj] = 6; vdst[bj] = (bf16_t*)(ws + WS_VA) + (size_t)(un - 12) * 4096 * 128; }
                else if (un >= 28 && un < 33) { isv[bj] = true; vH[bj] = 5; vdst[bj] = (bf16_t*)(ws + WS_VB) + (size_t)(un - 28) * 4096 * 128; }
                else if (un >= 43) { isv[bj] = true; vH[bj] = 5; vdst[bj] = (bf16_t*)(ws + WS_VC) + (size_t)(un - 43) * 4096 * 128; } } }
        const int cin = wc * 32 + 8 * fq;
        float rs[8];
#pragma unroll
        for (int g = 0; g < 8; ++g) rs[g] = ldg<float>(rstd1 + (size_t)(row0 + (g >> 2) * 128 + (g & 3) * 16) * 8);
        if (isg) {
#pragma unroll
            for (int g = 0; g < 8; ++g) rs[g] *= -LOG2E;
#pragma unroll
            for (int bj = 0; bj < 2; ++bj)
#pragma unroll
                for (int n = 0; n < 2; ++n) bv[bj][n] = bv[bj][n] * -LOG2E; }
#pragma unroll
        for (int ai = 0; ai < 2; ++ai)
#pragma unroll
            for (int m = 0; m < 4; ++m) { const int r = row0 + ai * 128 + m * 16; bf16_t* rowp = base + (size_t)r * PQ + col0;
#pragma unroll
                for (int bj = 0; bj < 2; ++bj) {
                    const i32x4_ i0 = __builtin_bit_cast(i32x4_, acc[ai][bj][m][0]), i1 = __builtin_bit_cast(i32x4_, acc[ai][bj][m][1]);
                    f32x4 v0 = (f32x4){(float)i0[0], (float)i0[1], (float)i0[2], (float)i0[3]} * rs[ai * 4 + m] * cs[bj][0] + bv[bj][0], v1 = (f32x4){(float)i1[0], (float)i1[1], (float)i1[2], (float)i1[3]} * rs[ai * 4 + m] * cs[bj][1] + bv[bj][1];
                    if (isg) {
                        f32x4 e0, e1;
#pragma unroll
                        for (int j = 0; j < 4; ++j) { e0[j] = __builtin_amdgcn_exp2f(v0[j]); e1[j] = __builtin_amdgcn_exp2f(v1[j]); }
                        e0 = e0 + 1.0f; e1 = e1 + 1.0f;
#pragma unroll
                        for (int j = 0; j < 4; ++j) { v0[j] = __builtin_amdgcn_fmed3f(__builtin_amdgcn_rcpf(e0[j]), 1.f / 255.f, 1.0f); v1[j] = __builtin_amdgcn_fmed3f(__builtin_amdgcn_rcpf(e1[j]), 1.f / 255.f, 1.0f); } }
                    if (isg) stg<u32x2>((unsigned char*)gates + (size_t)(u.pm * 24 + (u.pn - 24)) * 65536 + (size_t)((((wr * 4 + wc) * 16 + ai * 8 + m * 2 + bj) * 64 + fq * 16 + fr) * 8),
                                        (u32x2){q8x4(v0[0], v0[1], v0[2], v0[3], 255.f), q8x4(v1[0], v1[1], v1[2], v1[3], 255.f)});
                    else if (isv[bj]) stg<bf16x8>(vdst[bj] + ((size_t)((r >> 12) * vH[bj]) * 4096 + (r & 4095)) * 128 + cin, pack8(v0, v1));
                    else stg<bf16x8>(rowp + bj * 128, pack8(v0, v1)); } }
    }
};
struct EpiBf16 {
    static constexpr bool PERM = true;
    bf16_t* O; int ldc;
    __device__ __forceinline__ void operator()(const f32x4 (&acc)[2][2][4][2], const pg8::Unit& u, int wr, int wc, int fr, int fq) const {
        const int row0 = u.pm * 256 + wr * 64 + fr, col0 = u.pn * 256 + wc * 32 + 8 * fq;
#pragma unroll
        for (int ai = 0; ai < 2; ++ai)
#pragma unroll
            for (int m = 0; m < 4; ++m) { bf16_t* rowp = O + (size_t)(row0 + ai * 128 + m * 16) * ldc + col0;
#pragma unroll
                for (int bj = 0; bj < 2; ++bj) stg<bf16x8>(rowp + bj * 128, pack8(acc[ai][bj][m][0], acc[ai][bj][m][1])); }
    }
};
struct EpiMerge {
    static constexpr bool PERM = true;
    bf16_t* merged; const bf16_t* gates;
    __device__ __forceinline__ bool keep(const pg8::Unit& u) const { return u.aux < 2; }
    __device__ __forceinline__ void operator()(f32x4 (&acc)[2][2][4][2], const pg8::Unit& u, int wr, int wc, int fr, int fq) const {
        const int br = u.aux, row0 = u.pm * 256 + wr * 64 + fr, col0 = u.pn * 256 + wc * 32 + 8 * fq;
        u32x2 gc[2], hc[2], gn[2], hn[2];
#define EM_LOAD(G, H, grp) do { const unsigned char* g_ = (const unsigned char*)gates + (size_t)(u.pm * 24 + br * 8 + u.pn) * 65536 + (size_t)((((wr * 4 + wc) * 16 + (grp) * 2) * 64 + fq * 16 + fr) * 8);     \
            G[0] = ldg_nt<u32x2>(g_); G[1] = ldg_nt<u32x2>(g_ + 512); \
            if (br < 2) { H[0] = ldg<u32x2>(g_ + (size_t)8 * 65536); H[1] = ldg<u32x2>(g_ + (size_t)8 * 65536 + 512); } } while (0)
        EM_LOAD(gc, hc, 0);
#pragma unroll
        for (int grp = 0; grp < 8; ++grp) { const int ai = grp >> 2, m = grp & 3; const size_t r = (size_t)(row0 + ai * 128 + m * 16);
            if (grp + 1 < 8) EM_LOAD(gn, hn, grp + 1);
#pragma unroll
            for (int bj = 0; bj < 2; ++bj) { const int c = col0 + bj * 128; const u32x2 g = gc[bj];
                float f[8];
#pragma unroll
                for (int q = 0; q < 8; ++q) f[q] = (float)((g[q >> 2] >> (8 * (q & 3))) & 0xffu);
                if (br < 2) { const u32x2 h = hc[bj];
#pragma unroll
                    for (int q = 0; q < 8; ++q) f[q] *= __builtin_amdgcn_rcpf((float)((h[q >> 2] >> (8 * (q & 3))) & 0xffu)); }
                else {
#pragma unroll
                    for (int q = 0; q < 8; ++q) f[q] *= 1.f / 255.f; }
                f32x4 v0 = acc[ai][bj][m][0], v1 = acc[ai][bj][m][1];
                v0[0] *= f[0]; v0[1] *= f[1]; v0[2] *= f[2]; v0[3] *= f[3]; v1[0] *= f[4]; v1[1] *= f[5]; v1[2] *= f[6]; v1[3] *= f[7];
                if (br < 2) { acc[ai][bj][m][0] = v0; acc[ai][bj][m][1] = v1; }
                else { int o0 = 0, o1 = 0;
                    o0 = __builtin_amdgcn_cvt_pk_fp8_f32(v0[0] * M8_SCALE, v0[1] * M8_SCALE, o0, false); o0 = __builtin_amdgcn_cvt_pk_fp8_f32(v0[2] * M8_SCALE, v0[3] * M8_SCALE, o0, true);
                    o1 = __builtin_amdgcn_cvt_pk_fp8_f32(v1[0] * M8_SCALE, v1[1] * M8_SCALE, o1, false); o1 = __builtin_amdgcn_cvt_pk_fp8_f32(v1[2] * M8_SCALE, v1[3] * M8_SCALE, o1, true);
                    stg<u32x2>((unsigned char*)merged + r * 2048 + c, (u32x2){(unsigned)o0, (unsigned)o1}); } }
            gc[0] = gn[0]; gc[1] = gn[1]; hc[0] = hn[0]; hc[1] = hn[1]; }
#undef EM_LOAD
    }
};
struct EpiRes {
    static constexpr bool PERM = false;
    float* out; const float* res;
    __device__ __forceinline__ void operator()(const f32x4 (&acc)[2][2][4][2], const pg8::Unit& u, int wr, int wc, int fr, int fq) const {
        const int row0 = u.pm * 256 + wr * 64 + fr, col0 = u.pn * 256 + wc * 32 + 4 * fq;
#pragma unroll
        for (int ai = 0; ai < 2; ++ai)
#pragma unroll
            for (int m = 0; m < 4; ++m) { const size_t off = (size_t)(row0 + ai * 128 + m * 16) * DM + col0;
#pragma unroll
                for (int bj = 0; bj < 2; ++bj)
#pragma unroll
                    for (int n = 0; n < 2; ++n) { const f32x4 rv = ldg<f32x4>(res + off + bj * 128 + n * 16); stg<f32x4>(out + off + bj * 128 + n * 16, rv + acc[ai][bj][m][n]); }
                asm volatile("" ::: "memory"); }
    }
};

struct EpiRes2 {
    static constexpr bool PERM = true;
    float* out; const float* res; bf16_t* hg; const float* g2; unsigned long long* rowss;
    __device__ __forceinline__ void operator()(const f32x4 (&acc)[2][2][4][2], const pg8::Unit& u, int wr, int wc, int fr, int fq) const {
        const int row0 = u.pm * 256 + wr * 64 + fr, col0 = u.pn * 256 + wc * 32 + 8 * fq;
        f32x4 gv[2][2];
#pragma unroll
        for (int bj = 0; bj < 2; ++bj)
#pragma unroll
            for (int n = 0; n < 2; ++n) gv[bj][n] = ldg<f32x4>(g2 + col0 + bj * 128 + 4 * n);
        f32x4 rc[4], rn[4];
#define ER_LOAD(R, grp) do { const size_t o_ = (size_t)(row0 + ((grp) >> 2) * 128 + ((grp) & 3) * 16) * DM + col0; \
            R[0] = ldg_nt<f32x4>(res + o_); R[1] = ldg_nt<f32x4>(res + o_ + 4); R[2] = ldg_nt<f32x4>(res + o_ + 128); R[3] = ldg_nt<f32x4>(res + o_ + 132); } while (0)
        ER_LOAD(rc, 0);
#pragma unroll
        for (int grp = 0; grp < 8; ++grp) { const int ai = grp >> 2, m = grp & 3; const int r = row0 + ai * 128 + m * 16; const size_t off = (size_t)r * DM + col0; float ss = 0.f;
            if (grp + 1 < 8) ER_LOAD(rn, grp + 1);
#pragma unroll
            for (int bj = 0; bj < 2; ++bj) {
                const f32x4 v0 = acc[ai][bj][m][0] + rc[2 * bj], v1 = acc[ai][bj][m][1] + rc[2 * bj + 1];
                stg<f32x4>(out + off + bj * 128, v0); stg<f32x4>(out + off + bj * 128 + 4, v1);
                ss += v0[0] * v0[0] + v0[1] * v0[1] + v0[2] * v0[2] + v0[3] * v0[3] + v1[0] * v1[0] + v1[1] * v1[1] + v1[2] * v1[2] + v1[3] * v1[3];
                stg<bf16x8>(hg + off + bj * 128, pack8(v0 * gv[bj][0], v1 * gv[bj][1])); }
            ss += shx<16>(ss); ss = sum32(ss);
            if (fq == 0) atomicAdd(rowss + r, (unsigned long long)(ss * 16777216.f + 0.5f));
#pragma unroll
            for (int q = 0; q < 4; ++q) rc[q] = rn[q]; }
#undef ER_LOAD
    }
};
__device__ __forceinline__ float rstd_of(const unsigned long long* rowss, int r) { const unsigned long long v = ldg<unsigned long long>(rowss + r); return rsqrtf((float)v * (1.f / 16777216.f) * (1.f / DM) + NORM_EPS); }
struct EpiBf16S {
    static constexpr bool PERM = true;
    bf16_t* O; int ldc; const unsigned long long* rowss; float oscale;
    __device__ __forceinline__ void operator()(const f32x4 (&acc)[2][2][4][2], const pg8::Unit& u, int wr, int wc, int fr, int fq) const {
        const int row0 = u.pm * 256 + wr * 64 + fr, col0 = u.pn * 256 + wc * 32 + 8 * fq;
        float rs[8];
#pragma unroll
        for (int grp = 0; grp < 8; ++grp) rs[grp] = rstd_of(rowss, row0 + (grp >> 2) * 128 + (grp & 3) * 16) * oscale;
        int fo = fq, ro = fr; asm volatile("" : "+v"(fo), "+v"(ro));
        const unsigned lb = (unsigned)((((2 * wc + (fo >> 1)) * 2 + (fo & 1)) * 32 + ro) * 8);
        bf16_t* tile = O + (size_t)(u.pm * 8 + u.pn) * 65536;
#pragma unroll
        for (int ai = 0; ai < 2; ++ai)
#pragma unroll
            for (int m = 0; m < 4; ++m) {
                const unsigned so = (unsigned)((4 * ai + 2 * wr + (m >> 1)) * 2 * 4096 + 16 * (m & 1) * 8);
#pragma unroll
                for (int bj = 0; bj < 2; ++bj) stg<bf16x8>(tile + so + bj * 4096 + lb, pack8(acc[ai][bj][m][0] * rs[ai * 4 + m], acc[ai][bj][m][1] * rs[ai * 4 + m])); }
    }
};

struct EpiRes3 {
    static constexpr bool PERM = true;
    bf16_t* out; const float* res; const bf16_t* res16; unsigned long long* rowss; unsigned char* out8;
    __device__ __forceinline__ void operator()(const f32x4 (&acc)[2][2][4][2], const pg8::Unit& u, int wr, int wc, int fr, int fq) const {
        const int row0 = u.pm * 256 + wr * 64 + fr, col0 = u.pn * 256 + wc * 32 + 8 * fq;
        f32x4 rc[4], rn[4];
#define ER_LOAD(R, grp) do { const size_t o_ = (size_t)(row0 + ((grp) >> 2) * 128 + ((grp) & 3) * 16) * DM + col0; \
            if (res16) { const u32x4 a_ = ldg_nt<u32x4>(res16 + o_), b_ = ldg_nt<u32x4>(res16 + o_ + 128); \
                R[0] = (f32x4){bflo(a_[0]), bfhi(a_[0]), bflo(a_[1]), bfhi(a_[1])}; R[1] = (f32x4){bflo(a_[2]), bfhi(a_[2]), bflo(a_[3]), bfhi(a_[3])}; \
                R[2] = (f32x4){bflo(b_[0]), bfhi(b_[0]), bflo(b_[1]), bfhi(b_[1])}; R[3] = (f32x4){bflo(b_[2]), bfhi(b_[2]), bflo(b_[3]), bfhi(b_[3])}; } \
            else { R[0] = ldg_nt<f32x4>(res + o_); R[1] = ldg_nt<f32x4>(res + o_ + 4); R[2] = ldg_nt<f32x4>(res + o_ + 128); R[3] = ldg_nt<f32x4>(res + o_ + 132); } } while (0)
        ER_LOAD(rc, 0);
#pragma unroll
        for (int grp = 0; grp < 8; ++grp) { const int ai = grp >> 2, m = grp & 3; const int r = row0 + ai * 128 + m * 16; const size_t off = (size_t)r * DM + col0; float ss = 0.f;
            if (grp + 1 < 8) ER_LOAD(rn, grp + 1);
#pragma unroll
            for (int bj = 0; bj < 2; ++bj) {
                const f32x4 v0 = acc[ai][bj][m][0] * (1.0f / (M8_SCALE * WO8_SCALE)) + rc[2 * bj], v1 = acc[ai][bj][m][1] * (1.0f / (M8_SCALE * WO8_SCALE)) + rc[2 * bj + 1];
                ss += v0[0] * v0[0] + v0[1] * v0[1] + v0[2] * v0[2] + v0[3] * v0[3] + v1[0] * v1[0] + v1[1] * v1[1] + v1[2] * v1[2] + v1[3] * v1[3];
                stg<bf16x8>(out + off + bj * 128, pack8(v0, v1));
                { int o0 = 0, o1 = 0;
                  o0 = __builtin_amdgcn_cvt_pk_fp8_f32(v0[0] * X8_SCALE, v0[1] * X8_SCALE, o0, false); o0 = __builtin_amdgcn_cvt_pk_fp8_f32(v0[2] * X8_SCALE, v0[3] * X8_SCALE, o0, true);
                  o1 = __builtin_amdgcn_cvt_pk_fp8_f32(v1[0] * X8_SCALE, v1[1] * X8_SCALE, o1, false); o1 = __builtin_amdgcn_cvt_pk_fp8_f32(v1[2] * X8_SCALE, v1[3] * X8_SCALE, o1, true);
                  stg<u32x2>(out8 + off + bj * 128, (u32x2){(unsigned)o0, (unsigned)o1}); } }
            ss += shx<16>(ss); ss = sum32(ss);
            if (fq == 0) atomicAdd(rowss + r, (unsigned long long)(ss * 16777216.f + 0.5f));
#pragma unroll
            for (int q = 0; q < 4; ++q) rc[q] = rn[q]; }
#undef ER_LOAD
    }
};

namespace att {
constexpr int D = 128, NW = 8, QBLK = 32, KVBLK = 64, QB = NW * QBLK;
constexpr int SHM_V = KVBLK * D * 2, SHM_K = KVBLK * D * 2;
constexpr int OFF_WS = 2 * SHM_V + 2 * SHM_K;
constexpr int OFF_BIAS = OFF_WS + NW * 64 * 4;
constexpr int OFF_KM = OFF_BIAS + 4096 * 4;
constexpr int OFF_MISC = OFF_KM + 32 * 128 * 2;
constexpr int OFF_Q = 94208;
constexpr float THR2 = 8.f * LOG2E;

#define KSWZ(row, colB) ((row) * 256 + ((colB) ^ (((row) & 7) << 4)))
#define SBAR() __builtin_amdgcn_sched_barrier(0)
__device__ __forceinline__ int v_st(int k, int c) { const int kk = (k & ~0xC) | ((k & 4) << 1) | ((k & 8) >> 1); return ((kk >> 3) * 4 + (c >> 5)) * 512 + ((kk & 7) * 32 + (c & 31)) * 2; }
__device__ __forceinline__ int v_rd_base(int lane) { return ((lane & 3) << 3) | (((lane >> 2) & 3) << 6) | (((lane >> 4) & 1) << 5) | (((lane >> 5) & 1) << 8); }
constexpr int v_rd_off(int d0, int ks, int half) { return d0 * 512 + ks * 4096 + half * 2048; }
__device__ __forceinline__ int crow(int r, int hi) { return (r & 3) + 8 * (r >> 2) + 4 * hi; }
__device__ __forceinline__ bf16x8 load8(const bf16_t* p) { return ldg<bf16x8>(p); }

__device__ __forceinline__ void mask_tile(f32x16& p0, f32x16& p1, int dq) {
    const float NEG = -__builtin_inff();
#pragma unroll
    for (int r = 0; r < 16; ++r) {
        const int c = (r & 3) + 8 * (r >> 2);
        if (dq - c < 0) p0[r] = NEG;
        if (dq - c - 32 < 0) p1[r] = NEG;
    }
}
__device__ __forceinline__ void kill_tile(f32x16& p0, f32x16& p1, bool dead) {
    const float NEG = -__builtin_inff();
#pragma unroll
    for (int r = 0; r < 16; ++r) { p0[r] = dead ? NEG : p0[r]; p1[r] = dead ? NEG : p1[r]; }
}
__device__ __forceinline__ void bias_tile(f32x16& p0, f32x16& p1, const float* bl, int hi) {
#pragma unroll
    for (int g = 0; g < 4; ++g) {
        const f32x4 b0 = *(const f32x4*)(bl + 8 * g + 4 * hi), b1 = *(const f32x4*)(bl + 32 + 8 * g + 4 * hi);
#pragma unroll
        for (int j = 0; j < 4; ++j) { p0[4 * g + j] += b0[j]; p1[4 * g + j] += b1[j]; }
        asm volatile("" ::: "memory");
    }
}
__device__ __forceinline__ void partialSM(f32x16& p0, f32x16& p1, float& m_reg, float& mn, float& alpha, bool dead) {
    float pmax = p0[0];
#pragma unroll
    for (int r = 1; r < 16; ++r) pmax = fmaxf(pmax, p0[r]);
#pragma unroll
    for (int r = 0; r < 16; ++r) pmax = fmaxf(pmax, p1[r]);
    { auto rr = __builtin_amdgcn_permlane32_swap(__float_as_uint(pmax), __float_as_uint(pmax), false, false);
      pmax = fmaxf(__uint_as_float(rr[0]), __uint_as_float(rr[1])); }
    pmax = dead ? -1e30f : pmax;
    if (__builtin_expect(__all((pmax - m_reg) <= THR2), 1)) { mn = m_reg; alpha = 1.f; }
    else { mn = fmaxf(m_reg, pmax); alpha = __builtin_amdgcn_exp2f(m_reg - mn); m_reg = mn; }
    const float mne = dead ? __builtin_inff() : mn;
#pragma unroll
    for (int r = 0; r < 16; ++r) p0[r] = p0[r] - mne;
#pragma unroll
    for (int r = 0; r < 16; ++r) p1[r] = p1[r] - mne;
#pragma unroll
    for (int r = 0; r < 16; ++r) p0[r] = __builtin_amdgcn_exp2f(p0[r]);
}
__device__ __forceinline__ void finishSM(f32x16& p0, f32x16& p1, float alpha, float& l_reg, bf16x8& pa0, bf16x8& pa1, bf16x8& pa2, bf16x8& pa3) {
#pragma unroll
    for (int r = 0; r < 16; ++r) p1[r] = __builtin_amdgcn_exp2f(p1[r]);
    float ps = 0;
#pragma unroll
    for (int r = 0; r < 16; ++r) ps += p0[r];
#pragma unroll
    for (int r = 0; r < 16; ++r) ps += p1[r];
    { auto rr = __builtin_amdgcn_permlane32_swap(__float_as_uint(ps), __float_as_uint(ps), false, false);
      ps = __uint_as_float(rr[0]) + __uint_as_float(rr[1]); }
    l_reg = l_reg * alpha + ps;
#define PK4(P, B_, OUT) do { unsigned a0 = cvtpk(P[B_+0], P[B_+1]), a1 = cvtpk(P[B_+2], P[B_+3]);                          \
        unsigned b0 = cvtpk(P[B_+4], P[B_+5]), b1 = cvtpk(P[B_+6], P[B_+7]);                                             \
        auto r0 = __builtin_amdgcn_permlane32_swap(a0, b0, false, false); auto r1 = __builtin_amdgcn_permlane32_swap(a1, b1, false, false); \
        u32x4 w = {r0[0], r1[0], r0[1], r1[1]}; OUT = *reinterpret_cast<bf16x8*>(&w); } while (0)
    PK4(p0, 0, pa0); PK4(p0, 8, pa1); PK4(p1, 0, pa2); PK4(p1, 8, pa3);
#undef PK4
}
template <int KB, int ND>
__device__ __forceinline__ void qkt_(f32x16& p0, f32x16& p1, const char* K_lds, int r32, int hi, const char* qr) {
    p0 = f32x16{}; p1 = f32x16{};
    const char* kb[4];
#pragma unroll
    for (int dd = 0; dd < 4; ++dd) kb[dd] = K_lds + KB * SHM_K + KSWZ(r32, (dd * 16 + hi * 8) * 2);
#pragma unroll
    for (int d0 = 0; d0 < ND; ++d0) { const char* a = kb[d0 & 3] + (d0 >> 2) * 128;
        bf16x8 b0 = *reinterpret_cast<const bf16x8*>(a);
        bf16x8 b1 = *reinterpret_cast<const bf16x8*>(a + 32 * 256);
        const bf16x8 q = *reinterpret_cast<const bf16x8*>(qr + d0 * 1024);
        p0 = __builtin_amdgcn_mfma_f32_32x32x16_bf16(b0, q, p0, 0, 0, 0);
        p1 = __builtin_amdgcn_mfma_f32_32x32x16_bf16(b1, q, p1, 0, 0, 0); }
}
template <int KB>
__device__ __forceinline__ void qkt(f32x16& p0, f32x16& p1, const char* K_lds, int r32, int hi, const char* qr, bool d64) {
    if (d64) qkt_<KB, 4>(p0, p1, K_lds, r32, hi, qr); else qkt_<KB, 8>(p0, p1, K_lds, r32, hi, qr);
}
template <int VB>
__device__ __forceinline__ void pv_tile(f32x16* o, int vb0, bf16x8 pa0, bf16x8 pa1, bf16x8 pa2, bf16x8 pa3) {
#define TRRD(dst, off) asm volatile("ds_read_b64_tr_b16 %0, %1 offset:%2" : "=&v"(dst) : "v"(vb0), "i"(off) : "memory")
#define PV_D0(d0) do { s16x4 l0, l1, l2, l3, h0, h1, h2, h3; constexpr int b_ = VB * SHM_V + v_rd_off(d0, 0, 0); \
        TRRD(l0, b_); TRRD(h0, b_ + 2048); TRRD(l1, b_ + 4096); TRRD(h1, b_ + 6144); TRRD(l2, b_ + 8192); TRRD(h2, b_ + 10240); TRRD(l3, b_ + 12288); TRRD(h3, b_ + 14336); \
        asm volatile("s_waitcnt lgkmcnt(0)" ::: "memory"); SBAR();   \
        o[d0] = __builtin_amdgcn_mfma_f32_32x32x16_bf16(pa0, (bf16x8){l0[0], l0[1], l0[2], l0[3], h0[0], h0[1], h0[2], h0[3]}, o[d0], 0, 0, 0);   \
        o[d0] = __builtin_amdgcn_mfma_f32_32x32x16_bf16(pa1, (bf16x8){l1[0], l1[1], l1[2], l1[3], h1[0], h1[1], h1[2], h1[3]}, o[d0], 0, 0, 0);   \
        o[d0] = __builtin_amdgcn_mfma_f32_32x32x16_bf16(pa2, (bf16x8){l2[0], l2[1], l2[2], l2[3], h2[0], h2[1], h2[2], h2[3]}, o[d0], 0, 0, 0);   \
        o[d0] = __builtin_amdgcn_mfma_f32_32x32x16_bf16(pa3, (bf16x8){l3[0], l3[1], l3[2], l3[3], h3[0], h3[1], h3[2], h3[3]}, o[d0], 0, 0, 0); } while (0)
    PV_D0(0); PV_D0(1); PV_D0(2); PV_D0(3);
#undef PV_D0
#undef TRRD
}

struct BlockRef { const bf16_t* Q; const bf16_t* K; const bf16_t* V; bf16_t* O; const float* cb; int P0, ldo, mode, jlo, kp; };
struct Seam { bf16x8 qr[8]; bf16x8 st_v0, st_v1, st_k0, st_k1; };

#define ROW(p, k0, rr) ((p) + (size_t)((k0) + (rr)) * D + sc)
#define VMW() asm volatile("s_waitcnt vmcnt(0)" ::: "memory")
#define VMWN(n) asm volatile("s_waitcnt vmcnt(%0)" :: "i"(n) : "memory")
#define SLOAD_H(Kp, Vp, k0, kp_) do { S.st_v0 = load8(ROW(Vp, k0, sr)); S.st_v1 = load8(ROW(Vp, k0, 32 + sr));              \
                         if (sc < (kp_)) { S.st_k0 = load8((Kp) + (size_t)((k0) + sr) * (kp_) + sc); S.st_k1 = load8((Kp) + (size_t)((k0) + 32 + sr) * (kp_) + sc); } } while (0)
#define SWRITE_HK(bf) do { *(bf16x8*)(K_lds + (bf) * SHM_K + kws) = S.st_k0; *(bf16x8*)(K_lds + (bf) * SHM_K + kws + 32 * 256) = S.st_k1; } while (0)
#define SWRITE_HV(bf) do { *(bf16x8*)(V_lds + (bf) * SHM_V + vst0) = S.st_v0; *(bf16x8*)(V_lds + (bf) * SHM_V + vst1) = S.st_v1; } while (0)
#define SWRITE_H(bf) do { SWRITE_HV(bf); SWRITE_HK(bf); } while (0)

__device__ __forceinline__ void attn_prime(const BlockRef& cur, char* lds, Seam& S) {
    int tid = threadIdx.x; asm volatile("" : "+v"(tid));
    const int wid = __builtin_amdgcn_readfirstlane(tid >> 6), lane = tid & 63, r32 = lane & 31, hi = lane >> 5;
    const int sr = tid >> 4, sc = (tid & 15) * 8, kws = KSWZ(sr, sc * 2); char* K_lds = lds + 2 * SHM_V;
#pragma unroll
    for (int d0 = 0; d0 < 8; ++d0) { S.qr[d0] = bf16x8{}; if (d0 * 16 < cur.kp) S.qr[d0] = load8(cur.Q + (size_t)(wid * QBLK + r32) * cur.kp + d0 * 16 + hi * 8); }
    S.st_k0 = bf16x8{}; S.st_k1 = bf16x8{};
    SLOAD_H(cur.K, cur.V, cur.jlo * KVBLK, cur.kp); VMW(); SWRITE_HK(0);
    __syncthreads();
}

__device__ __forceinline__ unsigned attn_item_setup(const BlockRef& cur, char* lds, const Seam& S) {
    int tid = threadIdx.x; asm volatile("" : "+v"(tid));
    const int lane = tid & 63, r32 = lane & 31, hi = lane >> 5;
    unsigned sel = 0u;
    if (cur.mode == 2) {
        float* bl = (float*)(lds + OFF_BIAS);
        const float cref = ldg<float>(cur.cb + cur.P0);
        for (int k = cur.jlo * KVBLK + tid; k < cur.P0 + QB; k += NW * 64) bl[k] = (cref - ldg<float>(cur.cb + k)) * LOG2E;
    } else if (cur.mode == 1) {
        const int own = cur.P0 >> 8;
        bf16_t* km = (bf16_t*)(lds + OFF_KM);
        { const int n = tid >> 4;
          u32x4 w = zero4();
          if (n < own) { typedef int i32x4s __attribute__((ext_vector_type(4))); const int* ks = (const int*)cur.cb + tid * 8; const i32x4s a = ldg<i32x4s>(ks), b = ldg<i32x4s>(ks + 4); const float sc = 1.f / (256.f * 262144.f);
              w = (u32x4){cvtpk((float)a[0] * sc, (float)a[1] * sc), cvtpk((float)a[2] * sc, (float)a[3] * sc), cvtpk((float)b[0] * sc, (float)b[1] * sc), cvtpk((float)b[2] * sc, (float)b[3] * sc)}; }
          *(u32x4*)(km + tid * 8) = w; }
        __syncthreads();
        f32x16 g = f32x16{};
#pragma unroll
        for (int d0 = 0; d0 < 8; ++d0) { const bf16x8 a = *(const bf16x8*)(km + r32 * 128 + d0 * 16 + hi * 8); g = __builtin_amdgcn_mfma_f32_32x32x16_bf16(a, S.qr[d0], g, 0, 0, 0); }
        float gv[16];
#pragma unroll
        for (int r = 0; r < 8; ++r) { const float mine = g[r], other = shx32(mine, hi != 0);
            const int nm = (r & 3) + 8 * (r >> 2);
            gv[nm] = hi ? other : mine; gv[nm + 4] = hi ? mine : other; }
#pragma unroll
        for (int pass = 0; pass < 3; ++pass) { float best = -__builtin_inff(); int bi = -1;
#pragma unroll
            for (int n = 0; n < 16; ++n) { const bool ok = (n < own) && !((sel >> n) & 1u) && (gv[n] > best); best = ok ? gv[n] : best; bi = ok ? n : bi; }
            if (bi >= 0) sel |= 1u << bi; }
    }
    __syncthreads();
    return sel;
}

template <class NextFn>
__device__ __forceinline__ void attn_block(const BlockRef& cur, const NextFn& next_ref, char* lds, Seam& S) {
    int tid = threadIdx.x; asm volatile("" : "+v"(tid));
    const int wid = __builtin_amdgcn_readfirstlane(tid >> 6), lane = tid & 63, r32 = lane & 31, hi = lane >> 5;
    const unsigned sel = attn_item_setup(cur, lds, S);
    const char* Q_lds = lds + OFF_Q + wid * 8192 + lane * 16;
#pragma unroll
    for (int d0 = 0; d0 < 8; ++d0) *(bf16x8*)(lds + OFF_Q + wid * 8192 + d0 * 1024 + lane * 16) = S.qr[d0];
    const int mode = cur.mode;
    const int jlo = cur.jlo, NT = cur.P0 / KVBLK + QB / KVBLK - jlo;
    const int qlo = cur.P0 + wid * QBLK, qm = qlo + r32 - 4 * hi;
    char* V_lds = lds; char* K_lds = lds + 2 * SHM_V;
    float* ws = (float*)(lds + OFF_WS) + wid * 64; float* li_l = ws, * al_l = ws + 32;
    const float* bias_l = (const float*)(lds + OFF_BIAS);
    float m_reg = -1e30f, l_reg = 0; f32x16 o[4] = {};
    const int sr = tid >> 4, sc = (tid & 15) * 8, vst0 = v_st(sr, sc), vst1 = vst0 + 8192  , kws = KSWZ(sr, sc * 2);
    const int vb0 = (int)(uintptr_t)V_lds + v_rd_base(lane);
    const bf16_t* Kh = cur.K; const bf16_t* Vh = cur.V;
#define RESC(a) do { if (__any((a) < 1.f)) { if (hi == 0) al_l[r32] = (a); asm volatile("s_waitcnt lgkmcnt(0)" ::: "memory");              \
                     for (int d_ = 0; d_ < 4; ++d_) for (int r = 0; r < 16; ++r) o[d_][r] *= al_l[crow(r, hi)]; } } while (0)
#define KBASE(t) ((jlo + (t)) * KVBLK)
#define MASKT(P0_, P1_, t) do { const int kb_ = KBASE(t);                                                          \
        if (mode == 2) bias_tile(P0_, P1_, bias_l + kb_, hi);                                                      \
        deadv = (mode == 1 && kb_ < cur.P0) ? !((sel >> (kb_ >> 8)) & 1u) : false;                                  \
        if (kb_ + KVBLK - 1 > qlo) mask_tile(P0_, P1_, qm - kb_); } while (0)
#define SEAM_K0() do { if (nxt.kp == 64) VMWN(4); else VMWN(8); SWRITE_HK(0); SBAR(); } while (0)
    f32x16 pA0, pA1, pB0, pB1; float mnA, mnB, alA, alB; bf16x8 pa0, pa1, pa2, pa3; bool deadv = false;
    SWRITE_HV(0); SBAR();
    const int kp = cur.kp; const bool d64 = kp == 64;
    if (NT > 1) { SLOAD_H(Kh, Vh, KBASE(1), kp); }
    SBAR(); qkt<0>(pA0, pA1, K_lds, r32, hi, Q_lds, d64);
    MASKT(pA0, pA1, 0); partialSM(pA0, pA1, m_reg, mnA, alA, deadv);
    if (NT > 1) { VMW(); SWRITE_H(1); }
    __syncthreads();
#define HALF_STEP(PX0, PX1, mnX, alX, PY0, PY1, alY, t, KB, VB, SB) do {                                           \
        SBAR(); qkt<KB>(PX0, PX1, K_lds, r32, hi, Q_lds, d64);                                                      \
        finishSM(PY0, PY1, alY, l_reg, pa0, pa1, pa2, pa3); SBAR();                                                \
        if ((t) + 1 < NT) { SLOAD_H(Kh, Vh, KBASE((t) + 1), kp); SBAR(); }                                         \
        pv_tile<VB>(o, vb0, pa0, pa1, pa2, pa3); MASKT(PX0, PX1, (t)); partialSM(PX0, PX1, m_reg, mnX, alX, deadv);       \
        __syncthreads();                                                                                           \
        if ((t) + 1 < NT) { VMW(); SWRITE_H(SB); }                                                                 \
        RESC(alX); __syncthreads(); } while (0)
    for (int t = 1; t + 1 < NT; t += 2) {
        HALF_STEP(pB0, pB1, mnB, alB, pA0, pA1, alA, t, 1, 0, 0);
        HALF_STEP(pA0, pA1, mnA, alA, pB0, pB1, alB, t + 1, 0, 1, 1);
    }
    const bool even = (NT & 1) == 0;
    if (even) { SBAR(); qkt<1>(pB0, pB1, K_lds, r32, hi, Q_lds, d64); SBAR(); }
    const BlockRef nxt = next_ref();
    SLOAD_H(nxt.K, nxt.V, nxt.jlo * KVBLK, nxt.kp); SBAR();
#pragma unroll
    for (int d0 = 0; d0 < 8; ++d0) { S.qr[d0] = bf16x8{}; if (d0 * 16 < nxt.kp) S.qr[d0] = load8(nxt.Q + (size_t)(wid * QBLK + r32) * nxt.kp + d0 * 16 + hi * 8); }
    SBAR();
    finishSM(pA0, pA1, alA, l_reg, pa0, pa1, pa2, pa3); SBAR();
    pv_tile<0>(o, vb0, pa0, pa1, pa2, pa3);
    if (even) { MASKT(pB0, pB1, NT - 1); partialSM(pB0, pB1, m_reg, mnB, alB, deadv); __syncthreads(); RESC(alB);
        finishSM(pB0, pB1, alB, l_reg, pa0, pa1, pa2, pa3); SBAR(); pv_tile<1>(o, vb0, pa0, pa1, pa2, pa3); }
    SBAR(); SEAM_K0();
    if (hi == 0) li_l[r32] = l_reg; asm volatile("s_waitcnt lgkmcnt(0)" ::: "memory");
    const GAS char* Ow = (const GAS char*)(cur.O + (size_t)(wid * QBLK) * cur.ldo);
    const unsigned ob = (unsigned)((4 * hi) * cur.ldo + r32) * 2u;
#pragma unroll
    for (int r = 0; r < 16; ++r) { const unsigned orow_b = (unsigned)(((r & 3) + 8 * (r >> 2)) * cur.ldo) * 2u;
        const float rl = __builtin_amdgcn_rcpf(li_l[crow(r, hi)]);
#pragma unroll
        for (int d0 = 0; d0 < 4; ++d0) { const float v = o[d0][r] * rl;
            const float vn = shx<1>(v);
            if ((r32 & 1) == 0) *(GAS unsigned*)(Ow + (size_t)(ob + orow_b + (unsigned)(d0 * 64))) = cvtpk(v, vn); } }
    __syncthreads();
#undef RESC
#undef KBASE
#undef MASKT
#undef SEAM_K0
#undef HALF_STEP
}
#undef ROW
#undef VMW
#undef VMWN
#undef SLOAD_H
#undef SWRITE_HK
#undef SWRITE_HV
#undef SWRITE_H
}

struct Args {
    const float* in[25]; float* out; unsigned char* ws;
    double invrev[16];
    int ph_lo, ph_hi;
};
struct Frame {
    int tid, lane, wave, G, bid, gw, GW;
    unsigned char* ws; unsigned char* lds;
};
constexpr int ARG_OFF = 159744;
__device__ __forceinline__ const float* arg_in(const Frame& F, int j) {
    int off = ARG_OFF; asm volatile("" : "+v"(off));
    const LAS unsigned* la = (const LAS unsigned*)((LAS unsigned char*)F.lds + off);
    const unsigned lo = __builtin_amdgcn_readfirstlane(la[2 * j]), hi = __builtin_amdgcn_readfirstlane(la[2 * j + 1]);
    return (const float*)(((unsigned long long)hi << 32) | lo);
}
__device__ __forceinline__ const LAS double* arg_invrev(const Frame& F) { int off = ARG_OFF + 27 * 8; asm volatile("" : "+v"(off)); return (const LAS double*)((LAS unsigned char*)F.lds + off); }
enum { I_X = 0, I_NORM1, I_WIN, I_BGATE, I_BFORGET, I_AQN, I_AKN, I_LQ1, I_LK1, I_LQ2, I_LK2, I_AON, I_BQN, I_BKN, I_CQN, I_CKN, I_WBA, I_WBB, I_WBC, I_WOUT, I_NORM2, I_WPQ, I_PSK, I_PU, I_PV };

#define XB_TMO      128
#define XB_XCNT(j)  (256  + 64 * (j))
#define XB_XSUB(j)  (1280 + 64 * (j))
#define XB_XGEN(j)  (2304 + 64 * (j))
#define XB_TOP      3328
#define XB_TOPGEN   3392
#define XCD_BAR_WORDS 3456
#define XB_SPIN_CAP (1u << 22)
__device__ __forceinline__ unsigned xb_ld(unsigned* p)              { return __hip_atomic_load(p, __ATOMIC_RELAXED, __HIP_MEMORY_SCOPE_AGENT); }
__device__ __forceinline__ unsigned xb_add(unsigned* p, unsigned v) { return __hip_atomic_fetch_add(p, v, __ATOMIC_RELAXED, __HIP_MEMORY_SCOPE_AGENT); }
__device__ __forceinline__ unsigned xb_xcc_id() { return (unsigned)__builtin_amdgcn_s_getreg((3 << 11) | 20) & 0xFu; }
#define XB_SPIN(cond, bar) do { unsigned _sp = 0; while (cond) { __builtin_amdgcn_s_sleep(1); \
    if ((++_sp & 255u) == 0u) { if (xb_ld(&(bar)[XB_TMO])) break; if (_sp > XB_SPIN_CAP) { atomicAdd(&(bar)[XB_TMO], 1u); break; } } } } while (0)
struct XcdBarrier { unsigned* bar; unsigned x; volatile LAS unsigned* st; };
__device__ __forceinline__ XcdBarrier xcd_barrier_post(unsigned* bar, volatile LAS unsigned* st) {
    XcdBarrier b; b.bar = bar; b.x = xb_xcc_id(); b.st = st;
    if (threadIdx.x == 0) (void)xb_add(&bar[XB_XCNT(b.x)], 1u);
    return b;
}
__device__ __forceinline__ void xcd_barrier_complete(unsigned* bar, unsigned x, unsigned& nloc, unsigned& nx) {
    const unsigned G = gridDim.x * gridDim.y * gridDim.z;
    unsigned sum, cnt, mine, sp = 0u;
    for (;;) {
        sum = 0u; cnt = 0u; mine = 0u;
#pragma unroll
        for (unsigned j = 0; j < 16; ++j) { const unsigned c = xb_ld(&bar[XB_XCNT(j)]); sum += c; cnt += (c > 0u) ? 1u : 0u; mine = (j == x) ? c : mine; }
        if (sum == G) break;
        __builtin_amdgcn_s_sleep(1);
        if ((++sp & 255u) == 0u) { if (xb_ld(&bar[XB_TMO])) break; if (sp > XB_SPIN_CAP) { atomicAdd(&bar[XB_TMO], 1u); break; } }
    }
    nloc = mine > 0u ? mine : 1u; nx = cnt > 0u ? cnt : 1u;
}
__device__ __forceinline__ void xcd_barrier(const XcdBarrier& b) {
    asm volatile("s_waitcnt vmcnt(0)" ::: "memory");
    __syncthreads();
    if (threadIdx.x == 0) {
        unsigned* bar = b.bar;
        __builtin_amdgcn_s_waitcnt(0);
        unsigned nloc = b.st[0], nx = b.st[1];
        if (nloc == 0u) { xcd_barrier_complete(bar, b.x, nloc, nx); b.st[0] = nloc; b.st[1] = nx; }
        const unsigned old = xb_add(&bar[XB_XSUB(b.x)], 1u);
        const unsigned gen = old / nloc;
        if (old + 1u == (gen + 1u) * nloc) {
            __builtin_amdgcn_fence(__ATOMIC_RELEASE, "agent");
            asm volatile("s_waitcnt vmcnt(0)" ::: "memory");
            const unsigned og = xb_add(&bar[XB_TOP], 1u);
            const unsigned tg = og / nx;
            if (og + 1u == (tg + 1u) * nx) xb_add(&bar[XB_TOPGEN], 1u);
            else XB_SPIN(xb_ld(&bar[XB_TOPGEN]) == tg, bar);
            __builtin_amdgcn_fence(__ATOMIC_ACQUIRE, "agent");
            xb_add(&bar[XB_XGEN(b.x)], 1u);
            asm volatile("s_waitcnt vmcnt(0)" ::: "memory");
        } else {
            XB_SPIN(xb_ld(&bar[XB_XGEN(b.x)]) == gen, bar);
            __builtin_amdgcn_fence(__ATOMIC_ACQUIRE, "agent");
            asm volatile("s_waitcnt vmcnt(0)" ::: "memory");
        }
    }
    __syncthreads();
}

struct CvtTile { const float* src; bf16_t* dst; const float* gk; int ldsrc, lddst; unsigned char* dst8; };
constexpr int CVT_TILES = 32 * 6 + 32 * 5 + 32 * 5 + 32 * 16 + 32 * 16;
__device__ __forceinline__ CvtTile cvt_decode(const Frame& F, int t) {
    const int l = t / CVT_TILES; int u = t - l * CVT_TILES;
    unsigned char* wl = F.ws + WS_W0 + (size_t)l * WL_SIZE;
    const float* W; const float* gk = nullptr; int ld, nt, kt, coloff = 0, kdoff = 0, lddst; bf16_t* D; unsigned char* D8 = nullptr;
    if (u < 32 * 6) { nt = u / 6; kt = u % 6; W = arg_in(F, I_WBA) + (size_t)l * 768 * DM; ld = DM; D = (bf16_t*)(wl + WO_WBR_T); lddst = 768; }
    else if ((u -= 32 * 6) < 32 * 5) { nt = u / 5; kt = u % 5; W = arg_in(F, I_WBB) + (size_t)l * 640 * DM; ld = DM; D = (bf16_t*)(wl + WO_WBR_T) + (size_t)2048 * 768; lddst = 768; }
    else if ((u -= 32 * 5) < 32 * 5) { nt = u / 5; kt = u % 5; W = arg_in(F, I_WBC) + (size_t)l * 640 * DM; ld = DM; D = (bf16_t*)(wl + WO_WBR_T) + (size_t)2 * 2048 * 768; lddst = 768; }
    else if ((u -= 32 * 5) < 32 * 16) { nt = u / 16; kt = u % 16; W = arg_in(F, I_WOUT) + (size_t)l * DM * DM; ld = DM; D = (bf16_t*)(wl + WO_WOUT_T); lddst = 2048; D8 = wl + WO_WOUT_T + (size_t)(nt * 64) * 2048 + kt * 128; }
    else { u -= 32 * 16; nt = u / 16; kt = u % 16; W = arg_in(F, I_WPQ) + (size_t)l * DM * DM; ld = DM; D = (bf16_t*)(wl + WO_WQ_T); lddst = 2048; gk = arg_in(F, I_NORM2) + l * DM + kt * 128; if (QF8_LAYER(l)) D8 = wl + WO_WQ_T + (size_t)(nt * 64) * 2048 + kt * 128; }
    CvtTile c; c.src = W + (size_t)(kt * 128) * ld + nt * 64 + coloff; c.ldsrc = ld; c.dst = D + (size_t)(nt * 64) * lddst + kdoff + kt * 128; c.lddst = lddst; c.gk = gk; c.dst8 = D8; return c;
}
__device__ __forceinline__ void cvt_load(const Frame& F, const CvtTile& c, float (&r)[16]) {
    const int n = F.tid & 63, kq = F.tid >> 6;
#pragma unroll
    for (int i = 0; i < 16; ++i) r[i] = ldg_nt<float>(c.src + (size_t)(kq + 8 * i) * c.ldsrc + n);
    if (c.gk) {
#pragma unroll
        for (int i = 0; i < 16; ++i) r[i] *= ldg<float>(c.gk + kq + 8 * i); }
}
__device__ __forceinline__ void cvt_store(const Frame& F, const CvtTile& c, const float (&r)[16]) {
    bf16_t* sT = (bf16_t*)F.lds;
    const int n = F.tid & 63, kq = F.tid >> 6;
#pragma unroll
    for (int i = 0; i < 16; ++i) sT[n * 130 + kq + 8 * i] = (bf16_t)(cvtpk(r[i], 0.f) & 0xffffu);
    __syncthreads();
    if (c.dst8) {
        const int nn = F.tid >> 3, k16 = (F.tid & 7) * 16; const bf16_t* s = sT + nn * 130 + k16; u32x4 w;
#pragma unroll
        for (int q = 0; q < 4; ++q) { const unsigned a = *(const unsigned*)(s + 4 * q), b = *(const unsigned*)(s + 4 * q + 2); int o = 0;
            o = __builtin_amdgcn_cvt_pk_fp8_f32(bflo(a) * WO8_SCALE, bfhi(a) * WO8_SCALE, o, false); o = __builtin_amdgcn_cvt_pk_fp8_f32(bflo(b) * WO8_SCALE, bfhi(b) * WO8_SCALE, o, true); w[q] = (unsigned)o; }
        stg<u32x4>(c.dst8 + (size_t)nn * c.lddst + k16, w);
    } else {
    const int kc = (F.tid & 15) * 8;
#pragma unroll
    for (int j = 0; j < 2; ++j) { const int nn = (F.tid >> 4) + 32 * j; const bf16_t* s = sT + nn * 130 + kc;
        u32x4 w; w.x = *(const unsigned*)(s); w.y = *(const unsigned*)(s + 2); w.z = *(const unsigned*)(s + 4); w.w = *(const unsigned*)(s + 6);
        stg<u32x4>(c.dst + (size_t)nn * c.lddst + kc, w); }
    }
    __syncthreads();
}
__device__ __forceinline__ void cvt_row_fp6(const f32x4 (&v)[8], unsigned char* dst, float* rsc, int lane) {
    float am = 0.f;
#pragma unroll
    for (int i = 0; i < 8; ++i) am = fmaxf(am, fmaxf(fmaxf(fabsf(v[i][0]), fabsf(v[i][1])), fmaxf(fabsf(v[i][2]), fabsf(v[i][3]))));
    am = fmaxf(am, shx<1>(am)); am = fmaxf(am, shx<2>(am)); am = fmaxf(am, shx<4>(am)); am = fmaxf(am, shx<8>(am)); am = fmaxf(am, shx<16>(am));
    am = fmaxf(am, shx32(am, lane >= 32));
    am = fmaxf(am, 1e-30f);
#if XFMT == 4
    const float sc4 = 6.0f / am;
    u32x4 p4;
#define E4(d, b) w = __builtin_amdgcn_cvt_scalef32_pk_fp4_f32(w, v[(8 * (d) + 2 * (b)) >> 2][(8 * (d) + 2 * (b)) & 3] * sc4, v[(8 * (d) + 2 * (b) + 1) >> 2][(8 * (d) + 2 * (b) + 1) & 3] * sc4, 1.0f, b)
#define E4D(d) { unsigned w = 0u; E4(d, 0); E4(d, 1); E4(d, 2); E4(d, 3); p4[d] = w; }
    E4D(0) E4D(1) E4D(2) E4D(3)
#undef E4
#undef E4D
    stg_nt<u32x4>(dst + lane * 16, p4);
    if (lane == 0) stg<float>(rsc, am * (1.f / 6.0f));
    return;
#endif
    const float sc = 7.0f / am;
    f32x16 a, b;
#pragma unroll
    for (int i = 0; i < 16; ++i) { a[i] = v[(2 * i) >> 2][(2 * i) & 3] * sc; b[i] = v[(2 * i + 1) >> 2][(2 * i + 1) & 3] * sc; }
    const u32x6 p = __builtin_amdgcn_cvt_scalef32_2xpk16_fp6_f32(a, b, 1.0f);
    stg<u32x2>(dst + lane * 24, (u32x2){p[0], p[1]}); stg<u32x2>(dst + lane * 24 + 8, (u32x2){p[2], p[3]}); stg<u32x2>(dst + lane * 24 + 16, (u32x2){p[4], p[5]});
    if (lane == 0) stg<float>(rsc, am * (1.f / 7.0f));
}
__device__ __forceinline__ void phase_convert(const Frame& F) {
    { const int total = DEPTH * CVT_TILES; int t = F.bid; float ra[16], rb[16];
      if (t < total) { const CvtTile c = cvt_decode(F, t); cvt_load(F, c, ra); }
      while (t < total) {
          int t2 = t + F.G; if (t2 < total) { const CvtTile c = cvt_decode(F, t2); cvt_load(F, c, rb); }
          { const CvtTile c = cvt_decode(F, t); cvt_store(F, c, ra); }
          t = t2; if (t >= total) break;
          t2 = t + F.G; if (t2 < total) { const CvtTile c = cvt_decode(F, t2); cvt_load(F, c, ra); }
          { const CvtTile c = cvt_decode(F, t); cvt_store(F, c, rb); }
          t = t2; } }
    { constexpr int NSTRIP = 12288 / 32, SP = 2056, NS = DEPTH * NSTRIP;
      bf16_t* sT = (bf16_t*)F.lds; float* sMax = (float*)(F.lds + 32 * SP * 2); float* sG = sMax + 512;
      const int n = F.tid & 31, kq = F.tid >> 5;
      for (int i = F.tid; i < DEPTH * DM; i += 512) sG[i] = ldg<float>(arg_in(F, I_NORM1) + i);
      __syncthreads();
      float ra[16], rb[16]; float am = 0.f; int sidx = F.bid, b = 0;
      const bool xm_ = (F.G & 7) == 0 && NS % F.G == 0;
#define SMAP(v_) (xm_ ? (((v_) % F.G) & 7) * (NS / 8) + ((v_) / F.G) * (F.G >> 3) + (((v_) % F.G) >> 3) : (v_))
#define WQ_LOAD(R, sx, bx) do { const int l_ = (sx) / NSTRIP, n0_ = ((sx) % NSTRIP) * 32; const float* W_ = arg_in(F, I_WIN) + (size_t)l_ * DM * INCOLS + (size_t)((bx) * 256 + kq) * INCOLS + n0_ + (n0_ >= 6144 ? 5 : 0) + n; \
          _Pragma("unroll") for (int i = 0; i < 16; ++i) R[i] = ldg_nt<float>(W_ + (size_t)(16 * i) * INCOLS); } while (0)
#define WQ_PROC(R, sx, bx) do { const int l_ = (sx) / NSTRIP, n0_ = ((sx) % NSTRIP) * 32, kb_ = (bx) * 256 + kq; \
          _Pragma("unroll") for (int i = 0; i < 16; ++i) { const float v_ = R[i] * sG[l_ * DM + kb_ + 16 * i]; am = fmaxf(am, fabsf(v_)); sT[n * SP + kb_ + 16 * i] = (bf16_t)(cvtpk(v_, 0.f) & 0xffffu); } \
          if ((bx) == 7) { sMax[kq * 32 + n] = am; am = 0.f; __syncthreads(); \
              unsigned char* W8_ = F.ws + WS_W0 + (size_t)l_ * WL_SIZE + WO_WIN8; float* WSC_ = (float*)(F.ws + WS_W0 + (size_t)l_ * WL_SIZE + WO_WSC); \
              _Pragma("unroll 2") for (int j = 0; j < 8; ++j) { const int row = (F.tid >> 7) + 4 * j, kc = (F.tid & 127) * 16; float m_ = 1e-30f; \
                  _Pragma("unroll") for (int q = 0; q < 16; ++q) m_ = fmaxf(m_, sMax[q * 32 + row]); \
                  const float inv_ = 127.0f / m_; const u32x4 w0 = *(const u32x4*)(sT + row * SP + kc), w1 = *(const u32x4*)(sT + row * SP + kc + 8); u32x4 o; \
                  o[0] = q8x4(bflo(w0[0]), bfhi(w0[0]), bflo(w0[1]), bfhi(w0[1]), inv_); o[1] = q8x4(bflo(w0[2]), bfhi(w0[2]), bflo(w0[3]), bfhi(w0[3]), inv_); \
                  o[2] = q8x4(bflo(w1[0]), bfhi(w1[0]), bflo(w1[1]), bfhi(w1[1]), inv_); o[3] = q8x4(bflo(w1[2]), bfhi(w1[2]), bflo(w1[3]), bfhi(w1[3]), inv_); \
                  stg<u32x4>(W8_ + (size_t)(n0_ + row) * 2048 + kc, o); if ((F.tid & 127) == 0) stg<float>(WSC_ + n0_ + row, m_ * (1.0f / 127.0f)); } \
              __syncthreads(); } } while (0)
      if (sidx < NS) WQ_LOAD(ra, SMAP(sidx), 0);
      while (sidx < NS) {
          int s2 = sidx, b2 = b + 1; if (b2 == 8) { b2 = 0; s2 = sidx + F.G; }
          if (s2 < NS) WQ_LOAD(rb, SMAP(s2), b2);
          WQ_PROC(ra, SMAP(sidx), b);
          sidx = s2; b = b2; if (sidx >= NS) break;
          s2 = sidx; b2 = b + 1; if (b2 == 8) { b2 = 0; s2 = sidx + F.G; }
          if (s2 < NS) WQ_LOAD(ra, SMAP(s2), b2);
          WQ_PROC(rb, SMAP(sidx), b);
          sidx = s2; b = b2; }
#undef SMAP
#undef WQ_LOAD
#undef WQ_PROC
    }
    const size_t gt = (size_t)F.bid * 512 + F.tid, GT = (size_t)F.G * 512;
#pragma unroll 1
    for (int l = 0; l < DEPTH; ++l) {
        unsigned char* ws = F.ws + WS_W0 + (size_t)l * WL_SIZE;
        const float* w_in = arg_in(F, I_WIN) + (size_t)l * DM * INCOLS;
        for (size_t i = gt; i < (size_t)2 * 2048 * 16; i += GT) { const int which = (int)(i / (2048 * 16)), r = (int)((i / 16) % 2048), c = (int)(i % 16);
            bf16_t* p = (bf16_t*)(ws + WO_WBR_T) + (size_t)(1 + which) * 2048 * 768 + (size_t)r * 768 + 640 + c * 8;
            stg<u32x4>(p, zero4()); }
        for (size_t i = gt; i < (size_t)5 * 2048; i += GT) { const int c = (int)(i / 2048), k = (int)(i % 2048); stg<float>((float*)(ws + WO_WF) + i, ldg<float>(w_in + (size_t)k * INCOLS + 6144 + c) * ldg<float>(arg_in(F, I_NORM1) + l * DM + k)); }
        { const float* s = arg_in(F, I_PSK) + (size_t)l * 262144; bf16_t* d = (bf16_t*)(ws + WO_SK);
          for (size_t i = gt; i < (size_t)262144 / 8; i += GT) { const f32x4 a = ldg<f32x4>(s + i * 8), b = ldg<f32x4>(s + i * 8 + 4); stg<bf16x8>(d + i * 8, pack8(a, b)); } }
    }
#ifdef TAB1
    for (int R = F.gw; R < DEPTH * 2 * 16384; R += F.GW) {
        const int R2 = R; const bool two = false;
#else
    for (int R = F.gw; R < DEPTH * 2 * 16384; R += 2 * F.GW) {
        const int R2 = R + F.GW; const bool two = R2 < DEPTH * 2 * 16384;
#endif
        const int q1 = R >> 14, r1 = R & 16383, q2 = two ? (R2 >> 14) : q1, r2 = two ? (R2 & 16383) : r1;
        const float* s1 = ((q1 & 1) ? arg_in(F, I_PV) : arg_in(F, I_PU)) + ((size_t)(q1 >> 1) * 16384 + r1) * 2048;
        const float* s2 = ((q2 & 1) ? arg_in(F, I_PV) : arg_in(F, I_PU)) + ((size_t)(q2 >> 1) * 16384 + r2) * 2048;
        f32x4 va[8], vb[8];
#pragma unroll
        for (int i = 0; i < 8; ++i) va[i] = ldg_nt<f32x4>(s1 + i * 256 + F.lane * 4);
#ifndef TAB1
#pragma unroll
        for (int i = 0; i < 8; ++i) vb[i] = ldg_nt<f32x4>(s2 + i * 256 + F.lane * 4);
#endif
        if (!(q1 & 1)) { const float* g2 = arg_in(F, I_NORM2) + (q1 >> 1) * DM;
#pragma unroll
            for (int i = 0; i < 8; ++i) va[i] = va[i] * ldg<f32x4>(g2 + i * 256 + F.lane * 4); }
        if (two && !(q2 & 1)) { const float* g2 = arg_in(F, I_NORM2) + (q2 >> 1) * DM;
#pragma unroll
            for (int i = 0; i < 8; ++i) vb[i] = vb[i] * ldg<f32x4>(g2 + i * 256 + F.lane * 4); }
        { unsigned char* wl = F.ws + WS_W0 + (size_t)(q1 >> 1) * WL_SIZE; cvt_row_fp6(va, wl + ((q1 & 1) ? WO_V : WO_U) + (size_t)r1 * XROW, (float*)(wl + ((q1 & 1) ? WO_VSC : WO_USC)) + r1, F.lane); }
        if (two) { unsigned char* wl = F.ws + WS_W0 + (size_t)(q2 >> 1) * WL_SIZE; cvt_row_fp6(vb, wl + ((q2 & 1) ? WO_V : WO_U) + (size_t)r2 * XROW, (float*)(wl + ((q2 & 1) ? WO_VSC : WO_USC)) + r2, F.lane); }
    }
}

__device__ __forceinline__ void phase_norm(const Frame& F, const float* x, const float* bforget, const float* w_in, const float* g1) {
    unsigned char* H8 = F.ws + WS_H8; float* LOGF = (float*)(F.ws + WS_LOGF);
    const float* wfl = (const float*)F.lds;
    for (int i = F.tid; i < 5 * 2048; i += 512) { const int c = i >> 11, k = i & 2047; ((float*)F.lds)[i] = ldg<float>(w_in + (size_t)k * INCOLS + 6144 + c) * ldg<float>(g1 + k); }
    __syncthreads();
    for (int t = F.gw; t < T_TOK; t += F.GW) {
        const float* xr = x + (size_t)t * DM; f32x4 v[8]; float ss = 0.f;
#pragma unroll
        for (int i = 0; i < 8; ++i) { v[i] = ldg_nt<f32x4>(xr + i * 256 + F.lane * 4); ss += v[i][0] * v[i][0] + v[i][1] * v[i][1] + v[i][2] * v[i][2] + v[i][3] * v[i][3]; }
        ss = wave_sum(ss); const float rstd = rsqrtf(ss * (1.f / DM) + NORM_EPS);
        float am = 1e-30f;
#pragma unroll
        for (int i = 0; i < 8; ++i) am = fmaxf(am, fmaxf(fmaxf(fabsf(v[i][0]), fabsf(v[i][1])), fmaxf(fabsf(v[i][2]), fabsf(v[i][3]))));
        am = wave_max(am); const float inv = 127.0f / am;
#pragma unroll
        for (int i = 0; i < 8; ++i) stg<unsigned>(H8 + (size_t)t * DM + i * 256 + F.lane * 4, q8x4(v[i][0], v[i][1], v[i][2], v[i][3], inv));
        if (F.lane == 0) stg<float>(LOGF + t * 8 + 5, rstd * am * (1.0f / 127.0f));
#pragma unroll
        for (int c = 0; c < 5; ++c) { float d = 0.f;
#pragma unroll
            for (int i = 0; i < 8; ++i) { const f32x4 wv = *(const f32x4*)(wfl + c * 2048 + i * 256 + F.lane * 4); d += v[i][0] * wv[0] + v[i][1] * wv[1] + v[i][2] * wv[2] + v[i][3] * wv[3]; }
            d = wave_sum(d) * rstd;
            if (F.lane == 0) { const float z = d + ldg<float>(bforget + c); stg<float>(LOGF + t * 8 + c, fminf(z, 0.f) - log1pf(__expf(-fabsf(z)))); } }
    }
}

struct PrepP { const float* aqn; const float* akn; const float* bqn; const float* bkn; const float* cqn; const float* ckn; };
__device__ __forceinline__ void unpack8(const u32x4 w, float* x) { x[0] = bflo(w[0]); x[1] = bfhi(w[0]); x[2] = bflo(w[1]); x[3] = bfhi(w[1]); x[4] = bflo(w[2]); x[5] = bfhi(w[2]); x[6] = bflo(w[3]); x[7] = bfhi(w[3]); }
__device__ __forceinline__ u32x4 pack8u(const float* x) { return (u32x4){cvtpk(x[0], x[1]), cvtpk(x[2], x[3]), cvtpk(x[4], x[5]), cvtpk(x[6], x[7])}; }
template <int NDIM, bool ROPE>
__device__ __forceinline__ u32x4 qk_unit(const u32x4 raw, const float* gain, int li, int s, const LAS double* invrev, float qs) {
    float x[8]; unpack8(raw, x);
    float ss = 0.f;
#pragma unroll
    for (int e = 0; e < 8; ++e) ss += x[e] * x[e];
    ss += shx<1>(ss); ss += shx<2>(ss); ss += shx<4>(ss); if (NDIM == 128) ss += shx<8>(ss);
    const float rstd = rsqrtf(ss * (1.f / NDIM) + NORM_EPS);
    const int lu = NDIM == 128 ? li : (li & 7);
    const f32x4 g0 = ldg<f32x4>(gain + lu * 8), g1 = ldg<f32x4>(gain + lu * 8 + 4);
    x[0] *= rstd * g0[0]; x[1] *= rstd * g0[1]; x[2] *= rstd * g0[2]; x[3] *= rstd * g0[3]; x[4] *= rstd * g1[0]; x[5] *= rstd * g1[1]; x[6] *= rstd * g1[2]; x[7] *= rstd * g1[3];
    if (ROPE) {
        constexpr int PX = NDIM == 128 ? 2 : 1;
        const bool inrope = lu < 2 * PX, first = lu < PX;
#pragma unroll
        for (int e = 0; e < 8; ++e) {
            const float p = shx<PX>(x[e]);
            const double ir = NDIM == 128 ? ((lu & 1) ? invrev[8 + e] : invrev[e]) : invrev[2 * e];
            const double rev = (double)s * ir; const float fr = (float)(rev - floor(rev));
            const float c = __builtin_amdgcn_cosf(fr), sn = __builtin_amdgcn_sinf(fr);
            const float r = first ? (x[e] * c - p * sn) : (x[e] * c + p * sn);
            x[e] = inrope ? r : x[e];
        }
    }
#pragma unroll
    for (int e = 0; e < 8; ++e) x[e] *= qs;
    return pack8u(x);
}
__device__ __forceinline__ void phase_prep(const Frame& F, int l) {
    const LAS double* invrev = arg_invrev(F);
    unsigned char* ws = F.ws;
    const bf16_t* PROJ = (const bf16_t*)(ws + WS_PROJ);
    const float* aqn = arg_in(F, I_AQN) + l * 64; const float* akn = arg_in(F, I_AKN) + l * 64;
    const float* bqn = arg_in(F, I_BQN) + l * 128; const float* bkn = arg_in(F, I_BKN) + l * 128; const float* cqn = arg_in(F, I_CQN) + l * 128; const float* ckn = arg_in(F, I_CKN) + l * 128;
    const float QS64 = 0.125f * LOG2E, QS128 = 0.08838834764831845f * LOG2E;
    const int gq = F.lane >> 4, li = F.lane & 15;
    const bool wgred = F.GW * 4 == T_TOK;
    for (int t0 = F.gw * 4; t0 < T_TOK; t0 += F.GW * 4) {
        const int t = t0 + gq, b = t >> 12, s = t & 4095;
        const bf16_t* row = PROJ + (size_t)t * PQ + li * 8;
        u32x4 rawall[48];
#pragma unroll
        for (int u = 0; u < 48; ++u) { const bool isv = (u >= 12 && u < 18) || (u >= 28 && u < 33) || u >= 43;
            if (!isv) rawall[u] = ldg_nt<u32x4>(row + u * 128); }
#pragma unroll
        for (int batch = 0; batch < 4; ++batch) {
            u32x4* raw = rawall + batch * 12;
#pragma unroll
            for (int j = 0; j < 12; ++j) {
                const int u = batch * 12 + j;
                if (u < 6) {
                    const u32x4 o = qk_unit<64, true>(raw[j], aqn, li, s, invrev, QS64);
                    bf16_t* d = (bf16_t*)(ws + WS_QA) + ((size_t)(b * 12 + u * 2 + (li >> 3)) * 4096 + s) * 64 + (li & 7) * 8;
                    stg<u32x4>(d, o);
                } else if (u < 12) {
                    const u32x4 o = qk_unit<64, true>(raw[j], akn, li, s, invrev, 1.f);
                    bf16_t* d = (bf16_t*)(ws + WS_KA) + ((size_t)(b * 12 + (u - 6) * 2 + (li >> 3)) * 4096 + s) * 64 + (li & 7) * 8;
                    stg<u32x4>(d, o);
                } else if (u < 18) {
                } else if (u < 23) {
                    stg<u32x4>((bf16_t*)(ws + WS_QB) + ((size_t)(b * 5 + (u - 18)) * 4096 + s) * 128 + li * 8, qk_unit<128, true>(raw[j], bqn, li, s, invrev, QS128));
                } else if (u < 28) {
                    const u32x4 o = qk_unit<128, true>(raw[j], bkn, li, s, invrev, 1.f);
                    stg<u32x4>((bf16_t*)(ws + WS_KB) + ((size_t)(b * 5 + (u - 23)) * 4096 + s) * 128 + li * 8, o);
                    { float kv[8]; unpack8(o, kv); int* ksum = (int*)(ws + WS_KSUM) + ((size_t)(b * 5 + (u - 23)) * 16 + (s >> 8)) * 128 + li * 8;
                      float* skw = (float*)(F.lds + 8192) + (F.wave * 5 + (u - 23)) * 128 + li * 8;
#pragma unroll
                      for (int e = 0; e < 8; ++e) { float v = kv[e]; v += shx<16>(v); v = sum32(v);
                          if (F.lane < 16) { if (wgred) skw[e] = v; else atomicAdd(ksum + e, (int)rintf(v * 262144.f)); } } }
                } else if (u < 33) {
                } else if (u < 38) {
                    stg<u32x4>((bf16_t*)(ws + WS_QC) + ((size_t)(b * 5 + (u - 33)) * 4096 + s) * 128 + li * 8, qk_unit<128, false>(raw[j], cqn, li, s, invrev, QS128));
                } else if (u < 43) {
                    stg<u32x4>((bf16_t*)(ws + WS_KC) + ((size_t)(b * 5 + (u - 38)) * 4096 + s) * 128 + li * 8, qk_unit<128, false>(raw[j], ckn, li, s, invrev, 1.f));
                } else {
                }
            }
        }
    }
    if (wgred) {
        __syncthreads();
        const int tw = F.bid * 32, bb = tw >> 12, blk = (tw & 4095) >> 8; const float* sk = (const float*)(F.lds + 8192);
        for (int i = F.tid; i < 5 * 128; i += 512) { float v = 0.f;
#pragma unroll
            for (int w = 0; w < 8; ++w) v += sk[w * 640 + i];
            atomicAdd((int*)(ws + WS_KSUM) + ((size_t)(bb * 5 + i / 128) * 16 + blk) * 128 + (i & 127), (int)rintf(v * 262144.f)); }
        __syncthreads();
    }
    for (int i = F.bid * 512 + F.tid; i < T_TOK; i += F.G * 512) stg<unsigned long long>((unsigned long long*)(ws + WS_ROWSS) + i, 0ull);
    if (F.bid < 10) {
        const int b = F.bid / 5, h = F.bid % 5; const float* LOGF = (const float*)(ws + WS_LOGF); float* CB = (float*)(ws + WS_CB) + (size_t)F.bid * 4096;
        double* sd = (double*)F.lds;
        double loc[8]; double run = 0.0;
#pragma unroll
        for (int i = 0; i < 8; ++i) { run += (double)ldg<float>(LOGF + (size_t)(b * 4096 + F.tid * 8 + i) * 8 + h); loc[i] = run; }
        sd[F.tid] = run; __syncthreads();
        if (F.tid < 64) { double acc = 0.0;
#pragma unroll
            for (int i = 0; i < 8; ++i) { const double v = sd[F.tid * 8 + i]; sd[F.tid * 8 + i] = acc; acc += v; }
            sd[512 + F.tid] = acc; }
        __syncthreads();
        if (F.tid == 0) { double acc = 0.0; for (int i = 0; i < 64; ++i) { const double v = sd[512 + i]; sd[512 + i] = acc; acc += v; } }
        __syncthreads();
        const double base = sd[F.tid] + sd[512 + (F.tid >> 3)];
#pragma unroll
        for (int i = 0; i < 8; ++i) stg<float>(CB + F.tid * 8 + i, (float)(base + loc[i]));
        __syncthreads();
    }
}

constexpr int ATT_ITEMS = 44 * 16;
__device__ __forceinline__ float att_thresh(const float* gq, const float* gk, int lane) {
    float a = fmaxf(fabsf(ldg<float>(gq + lane)), fabsf(ldg<float>(gq + 64 + lane))), b = fmaxf(fabsf(ldg<float>(gk + lane)), fabsf(ldg<float>(gk + 64 + lane)));
    a = fmaxf(a, shx<1>(a)); a = fmaxf(a, shx<2>(a)); a = fmaxf(a, shx<4>(a)); a = fmaxf(a, shx<8>(a)); a = fmaxf(a, shx<16>(a)); a = fmaxf(a, shx32(a, lane >= 32));
    b = fmaxf(b, shx<1>(b)); b = fmaxf(b, shx<2>(b)); b = fmaxf(b, shx<4>(b)); b = fmaxf(b, shx<8>(b)); b = fmaxf(b, shx<16>(b)); b = fmaxf(b, shx32(b, lane >= 32));
    return __int_as_float(__builtin_amdgcn_readfirstlane(__float_as_int(2.f * (16.65f * a * b) + 40.f)));
}
__device__ __forceinline__ int att_jlo(const float* cb, int P0, float thresh, int) {
    int lane = threadIdx.x; asm volatile("" : "+v"(lane)); lane &= 63;
    const int nt0 = P0 / 64;
    bool need = true;
    if (lane < nt0) need = (ldg<float>(cb + P0) - ldg<float>(cb + lane * 64 + 63)) * LOG2E >= -thresh;
    const unsigned long long m = __ballot(need);
    return __builtin_amdgcn_readfirstlane((int)__builtin_ctzll(m));
}
__device__ __forceinline__ att::BlockRef att_item(unsigned char* ws, unsigned char* lds, int idx, int lane) {
    asm volatile("" : "+s"(ws));
    int qb, c; if (idx < 34 * 16) { qb = 15 - idx / 34; c = idx % 34; } else { const int j = idx - 34 * 16; qb = 15 - j / 10; c = 34 + j % 10; }
    att::BlockRef r; r.P0 = qb * 256; r.cb = nullptr; r.jlo = 0;
    r.kp = 128;
    if (c < 24) { const int b = c / 12, hs = c % 12; const size_t ho = ((size_t)(b * 12 + hs) * 4096) * 64; r.kp = 64;
        r.Q = (const bf16_t*)(ws + WS_QA) + ho + (size_t)r.P0 * 64; r.K = (const bf16_t*)(ws + WS_KA) + ho; r.V = (const bf16_t*)(ws + WS_VA) + ((size_t)(b * 6 + hs / 2) * 4096) * 128;
        r.O = (bf16_t*)(ws + WS_OA) + (size_t)(hs & 1) * T_TOK * 768 + ((size_t)b * 4096 + r.P0) * 768 + (hs / 2) * 128; r.ldo = 768; r.mode = 0;
    } else if (c < 34) { const int b = (c - 24) / 5, h = (c - 24) % 5; const size_t ho = ((size_t)(b * 5 + h) * 4096) * 128;
        r.Q = (const bf16_t*)(ws + WS_QB) + ho + (size_t)r.P0 * 128; r.K = (const bf16_t*)(ws + WS_KB) + ho; r.V = (const bf16_t*)(ws + WS_VB) + ho;
        r.O = (bf16_t*)(ws + WS_YCAT) + ((size_t)b * 4096 + r.P0) * 2048 + 768 + h * 128; r.ldo = 2048; r.mode = 1; r.cb = (const float*)(ws + WS_KSUM) + (size_t)(b * 5 + h) * 16 * 128;
    } else { const int b = (c - 34) / 5, h = (c - 34) % 5; const size_t ho = ((size_t)(b * 5 + h) * 4096) * 128;
        r.Q = (const bf16_t*)(ws + WS_QC) + ho + (size_t)r.P0 * 128; r.K = (const bf16_t*)(ws + WS_KC) + ho; r.V = (const bf16_t*)(ws + WS_VC) + ho;
        r.O = (bf16_t*)(ws + WS_YCAT) + ((size_t)b * 4096 + r.P0) * 2048 + 1408 + h * 128; r.ldo = 2048; r.mode = 2; r.cb = (const float*)(ws + WS_CB) + (size_t)(b * 5 + h) * 4096; r.jlo = att_jlo(r.cb, r.P0, *(volatile float*)(lds + att::OFF_MISC + 16), lane);
    }
    return r;
}
__device__ __forceinline__ int queue_fetch(const Frame& F, unsigned* ctr) {
    volatile int* slot = (volatile int*)(F.lds + att::OFF_MISC);
    int tid = threadIdx.x; asm volatile("" : "+v"(tid));
    if (tid == 0) *slot = (int)atomicAdd(ctr, 1u);
    __syncthreads();
    const int v = __builtin_amdgcn_readfirstlane(*slot);
    __syncthreads();
    return v;
}
__device__ __forceinline__ void phase_attention(const Frame& F, int slot, const float* gq, const float* gk) {
    unsigned* ctr = (unsigned*)(F.ws + WS_CTL) + 16 + slot;
    { const float th_ = att_thresh(gq, gk, F.lane); if (F.tid == 0) *(volatile float*)(F.lds + att::OFF_MISC + 16) = th_; }
    __syncthreads();
    int ci, ni = 0;
    if (F.G <= ATT_ITEMS) ci = F.bid; else { ci = queue_fetch(F, ctr); if (ci >= ATT_ITEMS) return; }
    const int qbase = (F.G <= ATT_ITEMS) ? F.G : 0;
    att::Seam S;
    { const att::BlockRef cur = att_item(F.ws, F.lds, ci, F.lane); att::attn_prime(cur, (char*)F.lds, S); }
    for (;;) {
        const att::BlockRef cur = att_item(F.ws, F.lds, ci, F.lane);
        att::attn_block(cur, [&]() { ni = qbase + queue_fetch(F, ctr); return att_item(F.ws, F.lds, ni < ATT_ITEMS ? ni : ci, 0); }, (char*)F.lds, S);
        if (ni >= ATT_ITEMS) break;
        ci = ni;
    }
}

__device__ __forceinline__ void phase_postA(const Frame& F, int l) {
    const float lam_init = l == 0 ? 0.2f : 0.35550906759931f;
    const float* lq1 = arg_in(F, I_LQ1) + l * 64; const float* lk1 = arg_in(F, I_LK1) + l * 64; const float* lq2 = arg_in(F, I_LQ2) + l * 64; const float* lk2 = arg_in(F, I_LK2) + l * 64;
    const float d1 = wave_sum(ldg<float>(lq1 + F.lane) * ldg<float>(lk1 + F.lane)), d2 = wave_sum(ldg<float>(lq2 + F.lane) * ldg<float>(lk2 + F.lane));
    const float lam = __expf(d1) - __expf(d2) + lam_init;
    const float* gon = arg_in(F, I_AON) + l * 128;
    const bf16_t* O1 = (const bf16_t*)(F.ws + WS_OA); const bf16_t* O2 = O1 + (size_t)T_TOK * 768; bf16_t* Y = (bf16_t*)(F.ws + WS_YCAT);
    const int li = F.lane & 15, gq = F.lane >> 4;
    const f32x4 g0 = ldg<f32x4>(gon + li * 8), g1 = ldg<f32x4>(gon + li * 8 + 4);
    for (int ub = F.gw * 4; ub < T_TOK * 6; ub += F.GW * 4 * 6) {
      u32x4 ra[6], rc[6];
#pragma unroll
      for (int q = 0; q < 6; ++q) { const int u0 = ub + q * F.GW * 4; if (u0 < T_TOK * 6) { const int u = u0 + gq, t = u / 6, h = u % 6;
          ra[q] = ldg_nt<u32x4>(O1 + (size_t)t * 768 + h * 128 + li * 8); rc[q] = ldg_nt<u32x4>(O2 + (size_t)t * 768 + h * 128 + li * 8); } }
#pragma unroll
      for (int q = 0; q < 6; ++q) { const int u0 = ub + q * F.GW * 4; if (u0 >= T_TOK * 6) break;
        const int u = u0 + gq, t = u / 6, h = u % 6;
        float a[8], c[8]; unpack8(ra[q], a); unpack8(rc[q], c);
        float ss = 0.f;
#pragma unroll
        for (int e = 0; e < 8; ++e) { a[e] = a[e] - lam * c[e]; ss += a[e] * a[e]; }
        ss += shx<1>(ss); ss += shx<2>(ss); ss += shx<4>(ss); ss += shx<8>(ss);
        const float sc = rsqrtf(ss * (1.f / 128) + NORM_EPS) * (1.f - lam_init);
        a[0] *= sc * g0[0]; a[1] *= sc * g0[1]; a[2] *= sc * g0[2]; a[3] *= sc * g0[3]; a[4] *= sc * g1[0]; a[5] *= sc * g1[1]; a[6] *= sc * g1[2]; a[7] *= sc * g1[3];
        stg<u32x4>(Y + (size_t)t * 2048 + h * 128 + li * 8, pack8u(a));
      }
    }
}

__device__ __forceinline__ int f2sort(float f) { const int b = __float_as_int(f); return b ^ ((b >> 31) & 0x7fffffff); }
__device__ __forceinline__ float sort2f(int s) { return __int_as_float(s ^ ((s >> 31) & 0x7fffffff)); }
__device__ __forceinline__ void ce_desc(int& a, int& b) { const int hi = max(a, b), lo = min(a, b); a = hi; b = lo; }
template <int N> __device__ __forceinline__ void bitonic_sort_desc(int* a) {
#pragma unroll
    for (int k = 2; k <= N; k <<= 1)
#pragma unroll
        for (int j = k >> 1; j > 0; j >>= 1)
#pragma unroll
            for (int i = 0; i < N; ++i) { const int l = i ^ j; if (l > i) { if ((i & k) == 0) ce_desc(a[i], a[l]); else ce_desc(a[l], a[i]); } }
}
template <int N> __device__ __forceinline__ void bitonic_merge_desc(int* c) {
#pragma unroll
    for (int j = N >> 1; j > 0; j >>= 1)
#pragma unroll
        for (int i = 0; i < N; ++i) { const int l = i ^ j; if (l > i) ce_desc(c[i], c[l]); }
}
__device__ __forceinline__ void top16_merge(int* a, const int* b) {
#pragma unroll
    for (int i = 0; i < 16; ++i) a[i] = max(a[i], b[15 - i]);
    bitonic_merge_desc<16>(a);
}
__device__ __forceinline__ void top16_of_64(int* key) {
    bitonic_sort_desc<16>(key); bitonic_sort_desc<16>(key + 16); bitonic_sort_desc<16>(key + 32); bitonic_sort_desc<16>(key + 48);
    top16_merge(key, key + 16); top16_merge(key + 32, key + 48); top16_merge(key, key + 32);
}
__device__ __forceinline__ void phase_topk(const Frame& F, const unsigned char* wl) {
    const bf16_t* QP = (const bf16_t*)(F.ws + WS_QP); const bf16_t* SK = (const bf16_t*)(wl + WO_SK);
    int* PIDX = (int*)(F.ws + WS_PIDX); float* PGATE = (float*)(F.ws + WS_PGATE);
    const int r32 = F.lane & 31, hi = F.lane >> 5;
    const int IMIN = (int)0x80000000;
    pg8::TileOrder ord; ord.init(T_TOK, 2048, F.G, F.bid);
    for (int it = 0;; ++it) {
        int tt, h; if (!ord.tile(it, tt, h)) break;
        const int t = tt * 256 + F.wave * 32 + r32;
        __syncthreads();
#pragma unroll
        for (int i = 0; i < 8; ++i) { const int cidx = F.tid + 512 * i;
            const int pp = cidx >> 11, n = (cidx >> 4) & 127, ch = cidx & 15;
            const u32x4 w = ldg<u32x4>(SK + ((size_t)((h * 2 + pp) * 128 + n)) * 128 + ch * 8);
            *(u32x4*)(F.lds + pp * 32768 + n * 256 + ((ch ^ (n & 15)) << 4)) = w; }
        __syncthreads();
        int kk[2][16];
#pragma unroll
        for (int p = 0; p < 2; ++p) {
            bf16x8 qf[8];
#pragma unroll
            for (int ks = 0; ks < 8; ++ks) qf[ks] = ldg<bf16x8>(QP + (size_t)(tt * 8 + h) * 65536 + (size_t)(((((F.wave * 2 + p) * 8 + ks) * 2 + hi) * 32 + r32) * 8));
            f32x16 acc[4];
#pragma unroll
            for (int nb = 0; nb < 4; ++nb) { acc[nb] = f32x16{};
#pragma unroll
                for (int ks = 0; ks < 8; ++ks) { const int n = nb * 32 + r32; const bf16x8 kf = *(const bf16x8*)(F.lds + p * 32768 + n * 256 + (((ks * 2 + hi) ^ (n & 15)) << 4));
                    acc[nb] = __builtin_amdgcn_mfma_f32_32x32x16_bf16(kf, qf[ks], acc[nb], 0, 0, 0); } }
            int key[64];
#pragma unroll
            for (int nb = 0; nb < 4; ++nb)
#pragma unroll
                for (int r = 0; r < 16; ++r) { const int n = nb * 32 + (r & 3) + 8 * (r >> 2) + 4 * hi; key[nb * 16 + r] = (f2sort(acc[nb][r]) & ~127) | n; }
            top16_of_64(key);
            { int other[16];
#pragma unroll
              for (int i = 0; i < 16; ++i) { auto rr = __builtin_amdgcn_permlane32_swap((unsigned)key[i], (unsigned)key[i], false, false); other[i] = hi ? (int)rr[0] : (int)rr[1]; }
              top16_merge(key, other); }
#pragma unroll
            for (int i = 0; i < 16; ++i) kk[p][i] = key[i];
        }
        float vA[16], vB[16];
#pragma unroll
        for (int i = 0; i < 16; ++i) { vA[i] = sort2f(kk[0][i] & ~127); vB[i] = sort2f(kk[1][i] & ~127); }
        int cand[64]; int cnt = 0;
#pragma unroll
        for (int i = 0; i < 16; ++i)
#pragma unroll
            for (int j = 0; j < 16; ++j) if ((i + 1) * (j + 1) <= 16) { cand[cnt] = (f2sort(vA[i] + vB[j]) & ~255) | (i * 16 + j); ++cnt; }
#pragma unroll
        for (int i = 50; i < 64; ++i) cand[i] = IMIN;
        top16_of_64(cand);
        int top[16];
#pragma unroll
        for (int i = 0; i < 16; ++i) top[i] = cand[i];
        int ex[16]; float ev[16]; float esum = 0.f;
        const float vmax = sort2f(top[0] & ~255);
#pragma unroll
        for (int k = 0; k < 16; ++k) {
            const int ij = top[k] & 255, i = ij >> 4, j = ij & 15;
            int na = 0, nbv = 0;
#pragma unroll
            for (int q = 0; q < 16; ++q) { na = (i == q) ? kk[0][q] : na; nbv = (j == q) ? kk[1][q] : nbv; }
            ex[k] = (na & 127) * 128 + (nbv & 127);
            ev[k] = __expf(sort2f(top[k] & ~255) - vmax); esum += ev[k];
        }
        const float inv = 1.f / esum;
        int oi[8]; float og[8];
#pragma unroll
        for (int k = 0; k < 8; ++k) { oi[k] = hi ? ex[8 + k] : ex[k]; og[k] = (hi ? ev[8 + k] : ev[k]) * inv; }
        int* pi = PIDX + (size_t)t * 128 + h * 16 + hi * 8; float* pg = PGATE + (size_t)t * 128 + h * 16 + hi * 8;
        stg<u32x4>(pi, (u32x4){(unsigned)oi[0], (unsigned)oi[1], (unsigned)oi[2], (unsigned)oi[3]}); stg<u32x4>(pi + 4, (u32x4){(unsigned)oi[4], (unsigned)oi[5], (unsigned)oi[6], (unsigned)oi[7]});
        stg<f32x4>(pg, (f32x4){og[0], og[1], og[2], og[3]}); stg<f32x4>(pg + 4, (f32x4){og[4], og[5], og[6], og[7]});
    }
}

__device__ __forceinline__ float dot8(const u32x4 a, const u32x4 b, float c) {
#pragma unroll
    for (int i = 0; i < 4; ++i) { c = fmaf(bflo(a[i]), bflo(b[i]), c); c = fmaf(bfhi(a[i]), bfhi(b[i]), c); }
    return c;
}
template <int M> __device__ __forceinline__ int xchg_i(int v, bool upper) {
    if constexpr (M < 32) return __builtin_amdgcn_ds_swizzle(v, (M << 10) | 0x1f);
    else { auto rr = __builtin_amdgcn_permlane32_swap((unsigned)v, (unsigned)v, false, false); return (int)(upper ? rr[0] : rr[1]); } }
template <int M> __device__ __forceinline__ float xchg_f(float v, bool upper) { return __int_as_float(xchg_i<M>(__float_as_int(v), upper)); }
__device__ __forceinline__ void phase_gather(const Frame& F, const float* xres, float* xout, const unsigned char* wl, const float* nxt_g1, const float* nxt_bf, const float* nxt_wf) {
    const bf16_t* H = (const bf16_t*)(F.ws + WS_HG); const unsigned long long* ROWSS = (const unsigned long long*)(F.ws + WS_ROWSS); const unsigned char* U = wl + WO_U; const unsigned char* V = wl + WO_V;
    const float* USC = (const float*)(wl + WO_USC); const float* VSC = (const float*)(wl + WO_VSC);
    const int* PIDX = (const int*)(F.ws + WS_PIDX); const float* PGATE = (const float*)(F.ws + WS_PGATE);
    const int lane = F.lane; const bool b5 = (lane >> 5) & 1, b4 = (lane >> 4) & 1;
    const float* wfl = (const float*)F.lds;
    if (nxt_bf) { for (int i = F.tid; i < 5 * 2048 / 4; i += 512) *(f32x4*)(F.lds + i * 16) = ldg<f32x4>(nxt_wf + i * 4); __syncthreads(); }
    u32x2 nxw[8]; int nid0, nid1; float ngg0, ngg1; unsigned long long nss;
#define GT_PREF(tt_) do { _Pragma("unroll") for (int i = 0; i < 8; ++i) nxw[i] = ldg_nt<u32x2>(H + (size_t)(tt_) * DM + i * 256 + lane * 4); \
        nid0 = ldg_nt<int>(PIDX + (size_t)(tt_) * 128 + lane); nid1 = ldg_nt<int>(PIDX + (size_t)(tt_) * 128 + 64 + lane); \
        ngg0 = ldg_nt<float>(PGATE + (size_t)(tt_) * 128 + lane); ngg1 = ldg_nt<float>(PGATE + (size_t)(tt_) * 128 + 64 + lane); nss = ldg<unsigned long long>(ROWSS + (tt_)); } while (0)
    if (F.gw < T_TOK) GT_PREF(F.gw);
    for (int t = F.gw; t < T_TOK; t += F.GW) {
        float x[32];
#pragma unroll
        for (int i = 0; i < 8; ++i) { const u32x2 w = nxw[i];
            x[i * 4 + 0] = bflo(w[0]); x[i * 4 + 1] = bfhi(w[0]); x[i * 4 + 2] = bflo(w[1]); x[i * 4 + 3] = bfhi(w[1]); }
        int id0 = nid0, id1 = nid1;
        float gg0 = ngg0, gg1 = ngg1;
        const float rs_t = rsqrtf((float)nss * (1.f / 16777216.f) * (1.f / DM) + NORM_EPS);
        { const int tn_ = t + F.GW < T_TOK ? t + F.GW : t; GT_PREF(tn_); }
        float y[32];
#pragma unroll
        for (int i = 0; i < 32; ++i) y[i] = 0.f;
        { int k0 = id0 * 128 + lane, k1 = id1 * 128 + 64 + lane; float g0 = gg0, g1 = gg1; const bool up32 = lane >= 32;
#define GS_CE(M, UP0, UP1) { const int q0 = xchg_i<M>(k0, up32), q1 = xchg_i<M>(k1, up32); const float h0 = xchg_f<M>(g0, up32), h1 = xchg_f<M>(g1, up32); const bool lo_ = (lane & M) == 0; \
            const bool t0 = (lo_ == (UP0)) ? (q0 < k0) : (q0 > k0), t1 = (lo_ == (UP1)) ? (q1 < k1) : (q1 > k1); \
            k0 = t0 ? q0 : k0; g0 = t0 ? h0 : g0; k1 = t1 ? q1 : k1; g1 = t1 ? h1 : g1; }
#define GS_UP(K) ((lane & (K)) == 0)
          GS_CE(1, GS_UP(2), GS_UP(2))
          GS_CE(2, GS_UP(4), GS_UP(4)) GS_CE(1, GS_UP(4), GS_UP(4))
          GS_CE(4, GS_UP(8), GS_UP(8)) GS_CE(2, GS_UP(8), GS_UP(8)) GS_CE(1, GS_UP(8), GS_UP(8))
          GS_CE(8, GS_UP(16), GS_UP(16)) GS_CE(4, GS_UP(16), GS_UP(16)) GS_CE(2, GS_UP(16), GS_UP(16)) GS_CE(1, GS_UP(16), GS_UP(16))
          GS_CE(16, GS_UP(32), GS_UP(32)) GS_CE(8, GS_UP(32), GS_UP(32)) GS_CE(4, GS_UP(32), GS_UP(32)) GS_CE(2, GS_UP(32), GS_UP(32)) GS_CE(1, GS_UP(32), GS_UP(32))
          GS_CE(32, true, false) GS_CE(16, true, false) GS_CE(8, true, false) GS_CE(4, true, false) GS_CE(2, true, false) GS_CE(1, true, false)
          { const bool sw = k0 > k1; const int tk = sw ? k1 : k0; k1 = sw ? k0 : k1; k0 = tk; const float tg = sw ? g1 : g0; g1 = sw ? g0 : g1; g0 = tg; }
          GS_CE(32, true, true) GS_CE(16, true, true) GS_CE(8, true, true) GS_CE(4, true, true) GS_CE(2, true, true) GS_CE(1, true, true)
#undef GS_CE
#undef GS_UP
          id0 = k0 >> 7; id1 = k1 >> 7; gg0 = g0; gg1 = g1; }
        for (int g = 0; g < 32; ++g) {
            const int src = (g & 15) * 4; const int idv = g < 16 ? id0 : id1; const float ggv = g < 16 ? gg0 : gg1;
            int e[4]; int gt[4];
#pragma unroll
            for (int k = 0; k < 4; ++k) { e[k] = __builtin_amdgcn_readlane(idv, src + k); gt[k] = __builtin_amdgcn_readlane(__float_as_int(ggv), src + k); }
            float us[4], vs[4]; float d[4];
#if XFMT == 4
            u32x4 ur[4], vr[4];
#pragma unroll
            for (int k = 0; k < 4; ++k) { ur[k] = ldg<u32x4>(U + (size_t)e[k] * XROW + lane * 16); us[k] = ldg<float>(USC + e[k]); }
#pragma unroll
            for (int k = 0; k < 4; ++k) { vr[k] = ldg<u32x4>(V + (size_t)e[k] * XROW + lane * 16); vs[k] = ldg<float>(VSC + e[k]); }
#pragma unroll
            for (int k = 0; k < 4; ++k) { f32x2 s2 = {0.f, 0.f};
#pragma unroll
                for (int dd = 0; dd < 4; ++dd) {
#define D4(b) { const f32x2 r = __builtin_amdgcn_cvt_scalef32_pk_f32_fp4(ur[k][dd], 1.0f, b); s2 = (f32x2){x[8 * dd + 2 * (b)], x[8 * dd + 2 * (b) + 1]} * r + s2; }
                    D4(0) D4(1) D4(2) D4(3)
#undef D4
                }
                d[k] = s2[0] + s2[1]; }
#else
            u32x2 ur[4][3], vr[4][3];
#pragma unroll
            for (int k = 0; k < 4; ++k) {
#pragma unroll
                for (int c = 0; c < 3; ++c) ur[k][c] = ldg<u32x2>(U + (size_t)e[k] * XROW + lane * 24 + c * 8);
                us[k] = ldg<float>(USC + e[k]); }
#pragma unroll
            for (int k = 0; k < 4; ++k) {
#pragma unroll
                for (int c = 0; c < 3; ++c) vr[k][c] = ldg<u32x2>(V + (size_t)e[k] * XROW + lane * 24 + c * 8);
                vs[k] = ldg<float>(VSC + e[k]); }
#pragma unroll
            for (int k = 0; k < 4; ++k) { const f32x32 uf = __builtin_amdgcn_cvt_scalef32_pk32_f32_fp6((u32x6){ur[k][0][0], ur[k][0][1], ur[k][1][0], ur[k][1][1], ur[k][2][0], ur[k][2][1]}, 1.0f);
                float s = 0.f;
#pragma unroll
                for (int q = 0; q < 32; ++q) s = fmaf(x[q], uf[q], s);
                d[k] = s; }
#endif
            float k0 = b5 ? d[2] : d[0], k1 = b5 ? d[3] : d[1];
            const float s0 = b5 ? d[0] : d[2], s1 = b5 ? d[1] : d[3];
            k0 += shx32(s0, b5); k1 += shx32(s1, b5);
            float kept = b4 ? k1 : k0; const float snd = b4 ? k0 : k1;
            kept += shx<16>(snd);
            kept += shx<8>(kept); kept += shx<4>(kept); kept += shx<2>(kept); kept += shx<1>(kept);
            const float ga = __int_as_float(b5 ? (b4 ? gt[3] : gt[2]) : (b4 ? gt[1] : gt[0]));
            const float usel = b5 ? (b4 ? us[3] : us[2]) : (b4 ? us[1] : us[0]);
            const float vsel = b5 ? (b4 ? vs[3] : vs[2]) : (b4 ? vs[1] : vs[0]);
            const float w = ga * gelu_exact(kept * usel * rs_t) * vsel;
            float wk[4];
#pragma unroll
            for (int k = 0; k < 4; ++k) wk[k] = __int_as_float(__builtin_amdgcn_readlane(__float_as_int(w), k * 16));
#if XFMT == 4
#pragma unroll
            for (int k = 0; k < 4; ++k)
#pragma unroll
                for (int dd = 0; dd < 4; ++dd) {
#define D4(b) { const f32x2 r = __builtin_amdgcn_cvt_scalef32_pk_f32_fp4(vr[k][dd], 1.0f, b); y[8 * dd + 2 * (b)] = fmaf(wk[k], r[0], y[8 * dd + 2 * (b)]); y[8 * dd + 2 * (b) + 1] = fmaf(wk[k], r[1], y[8 * dd + 2 * (b) + 1]); }
                    D4(0) D4(1) D4(2) D4(3)
#undef D4
                }
#else
#pragma unroll
            for (int k = 0; k < 4; ++k) { const f32x32 vf = __builtin_amdgcn_cvt_scalef32_pk32_f32_fp6((u32x6){vr[k][0][0], vr[k][0][1], vr[k][1][0], vr[k][1][1], vr[k][2][0], vr[k][2][1]}, 1.0f);
#pragma unroll
                for (int q = 0; q < 32; ++q) y[q] = fmaf(wk[k], vf[q], y[q]); }
#endif
        }
        float ss = 0.f;
#pragma unroll
        for (int i = 0; i < 32; ++i) { y[i] += x[i]; ss += y[i] * y[i]; }
        if (!nxt_bf) {
#pragma unroll
            for (int i = 0; i < 8; ++i) stg_nt<f32x4>(xout + (size_t)t * DM + i * 256 + lane * 4, (f32x4){y[i * 4 + 0], y[i * 4 + 1], y[i * 4 + 2], y[i * 4 + 3]});
        } else {
            ss = wave_sum(ss); const float rstd = rsqrtf(ss * (1.f / DM) + NORM_EPS);
            bf16_t* Hn = (bf16_t*)(F.ws + WS_H); float* LOGF = (float*)(F.ws + WS_LOGF);
#pragma unroll
            for (int i = 0; i < 8; ++i) stg<u32x2>(Hn + (size_t)t * DM + i * 256 + lane * 4, (u32x2){cvtpk(y[i * 4 + 0], y[i * 4 + 1]), cvtpk(y[i * 4 + 2], y[i * 4 + 3])});
            float am = 1e-30f;
#pragma unroll
            for (int i = 0; i < 32; ++i) am = fmaxf(am, fabsf(y[i]));
            am = wave_max(am); const float inv = 127.0f / am;
#pragma unroll
            for (int i = 0; i < 8; ++i) stg<unsigned>(F.ws + WS_H8 + (size_t)t * DM + i * 256 + lane * 4, q8x4(y[i * 4 + 0], y[i * 4 + 1], y[i * 4 + 2], y[i * 4 + 3], inv));
            if (lane == 0) stg<float>(LOGF + t * 8 + 5, rstd * am * (1.0f / 127.0f));
#pragma unroll 1
            for (int c5 = 0; c5 < 5; ++c5) { float d = 0.f;
#pragma unroll
                for (int i = 0; i < 8; ++i) { const f32x4 wv = *(const f32x4*)(wfl + c5 * 2048 + i * 256 + lane * 4);
                    d += y[i * 4 + 0] * wv[0] + y[i * 4 + 1] * wv[1] + y[i * 4 + 2] * wv[2] + y[i * 4 + 3] * wv[3]; }
                d = wave_sum(d) * rstd;
                if (lane == 0) { const float z = d + ldg<float>(nxt_bf + c5); stg<float>(LOGF + t * 8 + c5, fminf(z, 0.f) - log1pf(__expf(-fabsf(z)))); } }
        }
    }
}

#ifdef DUP_PH
constexpr int NSEQ_TOTAL = 1 + 9 * DEPTH;
#else
constexpr int NSEQ_TOTAL = 1 + 8 * DEPTH;
#endif
#ifndef ONLY_PH
#define PHSEL(k) (ph == (k))
#else
#define PHSEL(k) (ONLY_PH == (k) && ph == (k))
#endif
__global__ void __launch_bounds__(512, 2) mega_fwd(const Args args) {
    extern __shared__ __attribute__((aligned(16))) unsigned char lds[];
    cg::grid_group grid = cg::this_grid();
    LAS unsigned char* ldsl = (LAS unsigned char*)lds;
    if (threadIdx.x == 0) { LAS unsigned long long* la = (LAS unsigned long long*)(ldsl + ARG_OFF);
#pragma unroll
        for (int j = 0; j < 25; ++j) la[j] = (unsigned long long)(uintptr_t)args.in[j];
        la[25] = (unsigned long long)(uintptr_t)args.out; la[26] = (unsigned long long)(uintptr_t)args.ws;
        la[64] = 0ull;
#pragma unroll
        for (int j = 0; j < 16; ++j) la[27 + j] = (unsigned long long)__double_as_longlong(args.invrev[j]); }
    __syncthreads();
    const int ph_lo = args.ph_lo, ph_hi = args.ph_hi;
    (void)xcd_barrier_post((unsigned*)(args.ws + WS_CTL + 4096), (volatile LAS unsigned*)(ldsl + ARG_OFF + 512));
    for (int p = ph_lo; p < ph_hi; ++p) {
        asm volatile("" ::: "memory");
#define FRAME() Frame F; { int tid_ = threadIdx.x; asm volatile("" : "+v"(tid_)); int bid_ = blockIdx.x; asm volatile("" : "+s"(bid_)); \
        F.tid = tid_; F.lane = F.tid & 63; F.wave = __builtin_amdgcn_readfirstlane(F.tid >> 6); F.G = gridDim.x; F.bid = bid_; F.lds = lds; F.ws = ws; F.gw = F.bid * 8 + F.wave; F.GW = F.G * 8; }
        unsigned char* ws; { Frame F0; F0.lds = lds; ws = (unsigned char*)arg_in(F0, 26); }
        Frame FA; FA.lds = lds;
        int pp_ = p; asm volatile("" : "+s"(pp_));
#ifdef DUP_PH
        const int l = pp_ < 1 ? 0 : (pp_ - 1) / 9; int k_ = pp_ < 1 ? -1 : (pp_ - 1) - l * 9;
        bool dup2 = false; { constexpr int pos = DUP_PH < 7 ? DUP_PH - 1 : (DUP_PH == 8 ? 6 : 7); dup2 = (k_ == pos + 1); if (k_ > pos) --k_; }
#else
        const int l = pp_ < 1 ? 0 : (pp_ - 1) / 8; const int k_ = pp_ < 1 ? -1 : (pp_ - 1) - l * 8;
#endif
        const int ph = pp_ == 0 ? 0 : (k_ < 6 ? k_ + 1 : (k_ == 6 ? 8 : 10));
        const unsigned char* wl = ws + WS_W0 + (size_t)l * WL_SIZE;
        float* xout = (float*)arg_in(FA, 25);
        if (PHSEL(0)) {
            FRAME();
            phase_convert(F);
            __syncthreads();
            { FRAME(); phase_norm(F, arg_in(FA, I_X), arg_in(FA, I_BFORGET), arg_in(FA, I_WIN), arg_in(FA, I_NORM1)); }
        } else if (PHSEL(1)) {
            FRAME();
            SchedPlain S; S.ord.init(T_TOK, 12288, F.G, F.bid); S.A = (const char*)(ws + WS_H8); S.Bt = (const char*)(wl + WO_WIN8); S.arow = (size_t)256 * 2048; S.brow = (size_t)256 * 2048;
            for (int i_ = F.bid * 512 + F.tid; i_ < 10 * 16 * 128; i_ += F.G * 512) stg<int>((int*)(ws + WS_KSUM) + i_, 0);
            EpiProj E{(bf16_t*)(ws + WS_PROJ), (bf16_t*)(ws + WS_GATES), arg_in(FA, I_BGATE) + (size_t)l * 3 * DM, ws, (const float*)(ws + WS_LOGF) + 5, (const float*)(wl + WO_WSC)};
#if defined(DUP_PH) && defined(DUP_DRY)
            E.dry = dup2;
#endif
#ifdef STAGGER
            { const int d_ = (F.bid >> 3) & 3; for (int i_ = 0; i_ < d_ * STAGGER; ++i_) __builtin_amdgcn_s_sleep(127); }
#endif
            pg8::gemm_phase<EpiProj, SchedPlain, 2>(ldsl, 2048, 2048, 2048, S, E);
        } else if (PHSEL(2)) {
            FRAME();
            phase_prep(F, l);
        } else if (PHSEL(3)) {
            FRAME();
            phase_attention(F, pp_, arg_in(FA, I_CQN) + l * 128, arg_in(FA, I_CKN) + l * 128);
        } else if (PHSEL(4)) {
            FRAME();
            phase_postA(F, l);
        } else if (PHSEL(5)) {
            FRAME();
            SchedMerge S; S.ord.init(T_TOK, 2048, F.G, F.bid); S.Y = (const char*)(ws + WS_YCAT); S.W = (const char*)(wl + WO_WBR_T);
            EpiMerge E{(bf16_t*)(ws + WS_MERGED), (const bf16_t*)(ws + WS_GATES)};
            pg8::gemm_phase<EpiMerge, SchedMerge>(ldsl, 2048, 768, 768, S, E);
        } else if (PHSEL(6)) {
            FRAME();
            SchedPlain S; S.ord.init(T_TOK, 2048, F.G, F.bid); S.A = (const char*)(ws + WS_MERGED); S.Bt = (const char*)(wl + WO_WOUT_T); S.arow = (size_t)256 * 2048; S.brow = (size_t)256 * 2048;
            EpiRes3 E{(bf16_t*)(ws + WS_HG), arg_in(FA, I_X), l == 0 ? nullptr : (const bf16_t*)(ws + WS_H), (unsigned long long*)(ws + WS_ROWSS), ws + WS_HG8};
            pg8::gemm_phase<EpiRes3, SchedPlain, 1>(ldsl, 2048, 2048, 2048, S, E);
        } else if (PHSEL(8)) {
            FRAME();
            if (QF8_LAYER(l)) {
                SchedPlain S; S.ord.init(T_TOK, 2048, F.G, F.bid); S.A = (const char*)(ws + WS_HG8); S.Bt = (const char*)(wl + WO_WQ_T); S.arow = (size_t)256 * 2048; S.brow = (size_t)256 * 2048;
                EpiBf16S E{(bf16_t*)(ws + WS_QP), 2048, (const unsigned long long*)(ws + WS_ROWSS), 1.0f / (X8_SCALE * WO8_SCALE)};
                pg8::gemm_phase<EpiBf16S, SchedPlain, 1>(ldsl, 2048, 2048, 2048, S, E);
            } else {
                SchedPlain S; S.ord.init(T_TOK, 2048, F.G, F.bid); S.A = (const char*)(ws + WS_HG); S.Bt = (const char*)(wl + WO_WQ_T); S.arow = (size_t)256 * 2048 * 2; S.brow = (size_t)256 * 2048 * 2;
                EpiBf16S E{(bf16_t*)(ws + WS_QP), 2048, (const unsigned long long*)(ws + WS_ROWSS), 1.0f};
                pg8::gemm_phase<EpiBf16S, SchedPlain>(ldsl, 2048, 2048, 2048, S, E);
            }
            __builtin_amdgcn_fence(__ATOMIC_ACQUIRE, "agent");
            { FRAME(); phase_topk(F, wl); }
        } else if (PHSEL(10)) {
            FRAME();
            const bool more = l + 1 < DEPTH;
            phase_gather(F, nullptr, xout, wl, nullptr, more ? arg_in(FA, I_BFORGET) + (l + 1) * 5 : nullptr, more ? (const float*)(wl + WL_SIZE + WO_WF) : nullptr);
        }
        if (p + 1 < ph_hi) { if (p == ph_lo) grid.sync();
            else { XcdBarrier xb; xb.bar = (unsigned*)(ws + WS_CTL + 4096); xb.x = xb_xcc_id(); int so = ARG_OFF + 512; asm volatile("" : "+v"(so)); xb.st = (volatile LAS unsigned*)(ldsl + so); xcd_barrier(xb); } }
    }
}

#ifndef MK_PER_PHASE
#define MK_PER_PHASE 0
#endif
extern "C" void kernel_launch(void* const* d_in, const int* in_sizes, int n_in, void* d_out, int out_size, void* d_ws, size_t ws_size, hipStream_t stream) {
    static int grid = 0;
    if (grid == 0) {
        if (n_in != 25 || in_sizes[0] != T_TOK * DM || out_size != T_TOK * DM || ws_size < WS_END) {
            fprintf(stderr, "kernel_launch: unexpected shapes: n_in %d in0 %d out %d ws %zu (need %zu)\n", n_in, n_in > 0 ? in_sizes[0] : -1, out_size, ws_size, (size_t)WS_END); grid = -1; return; }
        int dev = 0, cus = 0, per_cu = 0;
        if (hipGetDevice(&dev) != hipSuccess || hipDeviceGetAttribute(&cus, hipDeviceAttributeMultiprocessorCount, dev) != hipSuccess) { grid = -1; return; }
        if (hipFuncSetAttribute((const void*)mega_fwd, hipFuncAttributeMaxDynamicSharedMemorySize, LDS_BYTES) != hipSuccess) { fprintf(stderr, "kernel_launch: hipFuncSetAttribute failed\n"); grid = -1; return; }
        if (hipOccupancyMaxActiveBlocksPerMultiprocessor(&per_cu, (const void*)mega_fwd, 512, LDS_BYTES) != hipSuccess || per_cu < 1) { fprintf(stderr, "kernel_launch: occupancy query says %d blocks per CU\n", per_cu); grid = -1; return; }
        (void)hipGetLastError();
        grid = cus;
    }
    if (grid < 0) return;
    (void)hipMemsetAsync((char*)d_ws + WS_CTL, 0, 32768, stream);
    Args a{};
    for (int i = 0; i < 25; ++i) a.in[i] = (const float*)d_in[i];
    a.out = (float*)d_out; a.ws = (unsigned char*)d_ws;
    for (int j = 0; j < 16; ++j) a.invrev[j] = pow(500000.0, -(double)j / 16.0) / 6.283185307179586476925286766559;
    const int total = NSEQ_TOTAL;
#if MK_PER_PHASE
    for (int p = 0; p < total; ++p) { a.ph_lo = p; a.ph_hi = p + 1; void* kargs[] = {&a};
        hipError_t e = hipLaunchCooperativeKernel((const void*)mega_fwd, dim3(grid), dim3(512), kargs, LDS_BYTES, stream);
        if (e != hipSuccess) { fprintf(stderr, "kernel_launch: launch %d failed: %s\n", p, hipGetErrorString(e)); break; } }
#else
    a.ph_lo = 0; a.ph_hi = total; void* kargs[] = {&a};
    hipError_t e = hipLaunchCooperativeKernel((const void*)mega_fwd, dim3(grid), dim3(512), kargs, LDS_BYTES, stream);
    if (e != hipSuccess) fprintf(stderr, "kernel_launch: cooperative launch failed: %s (grid %d)\n", hipGetErrorString(e), grid);
#endif
}
```

```cpp
#define XFMT 4
#define QF8_MASK 2
#define MF8_MASK 2
#include <hip/hip_runtime.h>
#include <hip/hip_cooperative_groups.h>
#include <cstdio>
#include <cstdint>
#include <cmath>
namespace cg = cooperative_groups;

#define LAS __attribute__((address_space(3)))
typedef unsigned short bf16_t;
typedef short bf16x8 __attribute__((ext_vector_type(8)));
typedef short s16x4 __attribute__((ext_vector_type(4)));
typedef float f32x2 __attribute__((ext_vector_type(2)));
typedef float f32x4 __attribute__((ext_vector_type(4)));
typedef float f32x16 __attribute__((ext_vector_type(16)));
typedef unsigned u32x2 __attribute__((ext_vector_type(2)));
typedef unsigned u32x4 __attribute__((ext_vector_type(4)));
typedef __bf16 bf16v2 __attribute__((ext_vector_type(2)));
typedef float f32x32 __attribute__((ext_vector_type(32)));
typedef unsigned u32x6 __attribute__((ext_vector_type(6)));
#ifndef XFMT
#define XFMT 6
#endif
constexpr int XROW = XFMT == 6 ? 1536 : 1024;
constexpr int XLB = XROW / 64;

constexpr int T_TOK = 8192, DM = 2048, SEQ = 4096, NBATCH = 2, DEPTH = 2, INCOLS = 12293;
constexpr int PQ = 6144;
constexpr float NORM_EPS = 1e-6f;
constexpr float LOG2E = 1.4426950408889634f;
#ifndef QF8_MASK
#define QF8_MASK 3
#endif
#define QF8_LAYER(l_) (((QF8_MASK) >> (l_)) & 1)
#ifndef MF8_MASK
#define MF8_MASK 0
#endif
#define MF8_LAYER(l_) (((MF8_MASK) >> (l_)) & 1)
constexpr float Y8_SCALE = 8.0f;
constexpr float X8_SCALE = 4.0f;
constexpr float M8_SCALE = 16.0f, WO8_SCALE = 128.0f;

constexpr size_t AL(size_t x) { return (x + 255) & ~(size_t)255; }
constexpr size_t WS_CTL = 0;
constexpr size_t WO_WIN_T = 0;
constexpr size_t WO_WBR_T = WO_WIN_T + AL((size_t)12288 * 2048 * 2);
constexpr size_t WO_WOUT_T = WO_WBR_T + AL((size_t)3 * 2048 * 768 * 2);
constexpr size_t WO_WQ_T = WO_WOUT_T + AL((size_t)2048 * 2048 * 2);
constexpr size_t WO_SK = WO_WQ_T + AL((size_t)2048 * 2048 * 2);
constexpr size_t WO_U = WO_SK + AL((size_t)8 * 2 * 128 * 128 * 2);
constexpr size_t WO_V = WO_U + AL((size_t)16384 * 2048);
constexpr size_t WO_WF = WO_V + AL((size_t)16384 * 2048);
constexpr size_t WO_USC = WO_WF + AL((size_t)8 * 2048 * 4);
constexpr size_t WO_VSC = WO_USC + AL((size_t)16384 * 4);
constexpr size_t WO_WIN8 = WO_VSC + AL((size_t)16384 * 4);
constexpr size_t WO_WSC = WO_WIN8 + AL((size_t)12288 * 2048);
constexpr size_t WL_SIZE = WO_WSC + AL((size_t)12288 * 4);
constexpr size_t WS_W0 = 65536;
constexpr size_t WS_XA = WS_W0 + DEPTH * WL_SIZE;
constexpr size_t WS_H8 = WS_XA;
constexpr size_t WS_XB = WS_XA + AL((size_t)T_TOK * DM * 4);
constexpr size_t WS_HG8 = WS_XB;
constexpr size_t WS_H = WS_XB + AL((size_t)T_TOK * DM * 4);
constexpr size_t WS_PROJ = WS_H + AL((size_t)T_TOK * DM * 2);
constexpr size_t WS_MERGED = WS_PROJ;
constexpr size_t WS_QP = WS_MERGED + AL((size_t)T_TOK * DM * 2);
constexpr size_t WS_HG = WS_QP + AL((size_t)T_TOK * DM * 2);
constexpr size_t WS_GATES = WS_PROJ + AL((size_t)T_TOK * PQ * 2);
constexpr size_t WS_LOGF = WS_GATES + AL((size_t)T_TOK * PQ * 2);
constexpr size_t WS_QA = WS_LOGF + AL((size_t)T_TOK * 8 * 4);
constexpr size_t WS_KA = WS_QA + AL((size_t)2 * 12 * 4096 * 128 * 2);
constexpr size_t WS_VA = WS_KA + AL((size_t)2 * 12 * 4096 * 128 * 2);
constexpr size_t WS_QB = WS_VA + AL((size_t)2 * 6 * 4096 * 128 * 2);
constexpr size_t SZ_H5 = AL((size_t)2 * 5 * 4096 * 128 * 2);
constexpr size_t WS_KB = WS_QB + SZ_H5;
constexpr size_t WS_VB = WS_KB + SZ_H5;
constexpr size_t WS_QC = WS_VB + SZ_H5;
constexpr size_t WS_KC = WS_QC + SZ_H5;
constexpr size_t WS_VC = WS_KC + SZ_H5;
constexpr size_t WS_CB = WS_VC + SZ_H5;
constexpr size_t WS_OA = WS_CB + AL((size_t)2 * 5 * 4096 * 4);
constexpr size_t WS_YCAT = WS_OA + AL((size_t)2 * T_TOK * 768 * 2);
constexpr size_t WS_PIDX = WS_YCAT + AL((size_t)T_TOK * DM * 2);
constexpr size_t WS_PGATE = WS_PIDX + AL((size_t)T_TOK * 128 * 4);
constexpr size_t WS_ROWSS = WS_PGATE + AL((size_t)T_TOK * 128 * 4);
constexpr size_t WS_KSUM = WS_ROWSS + AL((size_t)T_TOK * 8);
constexpr size_t WS_END = WS_KSUM + AL((size_t)10 * 16 * 128 * 4);
static_assert(3 * AL((size_t)T_TOK * DM * 2) <= AL((size_t)T_TOK * PQ * 2), "aliases fit in PROJ");

constexpr int LDS_BYTES = 159744 + 1024;

__device__ __forceinline__ int lane_id_() { return (int)__builtin_amdgcn_mbcnt_hi(~0u, __builtin_amdgcn_mbcnt_lo(~0u, 0u)); }
__device__ __forceinline__ int tid_of(int wid) { int t = wid * 64 + lane_id_(); asm volatile("" : "+v"(t)); return t; }
#define GAS __attribute__((address_space(1)))
template <class T> __device__ __forceinline__ T ldg(const void* p) { return *(const GAS T*)p; }
template <class T> __device__ __forceinline__ void stg(void* p, const T v) { *(GAS T*)p = v; }
template <class T> __device__ __forceinline__ T ldg_nt(const void* p) { return __builtin_nontemporal_load((const GAS T*)p); }
template <class T> __device__ __forceinline__ void stg_nt(void* p, const T v) { __builtin_nontemporal_store(v, (GAS T*)p); }
__device__ __forceinline__ u32x4 zero4() { unsigned z = 0u; asm volatile("" : "+v"(z)); return (u32x4){z, z, z, z}; }
__device__ __forceinline__ unsigned cvtpk(float lo, float hi) { unsigned r; asm volatile("v_cvt_pk_bf16_f32 %0, %1, %2" : "=v"(r) : "v"(lo), "v"(hi)); return r; }
__device__ __forceinline__ float bflo(unsigned u) { return __uint_as_float(u << 16); }
__device__ __forceinline__ float bfhi(unsigned u) { return __uint_as_float(u & 0xffff0000u); }
__device__ __forceinline__ bf16x8 pack8(f32x4 a, f32x4 b) {
    u32x4 w = {cvtpk(a[0], a[1]), cvtpk(a[2], a[3]), cvtpk(b[0], b[1]), cvtpk(b[2], b[3])};
    return *reinterpret_cast<bf16x8*>(&w);
}
template <int M> __device__ __forceinline__ float shx(float v) { static_assert(M >= 1 && M < 32, "xor mask"); return __int_as_float(__builtin_amdgcn_ds_swizzle(__float_as_int(v), (M << 10) | 0x1f)); }
__device__ __forceinline__ float shx32(float v, bool upper) { auto rr = __builtin_amdgcn_permlane32_swap(__float_as_uint(v), __float_as_uint(v), false, false); return __uint_as_float(upper ? rr[0] : rr[1]); }
__device__ __forceinline__ float sum32(float v) { auto rr = __builtin_amdgcn_permlane32_swap(__float_as_uint(v), __float_as_uint(v), false, false); return __uint_as_float(rr[0]) + __uint_as_float(rr[1]); }
__device__ __forceinline__ float wave_sum(float v) {
    v += shx<1>(v); v += shx<2>(v); v += shx<4>(v); v += shx<8>(v); v += shx<16>(v);
    return sum32(v);
}
__device__ __forceinline__ float sigmoidf_(float x) { return __builtin_amdgcn_rcpf(1.f + __expf(-x)); }
__device__ __forceinline__ float gelu_exact(float v) {
    const float av = fabsf(v), d = av * 0.2316418882f + 1.0f;
    const float t = __builtin_amdgcn_rcpf(d);
    float q = t * 0.5307027145f + (-0.7265760135f); q = q * t + 0.7107068705f; q = q * t + (-0.142248368f); q = q * t + 0.127414796f; q = q * t;
    const float e = __builtin_amdgcn_exp2f((v * v) * (-0.72134752044f));
    const float m = v * (q * e);
    return v < 0.f ? m : v - m;
}

__device__ __forceinline__ unsigned q8x4(float a, float b, float c, float d, float inv) {
    const unsigned ua = __float_as_uint(fmaf(a, inv, 12582912.0f)), ub = __float_as_uint(fmaf(b, inv, 12582912.0f)), uc = __float_as_uint(fmaf(c, inv, 12582912.0f)), ud = __float_as_uint(fmaf(d, inv, 12582912.0f));
    return __builtin_amdgcn_perm(ub, ua, 0x0c0c0400u) | __builtin_amdgcn_perm(ud, uc, 0x04000c0cu);
}
__device__ __forceinline__ float wave_max(float v) {
    v = fmaxf(v, shx<1>(v)); v = fmaxf(v, shx<2>(v)); v = fmaxf(v, shx<4>(v)); v = fmaxf(v, shx<8>(v)); v = fmaxf(v, shx<16>(v));
    auto rr = __builtin_amdgcn_permlane32_swap(__float_as_uint(v), __float_as_uint(v), false, false); return fmaxf(__uint_as_float(rr[0]), __uint_as_float(rr[1]));
}

namespace pg8 {
constexpr int BM = 256, BK = 64, HALF = 128, HTB = HALF * BK * 2, STAGE_BYTES = 8 * HTB, NXCD = 8, WGM = 8;
__device__ __forceinline__ int lds_byte(int r, int c) { const int st = (r >> 4) * 2 + (c >> 5), rr = r & 15, cc = c & 31, ob = rr * 64 + cc * 2; return st * 1024 + (ob ^ (((ob >> 9) & 1) << 5)); }
__device__ __forceinline__ void stage_rc(int b, int& R, int& C) { const int st = b / 1024, sb = b % 1024, swz = sb ^ (((sb >> 9) & 1) << 5); R = (st >> 1) * 16 + swz / 64; C = (st & 1) * 32 + (swz % 64) / 2; }
__device__ __forceinline__ int perm32(int rho) { const int n = rho >> 4, i = rho & 15; return 8 * (i >> 2) + 4 * n + (i & 3); }

typedef int i32x8 __attribute__((ext_vector_type(8)));
typedef int i32x4 __attribute__((ext_vector_type(4)));
typedef short s16x16 __attribute__((ext_vector_type(16)));
__device__ __forceinline__ i32x8 cat8(bf16x8 lo, bf16x8 hi) { return __builtin_bit_cast(i32x8, __builtin_shufflevector(lo, hi, 0, 1, 2, 3, 4, 5, 6, 7, 8, 9, 10, 11, 12, 13, 14, 15)); }
constexpr int F8SC = 0x7f7f7f7f;
struct Unit { const char* a; const char* b; int pm, pn, aux, nt = 0; };

template <class Epi> __device__ __forceinline__ auto epi_keep(const Epi& e, const Unit& u, int) -> decltype(e.keep(u)) { return e.keep(u); }
template <class Epi> __device__ __forceinline__ bool epi_keep(const Epi&, const Unit&, long) { return false; }
struct TileOrder {
    int nM, nN, nwg, G, c;
    __device__ void init(int M, int N, int G_, int c_) { nM = M / BM; nN = N / BM; nwg = nM * nN; G = G_; c = c_; }
    __device__ bool tile(int i, int& pm, int& pn) const {
        const long L = (long)i * G + c; if (L >= nwg) return false;
        int wgid = (int)L; { const int q = nwg / NXCD, r = nwg % NXCD, xcd = wgid % NXCD, off = wgid / NXCD; wgid = (xcd < r ? xcd * (q + 1) : r * (q + 1) + (xcd - r) * q) + off; }
        const int nig = WGM * nN, gid = wgid / nig, fm = gid * WGM, gsz = (nM - fm) < WGM ? (nM - fm) : WGM;
        pm = fm + ((wgid % nig) % gsz); pn = (wgid % nig) / gsz; return true;
    }
};

template <class Epi, class Sched, int MODE = 0>
__device__ __forceinline__ void gemm_phase(LAS unsigned char* lds, const int lda, const int ldb, const int K, const Sched& S, const Epi& E) {
    int tid = threadIdx.x; asm volatile("" : "+v"(tid));
    const int wid = __builtin_amdgcn_readfirstlane(tid >> 6), lane = tid & 63, wr = wid >> 2, wc = wid & 3, fr = lane & 15, fq = lane >> 4;
    constexpr bool F8 = MODE == 1;
    constexpr int EB = MODE ? 1 : 2;
    const int nt = K / (MODE ? 128 : BK);
    unsigned voffA[2], voffB[2];
#pragma unroll
    for (int i = 0; i < 2; ++i) { int R, C; stage_rc(tid * 16 + i * 8192, R, C); const int Rb = Epi::PERM ? ((R & ~31) + perm32(R & 31)) : R;
        voffA[i] = (unsigned)(R * lda * EB + C * 2); voffB[i] = (unsigned)(Rb * ldb * EB + C * 2); }
    const size_t kstep = (size_t)(BK * 2);
    const size_t hstepA = (size_t)HALF * lda * EB, hstepB = (size_t)HALF * ldb * EB;
    const unsigned ldsw = (unsigned)wid * 1024u;
    const int fcol = F8 ? ((fq >> 1) * 32 + (fq & 1) * 16) : fq * 8;
    constexpr int KOFF = F8 ? 16 : 1024;
    const int aoff = lds_byte(wr * 64 + fr, fcol), boff = lds_byte(wc * 32 + fr, fcol);
#define PG8_SA(b, h) (((b) * 2 + (h)) * HTB)
#define PG8_SB(b, h) ((4 + (b) * 2 + (h)) * HTB)
#define PG8_STAGE(bufoff, gbase, voff) do { _Pragma("unroll") for (int _i = 0; _i < 2; ++_i) \
        __builtin_amdgcn_global_load_lds((const unsigned*)((const char*)(gbase) + (voff)[_i]), (LAS unsigned*)(lds + (bufoff) + ldsw + _i * 8192), 16, 0, 0); } while (0)
#define PG8_LDA(dst, b, h) do { _Pragma("unroll") for (int m = 0; m < 4; ++m) _Pragma("unroll") for (int k = 0; k < 2; ++k) dst[m][k] = *(const LAS bf16x8*)(lds + PG8_SA(b, h) + aoff + m * 2048 + k * KOFF); } while (0)
#define PG8_LDB(dst, b, h) do { _Pragma("unroll") for (int n = 0; n < 2; ++n) _Pragma("unroll") for (int k = 0; k < 2; ++k) dst[n][k] = *(const LAS bf16x8*)(lds + PG8_SB(b, h) + boff + n * 2048 + k * KOFF); } while (0)
#define PG8_MMA(ai, bj, At, Bt) do { __builtin_amdgcn_s_setprio(1); _Pragma("unroll") for (int m = 0; m < 4; ++m) _Pragma("unroll") for (int n = 0; n < 2; ++n) { \
        if constexpr (F8) { const i32x8 b8_ = cat8(Bt[n][0], Bt[n][1]), a8_ = cat8(At[m][0], At[m][1]); \
            asm volatile("s_nop 1\n\tv_mfma_f32_16x16x128_f8f6f4 %0, %1, %2, %0" : "+v"(acc[ai][bj][m][n]) : "v"(b8_), "v"(a8_)); } \
        else if constexpr (MODE == 2) { _Pragma("unroll") for (int k = 0; k < 2; ++k) acc[ai][bj][m][n] = __builtin_bit_cast(f32x4, __builtin_amdgcn_mfma_i32_16x16x64_i8(__builtin_bit_cast(i32x4, Bt[n][k]), __builtin_bit_cast(i32x4, At[m][k]), __builtin_bit_cast(i32x4, acc[ai][bj][m][n]), 0, 0, 0)); } \
        else { _Pragma("unroll") for (int k = 0; k < 2; ++k) acc[ai][bj][m][n] = __builtin_amdgcn_mfma_f32_16x16x32_bf16(Bt[n][k], At[m][k], acc[ai][bj][m][n], 0, 0, 0); } } __builtin_amdgcn_s_setprio(0); } while (0)
#define PG8_WAIT_V(n) asm volatile("s_waitcnt vmcnt(" #n ")" ::: "memory")
#define PG8_WAIT_L(n) asm volatile("s_waitcnt lgkmcnt(" #n ")" ::: "memory")
#define PG8_BAR __builtin_amdgcn_s_barrier()
#define PG8_SCHED __builtin_amdgcn_sched_barrier(0)
    Unit cur, nxt; int ui = 0;
    if (!S.next(0, cur)) return;
    f32x4 acc[2][2][4][2];
#pragma unroll
    for (int a = 0; a < 2; ++a)
#pragma unroll
        for (int b = 0; b < 2; ++b)
#pragma unroll
            for (int m = 0; m < 4; ++m)
#pragma unroll
                for (int n = 0; n < 2; ++n) acc[a][b][m][n] = (f32x4){0.f, 0.f, 0.f, 0.f};
    bf16x8 At[4][2], B0[2][2], B1[2][2];
    const char* cA = cur.a; const char* cB = cur.b;
    PG8_STAGE(PG8_SB(0, 0), cB, voffB); PG8_STAGE(PG8_SA(0, 0), cA, voffA); PG8_STAGE(PG8_SB(0, 1), cB + hstepB, voffB); PG8_STAGE(PG8_SA(0, 1), cA + hstepA, voffA);
    if (wr == 1) PG8_BAR;
    PG8_WAIT_V(4); PG8_BAR;
    PG8_STAGE(PG8_SB(1, 0), cB + kstep, voffB); PG8_STAGE(PG8_SA(1, 0), cA + kstep, voffA); PG8_STAGE(PG8_SB(1, 1), cB + hstepB + kstep, voffB);
    PG8_WAIT_V(6); PG8_BAR;
    for (;;) {
        const bool has_next = S.next(ui + 1, nxt);
        const char* nA = has_next ? nxt.a : cA; const char* nB = has_next ? nxt.b : cB;
        const int ntu = cur.nt ? cur.nt : nt;
        for (int t = 0; t < ntu; t += 2) {
            const bool last = (t == ntu - 2);
            const char* a1 = cA + (size_t)(t + 1) * kstep;
            const char* a2 = last ? nA : cA + (size_t)(t + 2) * kstep; const char* b2 = last ? nB : cB + (size_t)(t + 2) * kstep;
            const char* a3 = a2 + kstep; const char* b3 = b2 + kstep;
            PG8_LDB(B0, 0, 0); PG8_SCHED; PG8_LDA(At, 0, 0); PG8_STAGE(PG8_SA(1, 1), a1 + hstepA, voffA);
            PG8_WAIT_L(8); PG8_BAR; PG8_WAIT_L(0); PG8_MMA(0, 0, At, B0); PG8_BAR; PG8_SCHED;
            PG8_LDB(B1, 0, 1); PG8_STAGE(PG8_SB(0, 0), b2, voffB);
            PG8_BAR; PG8_WAIT_L(0); PG8_MMA(0, 1, At, B1); PG8_BAR;
            PG8_LDA(At, 0, 1); PG8_STAGE(PG8_SA(0, 0), a2, voffA);
            PG8_BAR; PG8_WAIT_L(0); PG8_MMA(1, 0, At, B0); PG8_BAR; PG8_SCHED;
            PG8_STAGE(PG8_SB(0, 1), b2 + hstepB, voffB);
            PG8_WAIT_V(6); PG8_BAR; PG8_MMA(1, 1, At, B1); PG8_BAR;
            PG8_LDB(B0, 1, 0); PG8_SCHED; PG8_LDA(At, 1, 0); PG8_STAGE(PG8_SA(0, 1), a2 + hstepA, voffA);
            PG8_WAIT_L(8); PG8_BAR; PG8_WAIT_L(0); PG8_MMA(0, 0, At, B0); PG8_BAR; PG8_SCHED;
            PG8_LDB(B1, 1, 1); PG8_STAGE(PG8_SB(1, 0), b3, voffB);
            PG8_BAR; PG8_WAIT_L(0); PG8_MMA(0, 1, At, B1); PG8_BAR;
            PG8_LDA(At, 1, 1); PG8_STAGE(PG8_SA(1, 0), a3, voffA);
            PG8_BAR; PG8_WAIT_L(0); PG8_MMA(1, 0, At, B0); PG8_BAR; PG8_SCHED;
            PG8_STAGE(PG8_SB(1, 1), b3 + hstepB, voffB);
            PG8_WAIT_V(6); PG8_BAR; PG8_MMA(1, 1, At, B1); PG8_BAR;
        }
        if constexpr (F8) { asm volatile("s_nop 15\n\ts_nop 15" ::: "memory"); __builtin_amdgcn_sched_barrier(0); }
        E(acc, cur, wr, wc, fr, fq);
        if (!has_next) break;
        if (!epi_keep(E, cur, 0)) {
#pragma unroll
        for (int a = 0; a < 2; ++a)
#pragma unroll
            for (int b = 0; b < 2; ++b)
#pragma unroll
                for (int m = 0; m < 4; ++m)
#pragma unroll
                    for (int n = 0; n < 2; ++n) acc[a][b][m][n] = (f32x4){0.f, 0.f, 0.f, 0.f}; }
        cur = nxt; cA = nA; cB = nB; ++ui;
    }
    PG8_WAIT_V(0);
    if (wr == 0) PG8_BAR;
    PG8_BAR;
#undef PG8_SA
#undef PG8_SB
#undef PG8_STAGE
#undef PG8_LDA
#undef PG8_LDB
#undef PG8_MMA
#undef PG8_WAIT_V
#undef PG8_WAIT_L
#undef PG8_BAR
#undef PG8_SCHED
}
}

struct SchedPlain {
    pg8::TileOrder ord; const char* A; const char* Bt; size_t arow, brow;
    __device__ bool next(int i, pg8::Unit& u) const { int pm, pn; if (!ord.tile(i, pm, pn)) return false; u.pm = pm; u.pn = pn; u.aux = 0; u.a = A + (size_t)pm * arow; u.b = Bt + (size_t)pn * brow; return true; }
};
struct SchedMerge {
    pg8::TileOrder ord; const char* Y; const char* W; int f8 = 0;
    __device__ bool next(int i, pg8::Unit& u) const {
        const int r = i / 3, br = i - r * 3; int pm, pn; if (!ord.tile(r, pm, pn)) return false;
        u.pm = pm; u.pn = pn; u.aux = br;
        if (f8) { u.nt = 6; const int acol = br == 0 ? 0 : (br == 1 ? 768 : 1280);
            u.a = Y + ((size_t)pm * 256 * 2048 + acol); u.b = W + ((size_t)br * 2048 * 768 + (size_t)pn * 256 * 768); return true; }
        u.nt = br == 0 ? 12 : 10;
        const int acol = br == 0 ? 0 : (br == 1 ? 768 : 1408);
        u.a = Y + ((size_t)pm * 256 * 2048 + acol) * 2; u.b = W + ((size_t)br * 2048 * 768 + (size_t)pn * 256 * 768) * 2; return true;
    }
};

typedef int i32x4_ __attribute__((ext_vector_type(4)));
struct EpiProj {
    static constexpr bool PERM = true;
    bf16_t* proj; bf16_t* gates; const float* bgate; unsigned char* ws; const float* rstd1; const float* wsc;
    bool dry = false;
    __device__ __forceinline__ void operator()(const f32x4 (&acc)[2][2][4][2], const pg8::Unit& u, int wr, int wc, int fr, int fq) const {
        if (dry) return;
        const bool isg = u.pn >= 24;
        const int row0 = u.pm * 256 + wr * 64 + fr, col0 = (isg ? u.pn - 24 : u.pn) * 256 + wc * 32 + 8 * fq;
        bf16_t* base = isg ? gates : proj;
        f32x4 bv[2][2], cs[2][2];
#pragma unroll
        for (int bj = 0; bj < 2; ++bj)
#pragma unroll
            for (int n = 0; n < 2; ++n) { bv[bj][n] = isg ? ldg<f32x4>(bgate + col0 + bj * 128 + 4 * n) : (f32x4){0.f, 0.f, 0.f, 0.f}; cs[bj][n] = ldg<f32x4>(wsc + u.pn * 256 + wc * 32 + 8 * fq + bj * 128 + 4 * n); }
        bf16_t* vdst[2]; int vH[2]; bool isv[2];
#pragma unroll
        for (int bj = 0; bj < 2; ++bj) { const int un = 2 * u.pn + bj; isv[bj] = false; vdst[bj] = nullptr; vH[bj] = 1;
            if (!isg) {
                if (un >= 12 && un < 18) { isv[bj] = true; vH[bj] = 6; vdst[bj] = (bf16_t*)(ws + WS_VA) + (size_t)(un - 12) * 4096 * 128; }
                else if (un >= 28 && un < 33) { isv[bj] = true; vH[bj] = 5; vdst[bj] = (bf16_t*)(ws + WS_VB) + (size_t)(un - 28) * 4096 * 128; }
                else if (un >= 43) { isv[bj] = true; vH[bj] = 5; vdst[bj] = (bf16_t*)(ws + WS_VC) + (size_t)(un - 43) * 4096 * 128; } } }
        const int cin = wc * 32 + 8 * fq;
        float rs[8];
#pragma unroll
        for (int g = 0; g < 8; ++g) rs[g] = ldg<float>(rstd1 + (size_t)(row0 + (g >> 2) * 128 + (g & 3) * 16) * 8);
        if (isg) {
#pragma unroll
            for (int g = 0; g < 8; ++g) rs[g] *= -LOG2E;
#pragma unroll
            for (int bj = 0; bj < 2; ++bj)
#pragma unroll
                for (int n = 0; n < 2; ++n) bv[bj][n] = bv[bj][n] * -LOG2E; }
#pragma unroll
        for (int ai = 0; ai < 2; ++ai)
#pragma unroll
            for (int m = 0; m < 4; ++m) { const int r = row0 + ai * 128 + m * 16; bf16_t* rowp = base + (size_t)r * PQ + col0;
#pragma unroll
                for (int bj = 0; bj < 2; ++bj) {
                    const i32x4_ i0 = __builtin_bit_cast(i32x4_, acc[ai][bj][m][0]), i1 = __builtin_bit_cast(i32x4_, acc[ai][bj][m][1]);
                    f32x4 v0 = (f32x4){(float)i0[0], (float)i0[1], (float)i0[2], (float)i0[3]} * rs[ai * 4 + m] * cs[bj][0] + bv[bj][0], v1 = (f32x4){(float)i1[0], (float)i1[1], (float)i1[2], (float)i1[3]} * rs[ai * 4 + m] * cs[bj][1] + bv[bj][1];
                    if (isg) {
                        f32x4 e0, e1;
#pragma unroll
                        for (int j = 0; j < 4; ++j) { e0[j] = __builtin_amdgcn_exp2f(v0[j]); e1[j] = __builtin_amdgcn_exp2f(v1[j]); }
                        e0 = e0 + 1.0f; e1 = e1 + 1.0f;
#pragma unroll
                        for (int j = 0; j < 4; ++j) { v0[j] = __builtin_amdgcn_fmed3f(__builtin_amdgcn_rcpf(e0[j]), 1.f / 255.f, 1.0f); v1[j] = __builtin_amdgcn_fmed3f(__builtin_amdgcn_rcpf(e1[j]), 1.f / 255.f, 1.0f); } }
                    if (isg) stg<u32x2>((unsigned char*)gates + (size_t)(u.pm * 24 + (u.pn - 24)) * 65536 + (size_t)((((wr * 4 + wc) * 16 + ai * 8 + m * 2 + bj) * 64 + fq * 16 + fr) * 8),
                                        (u32x2){q8x4(v0[0], v0[1], v0[2], v0[3], 255.f), q8x4(v1[0], v1[1], v1[2], v1[3], 255.f)});
                    else if (isv[bj]) stg<bf16x8>(vdst[bj] + ((size_t)((r >> 12) * vH[bj]) * 4096 + (r & 4095)) * 128 + cin, pack8(v0, v1));
                    else stg<bf16x8>(rowp + bj * 128, pack8(v0, v1)); } }
    }
};
struct EpiBf16 {
    static constexpr bool PERM = true;
    bf16_t* O; int ldc;
    __device__ __forceinline__ void operator()(const f32x4 (&acc)[2][2][4][2], const pg8::Unit& u, int wr, int wc, int fr, int fq) const {
        const int row0 = u.pm * 256 + wr * 64 + fr, col0 = u.pn * 256 + wc * 32 + 8 * fq;
#pragma unroll
        for (int ai = 0; ai < 2; ++ai)
#pragma unroll
            for (int m = 0; m < 4; ++m) { bf16_t* rowp = O + (size_t)(row0 + ai * 128 + m * 16) * ldc + col0;
#pragma unroll
                for (int bj = 0; bj < 2; ++bj) stg<bf16x8>(rowp + bj * 128, pack8(acc[ai][bj][m][0], acc[ai][bj][m][1])); }
    }
};
struct EpiMerge {
    static constexpr bool PERM = true;
    bf16_t* merged; const bf16_t* gates; float fin = 1.f / 255.f;
    __device__ __forceinline__ bool keep(const pg8::Unit& u) const { return u.aux < 2; }
    __device__ __forceinline__ void operator()(f32x4 (&acc)[2][2][4][2], const pg8::Unit& u, int wr, int wc, int fr, int fq) const {
        const int br = u.aux, row0 = u.pm * 256 + wr * 64 + fr, col0 = u.pn * 256 + wc * 32 + 8 * fq;
        u32x2 gc[2], hc[2], gn[2], hn[2];
#define EM_LOAD(G, H, grp) do { const unsigned char* g_ = (const unsigned char*)gates + (size_t)(u.pm * 24 + br * 8 + u.pn) * 65536 + (size_t)((((wr * 4 + wc) * 16 + (grp) * 2) * 64 + fq * 16 + fr) * 8);     \
            G[0] = ldg_nt<u32x2>(g_); G[1] = ldg_nt<u32x2>(g_ + 512); \
            if (br < 2) { H[0] = ldg<u32x2>(g_ + (size_t)8 * 65536); H[1] = ldg<u32x2>(g_ + (size_t)8 * 65536 + 512); } } while (0)
        EM_LOAD(gc, hc, 0);
#pragma unroll
        for (int grp = 0; grp < 8; ++grp) { const int ai = grp >> 2, m = grp & 3; const size_t r = (size_t)(row0 + ai * 128 + m * 16);
            if (grp + 1 < 8) EM_LOAD(gn, hn, grp + 1);
#pragma unroll
            for (int bj = 0; bj < 2; ++bj) { const int c = col0 + bj * 128; const u32x2 g = gc[bj];
                float f[8];
#pragma unroll
                for (int q = 0; q < 8; ++q) f[q] = (float)((g[q >> 2] >> (8 * (q & 3))) & 0xffu);
                if (br < 2) { const u32x2 h = hc[bj];
#pragma unroll
                    for (int q = 0; q < 8; ++q) f[q] *= __builtin_amdgcn_rcpf((float)((h[q >> 2] >> (8 * (q & 3))) & 0xffu)); }
                else {
#pragma unroll
                    for (int q = 0; q < 8; ++q) f[q] *= fin; }
                f32x4 v0 = acc[ai][bj][m][0], v1 = acc[ai][bj][m][1];
                v0[0] *= f[0]; v0[1] *= f[1]; v0[2] *= f[2]; v0[3] *= f[3]; v1[0] *= f[4]; v1[1] *= f[5]; v1[2] *= f[6]; v1[3] *= f[7];
                if (br < 2) { acc[ai][bj][m][0] = v0; acc[ai][bj][m][1] = v1; }
                else { int o0 = 0, o1 = 0;
                    o0 = __builtin_amdgcn_cvt_pk_fp8_f32(v0[0] * M8_SCALE, v0[1] * M8_SCALE, o0, false); o0 = __builtin_amdgcn_cvt_pk_fp8_f32(v0[2] * M8_SCALE, v0[3] * M8_SCALE, o0, true);
                    o1 = __builtin_amdgcn_cvt_pk_fp8_f32(v1[0] * M8_SCALE, v1[1] * M8_SCALE, o1, false); o1 = __builtin_amdgcn_cvt_pk_fp8_f32(v1[2] * M8_SCALE, v1[3] * M8_SCALE, o1, true);
                    stg<u32x2>((unsigned char*)merged + r * 2048 + c, (u32x2){(unsigned)o0, (unsigned)o1}); } }
            gc[0] = gn[0]; gc[1] = gn[1]; hc[0] = hn[0]; hc[1] = hn[1]; }
#undef EM_LOAD
    }
};
struct EpiRes {
    static constexpr bool PERM = false;
    float* out; const float* res;
    __device__ __forceinline__ void operator()(const f32x4 (&acc)[2][2][4][2], const pg8::Unit& u, int wr, int wc, int fr, int fq) const {
        const int row0 = u.pm * 256 + wr * 64 + fr, col0 = u.pn * 256 + wc * 32 + 4 * fq;
#pragma unroll
        for (int ai = 0; ai < 2; ++ai)
#pragma unroll
            for (int m = 0; m < 4; ++m) { const size_t off = (size_t)(row0 + ai * 128 + m * 16) * DM + col0;
#pragma unroll
                for (int bj = 0; bj < 2; ++bj)
#pragma unroll
                    for (int n = 0; n < 2; ++n) { const f32x4 rv = ldg<f32x4>(res + off + bj * 128 + n * 16); stg<f32x4>(out + off + bj * 128 + n * 16, rv + acc[ai][bj][m][n]); }
                asm volatile("" ::: "memory"); }
    }
};

struct EpiRes2 {
    static constexpr bool PERM = true;
    float* out; const float* res; bf16_t* hg; const float* g2; unsigned long long* rowss;
    __device__ __forceinline__ void operator()(const f32x4 (&acc)[2][2][4][2], const pg8::Unit& u, int wr, int wc, int fr, int fq) const {
        const int row0 = u.pm * 256 + wr * 64 + fr, col0 = u.pn * 256 + wc * 32 + 8 * fq;
        f32x4 gv[2][2];
#pragma unroll
        for (int bj = 0; bj < 2; ++bj)
#pragma unroll
            for (int n = 0; n < 2; ++n) gv[bj][n] = ldg<f32x4>(g2 + col0 + bj * 128 + 4 * n);
        f32x4 rc[4], rn[4];
#define ER_LOAD(R, grp) do { const size_t o_ = (size_t)(row0 + ((grp) >> 2) * 128 + ((grp) & 3) * 16) * DM + col0; \
            R[0] = ldg_nt<f32x4>(res + o_); R[1] = ldg_nt<f32x4>(res + o_ + 4); R[2] = ldg_nt<f32x4>(res + o_ + 128); R[3] = ldg_nt<f32x4>(res + o_ + 132); } while (0)
        ER_LOAD(rc, 0);
#pragma unroll
        for (int grp = 0; grp < 8; ++grp) { const int ai = grp >> 2, m = grp & 3; const int r = row0 + ai * 128 + m * 16; const size_t off = (size_t)r * DM + col0; float ss = 0.f;
            if (grp + 1 < 8) ER_LOAD(rn, grp + 1);
#pragma unroll
            for (int bj = 0; bj < 2; ++bj) {
                const f32x4 v0 = acc[ai][bj][m][0] + rc[2 * bj], v1 = acc[ai][bj][m][1] + rc[2 * bj + 1];
                stg<f32x4>(out + off + bj * 128, v0); stg<f32x4>(out + off + bj * 128 + 4, v1);
                ss += v0[0] * v0[0] + v0[1] * v0[1] + v0[2] * v0[2] + v0[3] * v0[3] + v1[0] * v1[0] + v1[1] * v1[1] + v1[2] * v1[2] + v1[3] * v1[3];
                stg<bf16x8>(hg + off + bj * 128, pack8(v0 * gv[bj][0], v1 * gv[bj][1])); }
            ss += shx<16>(ss); ss = sum32(ss);
            if (fq == 0) atomicAdd(rowss + r, (unsigned long long)(ss * 16777216.f + 0.5f));
#pragma unroll
            for (int q = 0; q < 4; ++q) rc[q] = rn[q]; }
#undef ER_LOAD
    }
};
__device__ __forceinline__ float rstd_of(const unsigned long long* rowss, int r) { const unsigned long long v = ldg<unsigned long long>(rowss + r); return rsqrtf((float)v * (1.f / 16777216.f) * (1.f / DM) + NORM_EPS); }
struct EpiBf16S {
    static constexpr bool PERM = true;
    bf16_t* O; int ldc; const unsigned long long* rowss; float oscale;
    __device__ __forceinline__ void operator()(const f32x4 (&acc)[2][2][4][2], const pg8::Unit& u, int wr, int wc, int fr, int fq) const {
        const int row0 = u.pm * 256 + wr * 64 + fr, col0 = u.pn * 256 + wc * 32 + 8 * fq;
        float rs[8];
#pragma unroll
        for (int grp = 0; grp < 8; ++grp) rs[grp] = rstd_of(rowss, row0 + (grp >> 2) * 128 + (grp & 3) * 16) * oscale;
        int fo = fq, ro = fr; asm volatile("" : "+v"(fo), "+v"(ro));
        const unsigned lb = (unsigned)((((2 * wc + (fo >> 1)) * 2 + (fo & 1)) * 32 + ro) * 8);
        bf16_t* tile = O + (size_t)(u.pm * 8 + u.pn) * 65536;
#pragma unroll
        for (int ai = 0; ai < 2; ++ai)
#pragma unroll
            for (int m = 0; m < 4; ++m) {
                const unsigned so = (unsigned)((4 * ai + 2 * wr + (m >> 1)) * 2 * 4096 + 16 * (m & 1) * 8);
#pragma unroll
                for (int bj = 0; bj < 2; ++bj) stg<bf16x8>(tile + so + bj * 4096 + lb, pack8(acc[ai][bj][m][0] * rs[ai * 4 + m], acc[ai][bj][m][1] * rs[ai * 4 + m])); }
    }
};

struct EpiRes3 {
    static constexpr bool PERM = true;
    bf16_t* out; const float* res; const bf16_t* res16; unsigned long long* rowss; unsigned char* out8;
    __device__ __forceinline__ void operator()(const f32x4 (&acc)[2][2][4][2], const pg8::Unit& u, int wr, int wc, int fr, int fq) const {
        const int row0 = u.pm * 256 + wr * 64 + fr, col0 = u.pn * 256 + wc * 32 + 8 * fq;
        f32x4 rc[4], rn[4];
#define ER_LOAD(R, grp) do { const size_t o_ = (size_t)(row0 + ((grp) >> 2) * 128 + ((grp) & 3) * 16) * DM + col0; \
            if (res16) { const u32x4 a_ = ldg_nt<u32x4>(res16 + o_), b_ = ldg_nt<u32x4>(res16 + o_ + 128); \
                R[0] = (f32x4){bflo(a_[0]), bfhi(a_[0]), bflo(a_[1]), bfhi(a_[1])}; R[1] = (f32x4){bflo(a_[2]), bfhi(a_[2]), bflo(a_[3]), bfhi(a_[3])}; \
                R[2] = (f32x4){bflo(b_[0]), bfhi(b_[0]), bflo(b_[1]), bfhi(b_[1])}; R[3] = (f32x4){bflo(b_[2]), bfhi(b_[2]), bflo(b_[3]), bfhi(b_[3])}; } \
            else { R[0] = ldg_nt<f32x4>(res + o_); R[1] = ldg_nt<f32x4>(res + o_ + 4); R[2] = ldg_nt<f32x4>(res + o_ + 128); R[3] = ldg_nt<f32x4>(res + o_ + 132); } } while (0)
        ER_LOAD(rc, 0);
#pragma unroll
        for (int grp = 0; grp < 8; ++grp) { const int ai = grp >> 2, m = grp & 3; const int r = row0 + ai * 128 + m * 16; const size_t off = (size_t)r * DM + col0; float ss = 0.f;
            if (grp + 1 < 8) ER_LOAD(rn, grp + 1);
#pragma unroll
            for (int bj = 0; bj < 2; ++bj) {
                const f32x4 v0 = acc[ai][bj][m][0] * (1.0f / (M8_SCALE * WO8_SCALE)) + rc[2 * bj], v1 = acc[ai][bj][m][1] * (1.0f / (M8_SCALE * WO8_SCALE)) + rc[2 * bj + 1];
                ss += v0[0] * v0[0] + v0[1] * v0[1] + v0[2] * v0[2] + v0[3] * v0[3] + v1[0] * v1[0] + v1[1] * v1[1] + v1[2] * v1[2] + v1[3] * v1[3];
                stg<bf16x8>(out + off + bj * 128, pack8(v0, v1));
                { int o0 = 0, o1 = 0;
                  o0 = __builtin_amdgcn_cvt_pk_fp8_f32(v0[0] * X8_SCALE, v0[1] * X8_SCALE, o0, false); o0 = __builtin_amdgcn_cvt_pk_fp8_f32(v0[2] * X8_SCALE, v0[3] * X8_SCALE, o0, true);
                  o1 = __builtin_amdgcn_cvt_pk_fp8_f32(v1[0] * X8_SCALE, v1[1] * X8_SCALE, o1, false); o1 = __builtin_amdgcn_cvt_pk_fp8_f32(v1[2] * X8_SCALE, v1[3] * X8_SCALE, o1, true);
                  stg<u32x2>(out8 + off + bj * 128, (u32x2){(unsigned)o0, (unsigned)o1}); } }
            ss += shx<16>(ss); ss = sum32(ss);
            if (fq == 0) atomicAdd(rowss + r, (unsigned long long)(ss * 16777216.f + 0.5f));
#pragma unroll
            for (int q = 0; q < 4; ++q) rc[q] = rn[q]; }
#undef ER_LOAD
    }
};

namespace att {
constexpr int D = 128, NW = 8, QBLK = 32, KVBLK = 64, QB = NW * QBLK;
constexpr int SHM_V = KVBLK * D * 2, SHM_K = KVBLK * D * 2;
constexpr int OFF_WS = 2 * SHM_V + 2 * SHM_K;
constexpr int OFF_BIAS = OFF_WS + NW * 64 * 4;
constexpr int OFF_KM = OFF_BIAS + 4096 * 4;
constexpr int OFF_MISC = OFF_KM + 32 * 128 * 2;
constexpr int OFF_Q = 94208;
constexpr float THR2 = 8.f * LOG2E;

#define KSWZ(row, colB) ((row) * 256 + ((colB) ^ (((row) & 7) << 4)))
#define SBAR() __builtin_amdgcn_sched_barrier(0)
__device__ __forceinline__ int v_st(int k, int c) { const int kk = (k & ~0xC) | ((k & 4) << 1) | ((k & 8) >> 1); return ((kk >> 3) * 4 + (c >> 5)) * 512 + ((kk & 7) * 32 + (c & 31)) * 2; }
__device__ __forceinline__ int v_rd_base(int lane) { return ((lane & 3) << 3) | (((lane >> 2) & 3) << 6) | (((lane >> 4) & 1) << 5) | (((lane >> 5) & 1) << 8); }
constexpr int v_rd_off(int d0, int ks, int half) { return d0 * 512 + ks * 4096 + half * 2048; }
__device__ __forceinline__ int crow(int r, int hi) { return (r & 3) + 8 * (r >> 2) + 4 * hi; }
__device__ __forceinline__ bf16x8 load8(const bf16_t* p) { return ldg<bf16x8>(p); }

__device__ __forceinline__ void mask_tile(f32x16& p0, f32x16& p1, int dq) {
    const float NEG = -__builtin_inff();
#pragma unroll
    for (int r = 0; r < 16; ++r) {
        const int c = (r & 3) + 8 * (r >> 2);
        if (dq - c < 0) p0[r] = NEG;
        if (dq - c - 32 < 0) p1[r] = NEG;
    }
}
__device__ __forceinline__ void kill_tile(f32x16& p0, f32x16& p1, bool dead) {
    const float NEG = -__builtin_inff();
#pragma unroll
    for (int r = 0; r < 16; ++r) { p0[r] = dead ? NEG : p0[r]; p1[r] = dead ? NEG : p1[r]; }
}
__device__ __forceinline__ void bias_tile(f32x16& p0, f32x16& p1, const float* bl, int hi) {
#pragma unroll
    for (int g = 0; g < 4; ++g) {
        const f32x4 b0 = *(const f32x4*)(bl + 8 * g + 4 * hi), b1 = *(const f32x4*)(bl + 32 + 8 * g + 4 * hi);
#pragma unroll
        for (int j = 0; j < 4; ++j) { p0[4 * g + j] += b0[j]; p1[4 * g + j] += b1[j]; }
        asm volatile("" ::: "memory");
    }
}
__device__ __forceinline__ void partialSM(f32x16& p0, f32x16& p1, float& m_reg, float& mn, float& alpha, bool dead) {
    float pmax = p0[0];
#pragma unroll
    for (int r = 1; r < 16; ++r) pmax = fmaxf(pmax, p0[r]);
#pragma unroll
    for (int r = 0; r < 16; ++r) pmax = fmaxf(pmax, p1[r]);
    { auto rr = __builtin_amdgcn_permlane32_swap(__float_as_uint(pmax), __float_as_uint(pmax), false, false);
      pmax = fmaxf(__uint_as_float(rr[0]), __uint_as_float(rr[1])); }
    pmax = dead ? -1e30f : pmax;
    if (__builtin_expect(__all((pmax - m_reg) <= THR2), 1)) { mn = m_reg; alpha = 1.f; }
    else { mn = fmaxf(m_reg, pmax); alpha = __builtin_amdgcn_exp2f(m_reg - mn); m_reg = mn; }
    const float mne = dead ? __builtin_inff() : mn;
#pragma unroll
    for (int r = 0; r < 16; ++r) p0[r] = p0[r] - mne;
#pragma unroll
    for (int r = 0; r < 16; ++r) p1[r] = p1[r] - mne;
#pragma unroll
    for (int r = 0; r < 16; ++r) p0[r] = __builtin_amdgcn_exp2f(p0[r]);
}
__device__ __forceinline__ void finishSM(f32x16& p0, f32x16& p1, float alpha, float& l_reg, bf16x8& pa0, bf16x8& pa1, bf16x8& pa2, bf16x8& pa3) {
#pragma unroll
    for (int r = 0; r < 16; ++r) p1[r] = __builtin_amdgcn_exp2f(p1[r]);
    float ps = 0;
#pragma unroll
    for (int r = 0; r < 16; ++r) ps += p0[r];
#pragma unroll
    for (int r = 0; r < 16; ++r) ps += p1[r];
    { auto rr = __builtin_amdgcn_permlane32_swap(__float_as_uint(ps), __float_as_uint(ps), false, false);
      ps = __uint_as_float(rr[0]) + __uint_as_float(rr[1]); }
    l_reg = l_reg * alpha + ps;
#define PK4(P, B_, OUT) do { unsigned a0 = cvtpk(P[B_+0], P[B_+1]), a1 = cvtpk(P[B_+2], P[B_+3]);                          \
        unsigned b0 = cvtpk(P[B_+4], P[B_+5]), b1 = cvtpk(P[B_+6], P[B_+7]);                                             \
        auto r0 = __builtin_amdgcn_permlane32_swap(a0, b0, false, false); auto r1 = __builtin_amdgcn_permlane32_swap(a1, b1, false, false); \
        u32x4 w = {r0[0], r1[0], r0[1], r1[1]}; OUT = *reinterpret_cast<bf16x8*>(&w); } while (0)
    PK4(p0, 0, pa0); PK4(p0, 8, pa1); PK4(p1, 0, pa2); PK4(p1, 8, pa3);
#undef PK4
}
template <int KB, int ND>
__device__ __forceinline__ void qkt_(f32x16& p0, f32x16& p1, const char* K_lds, int r32, int hi, const char* qr) {
    p0 = f32x16{}; p1 = f32x16{};
    const char* kb[4];
#pragma unroll
    for (int dd = 0; dd < 4; ++dd) kb[dd] = K_lds + KB * SHM_K + KSWZ(r32, (dd * 16 + hi * 8) * 2);
#pragma unroll
    for (int d0 = 0; d0 < ND; ++d0) { const char* a = kb[d0 & 3] + (d0 >> 2) * 128;
        bf16x8 b0 = *reinterpret_cast<const bf16x8*>(a);
        bf16x8 b1 = *reinterpret_cast<const bf16x8*>(a + 32 * 256);
        const bf16x8 q = *reinterpret_cast<const bf16x8*>(qr + d0 * 1024);
        p0 = __builtin_amdgcn_mfma_f32_32x32x16_bf16(b0, q, p0, 0, 0, 0);
        p1 = __builtin_amdgcn_mfma_f32_32x32x16_bf16(b1, q, p1, 0, 0, 0); }
}
template <int KB>
__device__ __forceinline__ void qkt(f32x16& p0, f32x16& p1, const char* K_lds, int r32, int hi, const char* qr, bool d64) {
    if (d64) qkt_<KB, 4>(p0, p1, K_lds, r32, hi, qr); else qkt_<KB, 8>(p0, p1, K_lds, r32, hi, qr);
}
template <int VB>
__device__ __forceinline__ void pv_tile(f32x16* o, int vb0, bf16x8 pa0, bf16x8 pa1, bf16x8 pa2, bf16x8 pa3) {
#define TRRD(dst, off) asm volatile("ds_read_b64_tr_b16 %0, %1 offset:%2" : "=&v"(dst) : "v"(vb0), "i"(off) : "memory")
#define PV_D0(d0) do { s16x4 l0, l1, l2, l3, h0, h1, h2, h3; constexpr int b_ = VB * SHM_V + v_rd_off(d0, 0, 0); \
        TRRD(l0, b_); TRRD(h0, b_ + 2048); TRRD(l1, b_ + 4096); TRRD(h1, b_ + 6144); TRRD(l2, b_ + 8192); TRRD(h2, b_ + 10240); TRRD(l3, b_ + 12288); TRRD(h3, b_ + 14336); \
        asm volatile("s_waitcnt lgkmcnt(0)" ::: "memory"); SBAR();   \
        o[d0] = __builtin_amdgcn_mfma_f32_32x32x16_bf16(pa0, (bf16x8){l0[0], l0[1], l0[2], l0[3], h0[0], h0[1], h0[2], h0[3]}, o[d0], 0, 0, 0);   \
        o[d0] = __builtin_amdgcn_mfma_f32_32x32x16_bf16(pa1, (bf16x8){l1[0], l1[1], l1[2], l1[3], h1[0], h1[1], h1[2], h1[3]}, o[d0], 0, 0, 0);   \
        o[d0] = __builtin_amdgcn_mfma_f32_32x32x16_bf16(pa2, (bf16x8){l2[0], l2[1], l2[2], l2[3], h2[0], h2[1], h2[2], h2[3]}, o[d0], 0, 0, 0);   \
        o[d0] = __builtin_amdgcn_mfma_f32_32x32x16_bf16(pa3, (bf16x8){l3[0], l3[1], l3[2], l3[3], h3[0], h3[1], h3[2], h3[3]}, o[d0], 0, 0, 0); } while (0)
    PV_D0(0); PV_D0(1); PV_D0(2); PV_D0(3);
#undef PV_D0
#undef TRRD
}

struct BlockRef { const bf16_t* Q; const bf16_t* K; const bf16_t* V; bf16_t* O; const float* cb; int P0, ldo, mode, jlo, kp, o8 = 0; };
struct Seam { bf16x8 qr[8]; bf16x8 st_v0, st_v1, st_k0, st_k1; };

#define ROW(p, k0, rr) ((p) + (size_t)((k0) + (rr)) * D + sc)
#define VMW() asm volatile("s_waitcnt vmcnt(0)" ::: "memory")
#define VMWN(n) asm volatile("s_waitcnt vmcnt(%0)" :: "i"(n) : "memory")
#define SLOAD_H(Kp, Vp, k0, kp_) do { S.st_v0 = load8(ROW(Vp, k0, sr)); S.st_v1 = load8(ROW(Vp, k0, 32 + sr));              \
                         if (sc < (kp_)) { S.st_k0 = load8((Kp) + (size_t)((k0) + sr) * (kp_) + sc); S.st_k1 = load8((Kp) + (size_t)((k0) + 32 + sr) * (kp_) + sc); } } while (0)
#define SWRITE_HK(bf) do { *(bf16x8*)(K_lds + (bf) * SHM_K + kws) = S.st_k0; *(bf16x8*)(K_lds + (bf) * SHM_K + kws + 32 * 256) = S.st_k1; } while (0)
#define SWRITE_HV(bf) do { *(bf16x8*)(V_lds + (bf) * SHM_V + vst0) = S.st_v0; *(bf16x8*)(V_lds + (bf) * SHM_V + vst1) = S.st_v1; } while (0)
#define SWRITE_H(bf) do { SWRITE_HV(bf); SWRITE_HK(bf); } while (0)

__device__ __forceinline__ void attn_prime(const BlockRef& cur, char* lds, Seam& S) {
    int tid = threadIdx.x; asm volatile("" : "+v"(tid));
    const int wid = __builtin_amdgcn_readfirstlane(tid >> 6), lane = tid & 63, r32 = lane & 31, hi = lane >> 5;
    const int sr = tid >> 4, sc = (tid & 15) * 8, kws = KSWZ(sr, sc * 2); char* K_lds = lds + 2 * SHM_V;
#pragma unroll
    for (int d0 = 0; d0 < 8; ++d0) { S.qr[d0] = bf16x8{}; if (d0 * 16 < cur.kp) S.qr[d0] = load8(cur.Q + (size_t)(wid * QBLK + r32) * cur.kp + d0 * 16 + hi * 8); }
    S.st_k0 = bf16x8{}; S.st_k1 = bf16x8{};
    SLOAD_H(cur.K, cur.V, cur.jlo * KVBLK, cur.kp); VMW(); SWRITE_HK(0);
    __syncthreads();
}

__device__ __forceinline__ unsigned attn_item_setup(const BlockRef& cur, char* lds, const Seam& S) {
    int tid = threadIdx.x; asm volatile("" : "+v"(tid));
    const int lane = tid & 63, r32 = lane & 31, hi = lane >> 5;
    unsigned sel = 0u;
    if (cur.mode == 2) {
        float* bl = (float*)(lds + OFF_BIAS);
        const float cref = ldg<float>(cur.cb + cur.P0);
        for (int k = cur.jlo * KVBLK + tid; k < cur.P0 + QB; k += NW * 64) bl[k] = (cref - ldg<float>(cur.cb + k)) * LOG2E;
    } else if (cur.mode == 1) {
        const int own = cur.P0 >> 8;
        bf16_t* km = (bf16_t*)(lds + OFF_KM);
        { const int n = tid >> 4;
          u32x4 w = zero4();
          if (n < own) { typedef int i32x4s __attribute__((ext_vector_type(4))); const int* ks = (const int*)cur.cb + tid * 8; const i32x4s a = ldg<i32x4s>(ks), b = ldg<i32x4s>(ks + 4); const float sc = 1.f / (256.f * 262144.f);
              w = (u32x4){cvtpk((float)a[0] * sc, (float)a[1] * sc), cvtpk((float)a[2] * sc, (float)a[3] * sc), cvtpk((float)b[0] * sc, (float)b[1] * sc), cvtpk((float)b[2] * sc, (float)b[3] * sc)}; }
          *(u32x4*)(km + tid * 8) = w; }
        __syncthreads();
        f32x16 g = f32x16{};
#pragma unroll
        for (int d0 = 0; d0 < 8; ++d0) { const bf16x8 a = *(const bf16x8*)(km + r32 * 128 + d0 * 16 + hi * 8); g = __builtin_amdgcn_mfma_f32_32x32x16_bf16(a, S.qr[d0], g, 0, 0, 0); }
        float gv[16];
#pragma unroll
        for (int r = 0; r < 8; ++r) { const float mine = g[r], other = shx32(mine, hi != 0);
            const int nm = (r & 3) + 8 * (r >> 2);
            gv[nm] = hi ? other : mine; gv[nm + 4] = hi ? mine : other; }
#pragma unroll
        for (int pass = 0; pass < 3; ++pass) { float best = -__builtin_inff(); int bi = -1;
#pragma unroll
            for (int n = 0; n < 16; ++n) { const bool ok = (n < own) && !((sel >> n) & 1u) && (gv[n] > best); best = ok ? gv[n] : best; bi = ok ? n : bi; }
            if (bi >= 0) sel |= 1u << bi; }
    }
    __syncthreads();
    return sel;
}

template <class NextFn>
__device__ __forceinline__ void attn_block(const BlockRef& cur, const NextFn& next_ref, char* lds, Seam& S) {
    int tid = threadIdx.x; asm volatile("" : "+v"(tid));
    const int wid = __builtin_amdgcn_readfirstlane(tid >> 6), lane = tid & 63, r32 = lane & 31, hi = lane >> 5;
    const unsigned sel = attn_item_setup(cur, lds, S);
    const char* Q_lds = lds + OFF_Q + wid * 8192 + lane * 16;
#pragma unroll
    for (int d0 = 0; d0 < 8; ++d0) *(bf16x8*)(lds + OFF_Q + wid * 8192 + d0 * 1024 + lane * 16) = S.qr[d0];
    const int mode = cur.mode;
    const int jlo = cur.jlo, NT = cur.P0 / KVBLK + QB / KVBLK - jlo;
    const int qlo = cur.P0 + wid * QBLK, qm = qlo + r32 - 4 * hi;
    char* V_lds = lds; char* K_lds = lds + 2 * SHM_V;
    float* ws = (float*)(lds + OFF_WS) + wid * 64; float* li_l = ws, * al_l = ws + 32;
    const float* bias_l = (const float*)(lds + OFF_BIAS);
    float m_reg = -1e30f, l_reg = 0; f32x16 o[4] = {};
    const int sr = tid >> 4, sc = (tid & 15) * 8, vst0 = v_st(sr, sc), vst1 = vst0 + 8192  , kws = KSWZ(sr, sc * 2);
    const int vb0 = (int)(uintptr_t)V_lds + v_rd_base(lane);
    const bf16_t* Kh = cur.K; const bf16_t* Vh = cur.V;
#define RESC(a) do { if (__any((a) < 1.f)) { if (hi == 0) al_l[r32] = (a); asm volatile("s_waitcnt lgkmcnt(0)" ::: "memory");              \
                     for (int d_ = 0; d_ < 4; ++d_) for (int r = 0; r < 16; ++r) o[d_][r] *= al_l[crow(r, hi)]; } } while (0)
#define KBASE(t) ((jlo + (t)) * KVBLK)
#define MASKT(P0_, P1_, t) do { const int kb_ = KBASE(t);                                                          \
        if (mode == 2) bias_tile(P0_, P1_, bias_l + kb_, hi);                                                      \
        deadv = (mode == 1 && kb_ < cur.P0) ? !((sel >> (kb_ >> 8)) & 1u) : false;                                  \
        if (kb_ + KVBLK - 1 > qlo) mask_tile(P0_, P1_, qm - kb_); } while (0)
#define SEAM_K0() do { if (nxt.kp == 64) VMWN(4); else VMWN(8); SWRITE_HK(0); SBAR(); } while (0)
    f32x16 pA0, pA1, pB0, pB1; float mnA, mnB, alA, alB; bf16x8 pa0, pa1, pa2, pa3; bool deadv = false;
    SWRITE_HV(0); SBAR();
    const int kp = cur.kp; const bool d64 = kp == 64;
    if (NT > 1) { SLOAD_H(Kh, Vh, KBASE(1), kp); }
    SBAR(); qkt<0>(pA0, pA1, K_lds, r32, hi, Q_lds, d64);
    MASKT(pA0, pA1, 0); partialSM(pA0, pA1, m_reg, mnA, alA, deadv);
    if (NT > 1) { VMW(); SWRITE_H(1); }
    __syncthreads();
#define HALF_STEP(PX0, PX1, mnX, alX, PY0, PY1, alY, t, KB, VB, SB) do {                                           \
        SBAR(); qkt<KB>(PX0, PX1, K_lds, r32, hi, Q_lds, d64);                                                      \
        finishSM(PY0, PY1, alY, l_reg, pa0, pa1, pa2, pa3); SBAR();                                                \
        if ((t) + 1 < NT) { SLOAD_H(Kh, Vh, KBASE((t) + 1), kp); SBAR(); }                                         \
        pv_tile<VB>(o, vb0, pa0, pa1, pa2, pa3); MASKT(PX0, PX1, (t)); partialSM(PX0, PX1, m_reg, mnX, alX, deadv);       \
        __syncthreads();                                                                                           \
        if ((t) + 1 < NT) { VMW(); SWRITE_H(SB); }                                                                 \
        RESC(alX); __syncthreads(); } while (0)
    for (int t = 1; t + 1 < NT; t += 2) {
        HALF_STEP(pB0, pB1, mnB, alB, pA0, pA1, alA, t, 1, 0, 0);
        HALF_STEP(pA0, pA1, mnA, alA, pB0, pB1, alB, t + 1, 0, 1, 1);
    }
    const bool even = (NT & 1) == 0;
    if (even) { SBAR(); qkt<1>(pB0, pB1, K_lds, r32, hi, Q_lds, d64); SBAR(); }
    const BlockRef nxt = next_ref();
    SLOAD_H(nxt.K, nxt.V, nxt.jlo * KVBLK, nxt.kp); SBAR();
#pragma unroll
    for (int d0 = 0; d0 < 8; ++d0) { S.qr[d0] = bf16x8{}; if (d0 * 16 < nxt.kp) S.qr[d0] = load8(nxt.Q + (size_t)(wid * QBLK + r32) * nxt.kp + d0 * 16 + hi * 8); }
    SBAR();
    finishSM(pA0, pA1, alA, l_reg, pa0, pa1, pa2, pa3); SBAR();
    pv_tile<0>(o, vb0, pa0, pa1, pa2, pa3);
    if (even) { MASKT(pB0, pB1, NT - 1); partialSM(pB0, pB1, m_reg, mnB, alB, deadv); __syncthreads(); RESC(alB);
        finishSM(pB0, pB1, alB, l_reg, pa0, pa1, pa2, pa3); SBAR(); pv_tile<1>(o, vb0, pa0, pa1, pa2, pa3); }
    SBAR(); SEAM_K0();
    if (hi == 0) li_l[r32] = l_reg; asm volatile("s_waitcnt lgkmcnt(0)" ::: "memory");
    const GAS char* Ow = (const GAS char*)(cur.O + (size_t)(wid * QBLK) * cur.ldo);
    const unsigned ob = (unsigned)((4 * hi) * cur.ldo + r32) * 2u;
#pragma unroll
    for (int r = 0; r < 16; ++r) { const unsigned orow_b = (unsigned)(((r & 3) + 8 * (r >> 2)) * cur.ldo) * 2u;
        const float rl = __builtin_amdgcn_rcpf(li_l[crow(r, hi)]);
#pragma unroll
        for (int d0 = 0; d0 < 4; ++d0) { const float v = o[d0][r] * rl;
            const float vn = shx<1>(v);
            if (cur.o8) { if ((r32 & 1) == 0) *(GAS unsigned short*)((const GAS char*)cur.O + (size_t)(wid * QBLK) * cur.ldo + ((ob + orow_b) >> 1) + (unsigned)(d0 * 32)) = (unsigned short)__builtin_amdgcn_cvt_pk_fp8_f32(v * Y8_SCALE, vn * Y8_SCALE, 0, false); }
            else if ((r32 & 1) == 0) *(GAS unsigned*)(Ow + (size_t)(ob + orow_b + (unsigned)(d0 * 64))) = cvtpk(v, vn); } }
    __syncthreads();
#undef RESC
#undef KBASE
#undef MASKT
#undef SEAM_K0
#undef HALF_STEP
}
#undef ROW
#undef VMW
#undef VMWN
#undef SLOAD_H
#undef SWRITE_HK
#undef SWRITE_HV
#undef SWRITE_H
}

struct Args {
    const float* in[25]; float* out; unsigned char* ws;
    double invrev[16];
    int ph_lo, ph_hi;
};
struct Frame {
    int tid, lane, wave, G, bid, gw, GW;
    unsigned char* ws; unsigned char* lds;
};
constexpr int ARG_OFF = 159744;
__device__ __forceinline__ const float* arg_in(const Frame& F, int j) {
    int off = ARG_OFF; asm volatile("" : "+v"(off));
    const LAS unsigned* la = (const LAS unsigned*)((LAS unsigned char*)F.lds + off);
    const unsigned lo = __builtin_amdgcn_readfirstlane(la[2 * j]), hi = __builtin_amdgcn_readfirstlane(la[2 * j + 1]);
    return (const float*)(((unsigned long long)hi << 32) | lo);
}
__device__ __forceinline__ const LAS double* arg_invrev(const Frame& F) { int off = ARG_OFF + 27 * 8; asm volatile("" : "+v"(off)); return (const LAS double*)((LAS unsigned char*)F.lds + off); }
enum { I_X = 0, I_NORM1, I_WIN, I_BGATE, I_BFORGET, I_AQN, I_AKN, I_LQ1, I_LK1, I_LQ2, I_LK2, I_AON, I_BQN, I_BKN, I_CQN, I_CKN, I_WBA, I_WBB, I_WBC, I_WOUT, I_NORM2, I_WPQ, I_PSK, I_PU, I_PV };

#define XB_TMO      128
#define XB_XCNT(j)  (256  + 64 * (j))
#define XB_XSUB(j)  (1280 + 64 * (j))
#define XB_XGEN(j)  (2304 + 64 * (j))
#define XB_TOP      3328
#define XB_TOPGEN   3392
#define XCD_BAR_WORDS 3456
#define XB_SPIN_CAP (1u << 22)
__device__ __forceinline__ unsigned xb_ld(unsigned* p)              { return __hip_atomic_load(p, __ATOMIC_RELAXED, __HIP_MEMORY_SCOPE_AGENT); }
__device__ __forceinline__ unsigned xb_add(unsigned* p, unsigned v) { return __hip_atomic_fetch_add(p, v, __ATOMIC_RELAXED, __HIP_MEMORY_SCOPE_AGENT); }
__device__ __forceinline__ unsigned xb_xcc_id() { return (unsigned)__builtin_amdgcn_s_getreg((3 << 11) | 20) & 0xFu; }
#define XB_SPIN(cond, bar) do { unsigned _sp = 0; while (cond) { __builtin_amdgcn_s_sleep(1); \
    if ((++_sp & 255u) == 0u) { if (xb_ld(&(bar)[XB_TMO])) break; if (_sp > XB_SPIN_CAP) { atomicAdd(&(bar)[XB_TMO], 1u); break; } } } } while (0)
struct XcdBarrier { unsigned* bar; unsigned x; volatile LAS unsigned* st; };
__device__ __forceinline__ XcdBarrier xcd_barrier_post(unsigned* bar, volatile LAS unsigned* st) {
    XcdBarrier b; b.bar = bar; b.x = xb_xcc_id(); b.st = st;
    if (threadIdx.x == 0) (void)xb_add(&bar[XB_XCNT(b.x)], 1u);
    return b;
}
__device__ __forceinline__ void xcd_barrier_complete(unsigned* bar, unsigned x, unsigned& nloc, unsigned& nx) {
    const unsigned G = gridDim.x * gridDim.y * gridDim.z;
    unsigned sum, cnt, mine, sp = 0u;
    for (;;) {
        sum = 0u; cnt = 0u; mine = 0u;
#pragma unroll
        for (unsigned j = 0; j < 16; ++j) { const unsigned c = xb_ld(&bar[XB_XCNT(j)]); sum += c; cnt += (c > 0u) ? 1u : 0u; mine = (j == x) ? c : mine; }
        if (sum == G) break;
        __builtin_amdgcn_s_sleep(1);
        if ((++sp & 255u) == 0u) { if (xb_ld(&bar[XB_TMO])) break; if (sp > XB_SPIN_CAP) { atomicAdd(&bar[XB_TMO], 1u); break; } }
    }
    nloc = mine > 0u ? mine : 1u; nx = cnt > 0u ? cnt : 1u;
}
__device__ __forceinline__ void xcd_barrier(const XcdBarrier& b) {
    asm volatile("s_waitcnt vmcnt(0)" ::: "memory");
    __syncthreads();
    if (threadIdx.x == 0) {
        unsigned* bar = b.bar;
        __builtin_amdgcn_s_waitcnt(0);
        unsigned nloc = b.st[0], nx = b.st[1];
        if (nloc == 0u) { xcd_barrier_complete(bar, b.x, nloc, nx); b.st[0] = nloc; b.st[1] = nx; }
        const unsigned old = xb_add(&bar[XB_XSUB(b.x)], 1u);
        const unsigned gen = old / nloc;
        if (old + 1u == (gen + 1u) * nloc) {
            __builtin_amdgcn_fence(__ATOMIC_RELEASE, "agent");
            asm volatile("s_waitcnt vmcnt(0)" ::: "memory");
            const unsigned og = xb_add(&bar[XB_TOP], 1u);
            const unsigned tg = og / nx;
            if (og + 1u == (tg + 1u) * nx) xb_add(&bar[XB_TOPGEN], 1u);
            else XB_SPIN(xb_ld(&bar[XB_TOPGEN]) == tg, bar);
            __builtin_amdgcn_fence(__ATOMIC_ACQUIRE, "agent");
            xb_add(&bar[XB_XGEN(b.x)], 1u);
            asm volatile("s_waitcnt vmcnt(0)" ::: "memory");
        } else {
            XB_SPIN(xb_ld(&bar[XB_XGEN(b.x)]) == gen, bar);
            __builtin_amdgcn_fence(__ATOMIC_ACQUIRE, "agent");
            asm volatile("s_waitcnt vmcnt(0)" ::: "memory");
        }
    }
    __syncthreads();
}

struct CvtTile { const float* src; bf16_t* dst; const float* gk; int ldsrc, lddst; unsigned char* dst8; };
constexpr int CVT_TILES = 32 * 6 + 32 * 5 + 32 * 5 + 32 * 16 + 32 * 16;
__device__ __forceinline__ CvtTile cvt_decode(const Frame& F, int t) {
    const int l = t / CVT_TILES; int u = t - l * CVT_TILES;
    unsigned char* wl = F.ws + WS_W0 + (size_t)l * WL_SIZE;
    const float* W; const float* gk = nullptr; int ld, nt, kt, coloff = 0, kdoff = 0, lddst; bf16_t* D; unsigned char* D8 = nullptr;
    if (u < 32 * 6) { nt = u / 6; kt = u % 6; W = arg_in(F, I_WBA) + (size_t)l * 768 * DM; ld = DM; D = (bf16_t*)(wl + WO_WBR_T); lddst = 768;
        if (MF8_LAYER(l)) D8 = wl + WO_WBR_T + (size_t)(nt * 64) * 768 + kt * 128; }
    else if ((u -= 32 * 6) < 32 * 5) { nt = u / 5; kt = u % 5; W = arg_in(F, I_WBB) + (size_t)l * 640 * DM; ld = DM; D = (bf16_t*)(wl + WO_WBR_T) + (size_t)2048 * 768; lddst = 768;
        if (MF8_LAYER(l)) D8 = wl + WO_WBR_T + (size_t)2048 * 768 + (size_t)(nt * 64) * 768 + kt * 128; }
    else if ((u -= 32 * 5) < 32 * 5) { nt = u / 5; kt = u % 5; W = arg_in(F, I_WBC) + (size_t)l * 640 * DM; ld = DM; D = (bf16_t*)(wl + WO_WBR_T) + (size_t)2 * 2048 * 768; lddst = 768;
        if (MF8_LAYER(l)) D8 = wl + WO_WBR_T + (size_t)2 * 2048 * 768 + (size_t)(nt * 64) * 768 + 128 + kt * 128; }
    else if ((u -= 32 * 5) < 32 * 16) { nt = u / 16; kt = u % 16; W = arg_in(F, I_WOUT) + (size_t)l * DM * DM; ld = DM; D = (bf16_t*)(wl + WO_WOUT_T); lddst = 2048; D8 = wl + WO_WOUT_T + (size_t)(nt * 64) * 2048 + kt * 128; }
    else { u -= 32 * 16; nt = u / 16; kt = u % 16; W = arg_in(F, I_WPQ) + (size_t)l * DM * DM; ld = DM; D = (bf16_t*)(wl + WO_WQ_T); lddst = 2048; gk = arg_in(F, I_NORM2) + l * DM + kt * 128; if (QF8_LAYER(l)) D8 = wl + WO_WQ_T + (size_t)(nt * 64) * 2048 + kt * 128; }
    CvtTile c; c.src = W + (size_t)(kt * 128) * ld + nt * 64 + coloff; c.ldsrc = ld; c.dst = D + (size_t)(nt * 64) * lddst + kdoff + kt * 128; c.lddst = lddst; c.gk = gk; c.dst8 = D8; return c;
}
__device__ __forceinline__ void cvt_load(const Frame& F, const CvtTile& c, float (&r)[16]) {
    const int n = F.tid & 63, kq = F.tid >> 6;
#pragma unroll
    for (int i = 0; i < 16; ++i) r[i] = ldg_nt<float>(c.src + (size_t)(kq + 8 * i) * c.ldsrc + n);
    if (c.gk) {
#pragma unroll
        for (int i = 0; i < 16; ++i) r[i] *= ldg<float>(c.gk + kq + 8 * i); }
}
__device__ __forceinline__ void cvt_store(const Frame& F, const CvtTile& c, const float (&r)[16]) {
    bf16_t* sT = (bf16_t*)F.lds;
    const int n = F.tid & 63, kq = F.tid >> 6;
#pragma unroll
    for (int i = 0; i < 16; ++i) sT[n * 130 + kq + 8 * i] = (bf16_t)(cvtpk(r[i], 0.f) & 0xffffu);
    __syncthreads();
    if (c.dst8) {
        const int nn = F.tid >> 3, k16 = (F.tid & 7) * 16; const bf16_t* s = sT + nn * 130 + k16; u32x4 w;
#pragma unroll
        for (int q = 0; q < 4; ++q) { const unsigned a = *(const unsigned*)(s + 4 * q), b = *(const unsigned*)(s + 4 * q + 2); int o = 0;
            o = __builtin_amdgcn_cvt_pk_fp8_f32(bflo(a) * WO8_SCALE, bfhi(a) * WO8_SCALE, o, false); o = __builtin_amdgcn_cvt_pk_fp8_f32(bflo(b) * WO8_SCALE, bfhi(b) * WO8_SCALE, o, true); w[q] = (unsigned)o; }
        stg<u32x4>(c.dst8 + (size_t)nn * c.lddst + k16, w);
    } else {
    const int kc = (F.tid & 15) * 8;
#pragma unroll
    for (int j = 0; j < 2; ++j) { const int nn = (F.tid >> 4) + 32 * j; const bf16_t* s = sT + nn * 130 + kc;
        u32x4 w; w.x = *(const unsigned*)(s); w.y = *(const unsigned*)(s + 2); w.z = *(const unsigned*)(s + 4); w.w = *(const unsigned*)(s + 6);
        stg<u32x4>(c.dst + (size_t)nn * c.lddst + kc, w); }
    }
    __syncthreads();
}
__device__ __forceinline__ void cvt_row_fp6(const f32x4 (&v)[8], unsigned char* dst, float* rsc, int lane) {
    float am = 0.f;
#pragma unroll
    for (int i = 0; i < 8; ++i) am = fmaxf(am, fmaxf(fmaxf(fabsf(v[i][0]), fabsf(v[i][1])), fmaxf(fabsf(v[i][2]), fabsf(v[i][3]))));
    am = fmaxf(am, shx<1>(am)); am = fmaxf(am, shx<2>(am)); am = fmaxf(am, shx<4>(am)); am = fmaxf(am, shx<8>(am)); am = fmaxf(am, shx<16>(am));
    am = fmaxf(am, shx32(am, lane >= 32));
    am = fmaxf(am, 1e-30f);
#if XFMT == 4
    const float sc4 = 6.0f / am;
    u32x4 p4;
#define E4(d, b) w = __builtin_amdgcn_cvt_scalef32_pk_fp4_f32(w, v[(8 * (d) + 2 * (b)) >> 2][(8 * (d) + 2 * (b)) & 3] * sc4, v[(8 * (d) + 2 * (b) + 1) >> 2][(8 * (d) + 2 * (b) + 1) & 3] * sc4, 1.0f, b)
#define E4D(d) { unsigned w = 0u; E4(d, 0); E4(d, 1); E4(d, 2); E4(d, 3); p4[d] = w; }
    E4D(0) E4D(1) E4D(2) E4D(3)
#undef E4
#undef E4D
    stg_nt<u32x4>(dst + lane * 16, p4);
    if (lane == 0) stg<float>(rsc, am * (1.f / 6.0f));
    return;
#endif
    const float sc = 7.0f / am;
    f32x16 a, b;
#pragma unroll
    for (int i = 0; i < 16; ++i) { a[i] = v[(2 * i) >> 2][(2 * i) & 3] * sc; b[i] = v[(2 * i + 1) >> 2][(2 * i + 1) & 3] * sc; }
    const u32x6 p = __builtin_amdgcn_cvt_scalef32_2xpk16_fp6_f32(a, b, 1.0f);
    stg<u32x2>(dst + lane * 24, (u32x2){p[0], p[1]}); stg<u32x2>(dst + lane * 24 + 8, (u32x2){p[2], p[3]}); stg<u32x2>(dst + lane * 24 + 16, (u32x2){p[4], p[5]});
    if (lane == 0) stg<float>(rsc, am * (1.f / 7.0f));
}
__device__ __forceinline__ void phase_convert(const Frame& F) {
    { const int total = DEPTH * CVT_TILES; int t = F.bid; float ra[16], rb[16];
      if (t < total) { const CvtTile c = cvt_decode(F, t); cvt_load(F, c, ra); }
      while (t < total) {
          int t2 = t + F.G; if (t2 < total) { const CvtTile c = cvt_decode(F, t2); cvt_load(F, c, rb); }
          { const CvtTile c = cvt_decode(F, t); cvt_store(F, c, ra); }
          t = t2; if (t >= total) break;
          t2 = t + F.G; if (t2 < total) { const CvtTile c = cvt_decode(F, t2); cvt_load(F, c, ra); }
          { const CvtTile c = cvt_decode(F, t); cvt_store(F, c, rb); }
          t = t2; } }
    { constexpr int NSTRIP = 12288 / 32, SP = 2056, NS = DEPTH * NSTRIP;
      bf16_t* sT = (bf16_t*)F.lds; float* sMax = (float*)(F.lds + 32 * SP * 2); float* sG = sMax + 512;
      const int n = F.tid & 31, kq = F.tid >> 5;
      for (int i = F.tid; i < DEPTH * DM; i += 512) sG[i] = ldg<float>(arg_in(F, I_NORM1) + i);
      __syncthreads();
      float ra[16], rb[16]; float am = 0.f; int sidx = F.bid, b = 0;
      const bool xm_ = (F.G & 7) == 0 && NS % F.G == 0;
#define SMAP(v_) (xm_ ? (((v_) % F.G) & 7) * (NS / 8) + ((v_) / F.G) * (F.G >> 3) + (((v_) % F.G) >> 3) : (v_))
#define WQ_LOAD(R, sx, bx) do { const int l_ = (sx) / NSTRIP, n0_ = ((sx) % NSTRIP) * 32; const float* W_ = arg_in(F, I_WIN) + (size_t)l_ * DM * INCOLS + (size_t)((bx) * 256 + kq) * INCOLS + n0_ + (n0_ >= 6144 ? 5 : 0) + n; \
          _Pragma("unroll") for (int i = 0; i < 16; ++i) R[i] = ldg_nt<float>(W_ + (size_t)(16 * i) * INCOLS); } while (0)
#define WQ_PROC(R, sx, bx) do { const int l_ = (sx) / NSTRIP, n0_ = ((sx) % NSTRIP) * 32, kb_ = (bx) * 256 + kq; \
          _Pragma("unroll") for (int i = 0; i < 16; ++i) { const float v_ = R[i] * sG[l_ * DM + kb_ + 16 * i]; am = fmaxf(am, fabsf(v_)); sT[n * SP + kb_ + 16 * i] = (bf16_t)(cvtpk(v_, 0.f) & 0xffffu); } \
          if ((bx) == 7) { sMax[kq * 32 + n] = am; am = 0.f; __syncthreads(); \
              unsigned char* W8_ = F.ws + WS_W0 + (size_t)l_ * WL_SIZE + WO_WIN8; float* WSC_ = (float*)(F.ws + WS_W0 + (size_t)l_ * WL_SIZE + WO_WSC); \
              _Pragma("unroll 2") for (int j = 0; j < 8; ++j) { const int row = (F.tid >> 7) + 4 * j, kc = (F.tid & 127) * 16; float m_ = 1e-30f; \
                  _Pragma("unroll") for (int q = 0; q < 16; ++q) m_ = fmaxf(m_, sMax[q * 32 + row]); \
                  const float inv_ = 127.0f / m_; const u32x4 w0 = *(const u32x4*)(sT + row * SP + kc), w1 = *(const u32x4*)(sT + row * SP + kc + 8); u32x4 o; \
                  o[0] = q8x4(bflo(w0[0]), bfhi(w0[0]), bflo(w0[1]), bfhi(w0[1]), inv_); o[1] = q8x4(bflo(w0[2]), bfhi(w0[2]), bflo(w0[3]), bfhi(w0[3]), inv_); \
                  o[2] = q8x4(bflo(w1[0]), bfhi(w1[0]), bflo(w1[1]), bfhi(w1[1]), inv_); o[3] = q8x4(bflo(w1[2]), bfhi(w1[2]), bflo(w1[3]), bfhi(w1[3]), inv_); \
                  stg<u32x4>(W8_ + (size_t)(n0_ + row) * 2048 + kc, o); if ((F.tid & 127) == 0) stg<float>(WSC_ + n0_ + row, m_ * (1.0f / 127.0f)); } \
              __syncthreads(); } } while (0)
      if (sidx < NS) WQ_LOAD(ra, SMAP(sidx), 0);
      while (sidx < NS) {
          int s2 = sidx, b2 = b + 1; if (b2 == 8) { b2 = 0; s2 = sidx + F.G; }
          if (s2 < NS) WQ_LOAD(rb, SMAP(s2), b2);
          WQ_PROC(ra, SMAP(sidx), b);
          sidx = s2; b = b2; if (sidx >= NS) break;
          s2 = sidx; b2 = b + 1; if (b2 == 8) { b2 = 0; s2 = sidx + F.G; }
          if (s2 < NS) WQ_LOAD(ra, SMAP(s2), b2);
          WQ_PROC(rb, SMAP(sidx), b);
          sidx = s2; b = b2; }
#undef SMAP
#undef WQ_LOAD
#undef WQ_PROC
    }
    const size_t gt = (size_t)F.bid * 512 + F.tid, GT = (size_t)F.G * 512;
#pragma unroll 1
    for (int l = 0; l < DEPTH; ++l) {
        unsigned char* ws = F.ws + WS_W0 + (size_t)l * WL_SIZE;
        const float* w_in = arg_in(F, I_WIN) + (size_t)l * DM * INCOLS;
        if (MF8_LAYER(l)) {
            for (size_t i = gt; i < (size_t)2 * 2048 * 8; i += GT) { const int which = (int)(i / (2048 * 8)), r = (int)((i / 8) % 2048), c = (int)(i % 8);
                unsigned char* p = ws + WO_WBR_T + (size_t)(1 + which) * 2048 * 768 + (size_t)r * 768 + (which == 0 ? 640 : 0) + c * 16;
                stg<u32x4>(p, zero4()); }
        } else
        for (size_t i = gt; i < (size_t)2 * 2048 * 16; i += GT) { const int which = (int)(i / (2048 * 16)), r = (int)((i / 16) % 2048), c = (int)(i % 16);
            bf16_t* p = (bf16_t*)(ws + WO_WBR_T) + (size_t)(1 + which) * 2048 * 768 + (size_t)r * 768 + 640 + c * 8;
            stg<u32x4>(p, zero4()); }
        for (size_t i = gt; i < (size_t)5 * 2048; i += GT) { const int c = (int)(i / 2048), k = (int)(i % 2048); stg<float>((float*)(ws + WO_WF) + i, ldg<float>(w_in + (size_t)k * INCOLS + 6144 + c) * ldg<float>(arg_in(F, I_NORM1) + l * DM + k)); }
        { const float* s = arg_in(F, I_PSK) + (size_t)l * 262144; bf16_t* d = (bf16_t*)(ws + WO_SK);
          for (size_t i = gt; i < (size_t)262144 / 8; i += GT) { const f32x4 a = ldg<f32x4>(s + i * 8), b = ldg<f32x4>(s + i * 8 + 4); stg<bf16x8>(d + i * 8, pack8(a, b)); } }
    }
#ifdef TAB1
    for (int R = F.gw; R < DEPTH * 2 * 16384; R += F.GW) {
        const int R2 = R; const bool two = false;
#else
    for (int R = F.gw; R < DEPTH * 2 * 16384; R += 2 * F.GW) {
        const int R2 = R + F.GW; const bool two = R2 < DEPTH * 2 * 16384;
#endif
        const int q1 = R >> 14, r1 = R & 16383, q2 = two ? (R2 >> 14) : q1, r2 = two ? (R2 & 16383) : r1;
        const float* s1 = ((q1 & 1) ? arg_in(F, I_PV) : arg_in(F, I_PU)) + ((size_t)(q1 >> 1) * 16384 + r1) * 2048;
        const float* s2 = ((q2 & 1) ? arg_in(F, I_PV) : arg_in(F, I_PU)) + ((size_t)(q2 >> 1) * 16384 + r2) * 2048;
        f32x4 va[8], vb[8];
#pragma unroll
        for (int i = 0; i < 8; ++i) va[i] = ldg_nt<f32x4>(s1 + i * 256 + F.lane * 4);
#ifndef TAB1
#pragma unroll
        for (int i = 0; i < 8; ++i) vb[i] = ldg_nt<f32x4>(s2 + i * 256 + F.lane * 4);
#endif
        if (!(q1 & 1)) { const float* g2 = arg_in(F, I_NORM2) + (q1 >> 1) * DM;
#pragma unroll
            for (int i = 0; i < 8; ++i) va[i] = va[i] * ldg<f32x4>(g2 + i * 256 + F.lane * 4); }
        if (two && !(q2 & 1)) { const float* g2 = arg_in(F, I_NORM2) + (q2 >> 1) * DM;
#pragma unroll
            for (int i = 0; i < 8; ++i) vb[i] = vb[i] * ldg<f32x4>(g2 + i * 256 + F.lane * 4); }
        { unsigned char* wl = F.ws + WS_W0 + (size_t)(q1 >> 1) * WL_SIZE; cvt_row_fp6(va, wl + ((q1 & 1) ? WO_V : WO_U) + (size_t)r1 * XROW, (float*)(wl + ((q1 & 1) ? WO_VSC : WO_USC)) + r1, F.lane); }
        if (two) { unsigned char* wl = F.ws + WS_W0 + (size_t)(q2 >> 1) * WL_SIZE; cvt_row_fp6(vb, wl + ((q2 & 1) ? WO_V : WO_U) + (size_t)r2 * XROW, (float*)(wl + ((q2 & 1) ? WO_VSC : WO_USC)) + r2, F.lane); }
    }
}

__device__ __forceinline__ void phase_norm(const Frame& F, const float* x, const float* bforget, const float* w_in, const float* g1) {
    unsigned char* H8 = F.ws + WS_H8; float* LOGF = (float*)(F.ws + WS_LOGF);
    const float* wfl = (const float*)F.lds;
    for (int i = F.tid; i < 5 * 2048; i += 512) { const int c = i >> 11, k = i & 2047; ((float*)F.lds)[i] = ldg<float>(w_in + (size_t)k * INCOLS + 6144 + c) * ldg<float>(g1 + k); }
    __syncthreads();
    for (int t = F.gw; t < T_TOK; t += F.GW) {
        const float* xr = x + (size_t)t * DM; f32x4 v[8]; float ss = 0.f;
#pragma unroll
        for (int i = 0; i < 8; ++i) { v[i] = ldg_nt<f32x4>(xr + i * 256 + F.lane * 4); ss += v[i][0] * v[i][0] + v[i][1] * v[i][1] + v[i][2] * v[i][2] + v[i][3] * v[i][3]; }
        ss = wave_sum(ss); const float rstd = rsqrtf(ss * (1.f / DM) + NORM_EPS);
        float am = 1e-30f;
#pragma unroll
        for (int i = 0; i < 8; ++i) am = fmaxf(am, fmaxf(fmaxf(fabsf(v[i][0]), fabsf(v[i][1])), fmaxf(fabsf(v[i][2]), fabsf(v[i][3]))));
        am = wave_max(am); const float inv = 127.0f / am;
#pragma unroll
        for (int i = 0; i < 8; ++i) stg<unsigned>(H8 + (size_t)t * DM + i * 256 + F.lane * 4, q8x4(v[i][0], v[i][1], v[i][2], v[i][3], inv));
        if (F.lane == 0) stg<float>(LOGF + t * 8 + 5, rstd * am * (1.0f / 127.0f));
#pragma unroll
        for (int c = 0; c < 5; ++c) { float d = 0.f;
#pragma unroll
            for (int i = 0; i < 8; ++i) { const f32x4 wv = *(const f32x4*)(wfl + c * 2048 + i * 256 + F.lane * 4); d += v[i][0] * wv[0] + v[i][1] * wv[1] + v[i][2] * wv[2] + v[i][3] * wv[3]; }
            d = wave_sum(d) * rstd;
            if (F.lane == 0) { const float z = d + ldg<float>(bforget + c); stg<float>(LOGF + t * 8 + c, fminf(z, 0.f) - log1pf(__expf(-fabsf(z)))); } }
    }
}

struct PrepP { const float* aqn; const float* akn; const float* bqn; const float* bkn; const float* cqn; const float* ckn; };
__device__ __forceinline__ void unpack8(const u32x4 w, float* x) { x[0] = bflo(w[0]); x[1] = bfhi(w[0]); x[2] = bflo(w[1]); x[3] = bfhi(w[1]); x[4] = bflo(w[2]); x[5] = bfhi(w[2]); x[6] = bflo(w[3]); x[7] = bfhi(w[3]); }
__device__ __forceinline__ u32x4 pack8u(const float* x) { return (u32x4){cvtpk(x[0], x[1]), cvtpk(x[2], x[3]), cvtpk(x[4], x[5]), cvtpk(x[6], x[7])}; }
template <int NDIM, bool ROPE>
__device__ __forceinline__ u32x4 qk_unit(const u32x4 raw, const float* gain, int li, int s, const LAS double* invrev, float qs) {
    float x[8]; unpack8(raw, x);
    float ss = 0.f;
#pragma unroll
    for (int e = 0; e < 8; ++e) ss += x[e] * x[e];
    ss += shx<1>(ss); ss += shx<2>(ss); ss += shx<4>(ss); if (NDIM == 128) ss += shx<8>(ss);
    const float rstd = rsqrtf(ss * (1.f / NDIM) + NORM_EPS);
    const int lu = NDIM == 128 ? li : (li & 7);
    const f32x4 g0 = ldg<f32x4>(gain + lu * 8), g1 = ldg<f32x4>(gain + lu * 8 + 4);
    x[0] *= rstd * g0[0]; x[1] *= rstd * g0[1]; x[2] *= rstd * g0[2]; x[3] *= rstd * g0[3]; x[4] *= rstd * g1[0]; x[5] *= rstd * g1[1]; x[6] *= rstd * g1[2]; x[7] *= rstd * g1[3];
    if (ROPE) {
        constexpr int PX = NDIM == 128 ? 2 : 1;
        const bool inrope = lu < 2 * PX, first = lu < PX;
#pragma unroll
        for (int e = 0; e < 8; ++e) {
            const float p = shx<PX>(x[e]);
            const double ir = NDIM == 128 ? ((lu & 1) ? invrev[8 + e] : invrev[e]) : invrev[2 * e];
            const double rev = (double)s * ir; const float fr = (float)(rev - floor(rev));
            const float c = __builtin_amdgcn_cosf(fr), sn = __builtin_amdgcn_sinf(fr);
            const float r = first ? (x[e] * c - p * sn) : (x[e] * c + p * sn);
            x[e] = inrope ? r : x[e];
        }
    }
#pragma unroll
    for (int e = 0; e < 8; ++e) x[e] *= qs;
    return pack8u(x);
}
__device__ __forceinline__ void phase_prep(const Frame& F, int l) {
    const LAS double* invrev = arg_invrev(F);
    unsigned char* ws = F.ws;
    const bf16_t* PROJ = (const bf16_t*)(ws + WS_PROJ);
    const float* aqn = arg_in(F, I_AQN) + l * 64; const float* akn = arg_in(F, I_AKN) + l * 64;
    const float* bqn = arg_in(F, I_BQN) + l * 128; const float* bkn = arg_in(F, I_BKN) + l * 128; const float* cqn = arg_in(F, I_CQN) + l * 128; const float* ckn = arg_in(F, I_CKN) + l * 128;
    const float QS64 = 0.125f * LOG2E, QS128 = 0.08838834764831845f * LOG2E;
    const int gq = F.lane >> 4, li = F.lane & 15;
    const bool wgred = F.GW * 4 == T_TOK;
    for (int t0 = F.gw * 4; t0 < T_TOK; t0 += F.GW * 4) {
        const int t = t0 + gq, b = t >> 12, s = t & 4095;
        const bf16_t* row = PROJ + (size_t)t * PQ + li * 8;
        u32x4 rawall[48];
#pragma unroll
        for (int u = 0; u < 48; ++u) { const bool isv = (u >= 12 && u < 18) || (u >= 28 && u < 33) || u >= 43;
            if (!isv) rawall[u] = ldg_nt<u32x4>(row + u * 128); }
#pragma unroll
        for (int batch = 0; batch < 4; ++batch) {
            u32x4* raw = rawall + batch * 12;
#pragma unroll
            for (int j = 0; j < 12; ++j) {
                const int u = batch * 12 + j;
                if (u < 6) {
                    const u32x4 o = qk_unit<64, true>(raw[j], aqn, li, s, invrev, QS64);
                    bf16_t* d = (bf16_t*)(ws + WS_QA) + ((size_t)(b * 12 + u * 2 + (li >> 3)) * 4096 + s) * 64 + (li & 7) * 8;
                    stg<u32x4>(d, o);
                } else if (u < 12) {
                    const u32x4 o = qk_unit<64, true>(raw[j], akn, li, s, invrev, 1.f);
                    bf16_t* d = (bf16_t*)(ws + WS_KA) + ((size_t)(b * 12 + (u - 6) * 2 + (li >> 3)) * 4096 + s) * 64 + (li & 7) * 8;
                    stg<u32x4>(d, o);
                } else if (u < 18) {
                } else if (u < 23) {
                    stg<u32x4>((bf16_t*)(ws + WS_QB) + ((size_t)(b * 5 + (u - 18)) * 4096 + s) * 128 + li * 8, qk_unit<128, true>(raw[j], bqn, li, s, invrev, QS128));
                } else if (u < 28) {
                    const u32x4 o = qk_unit<128, true>(raw[j], bkn, li, s, invrev, 1.f);
                    stg<u32x4>((bf16_t*)(ws + WS_KB) + ((size_t)(b * 5 + (u - 23)) * 4096 + s) * 128 + li * 8, o);
                    { float kv[8]; unpack8(o, kv); int* ksum = (int*)(ws + WS_KSUM) + ((size_t)(b * 5 + (u - 23)) * 16 + (s >> 8)) * 128 + li * 8;
                      float* skw = (float*)(F.lds + 8192) + (F.wave * 5 + (u - 23)) * 128 + li * 8;
#pragma unroll
                      for (int e = 0; e < 8; ++e) { float v = kv[e]; v += shx<16>(v); v = sum32(v);
                          if (F.lane < 16) { if (wgred) skw[e] = v; else atomicAdd(ksum + e, (int)rintf(v * 262144.f)); } } }
                } else if (u < 33) {
                } else if (u < 38) {
                    stg<u32x4>((bf16_t*)(ws + WS_QC) + ((size_t)(b * 5 + (u - 33)) * 4096 + s) * 128 + li * 8, qk_unit<128, false>(raw[j], cqn, li, s, invrev, QS128));
                } else if (u < 43) {
                    stg<u32x4>((bf16_t*)(ws + WS_KC) + ((size_t)(b * 5 + (u - 38)) * 4096 + s) * 128 + li * 8, qk_unit<128, false>(raw[j], ckn, li, s, invrev, 1.f));
                } else {
                }
            }
        }
    }
    if (wgred) {
        __syncthreads();
        const int tw = F.bid * 32, bb = tw >> 12, blk = (tw & 4095) >> 8; const float* sk = (const float*)(F.lds + 8192);
        for (int i = F.tid; i < 5 * 128; i += 512) { float v = 0.f;
#pragma unroll
            for (int w = 0; w < 8; ++w) v += sk[w * 640 + i];
            atomicAdd((int*)(ws + WS_KSUM) + ((size_t)(bb * 5 + i / 128) * 16 + blk) * 128 + (i & 127), (int)rintf(v * 262144.f)); }
        __syncthreads();
    }
    for (int i = F.bid * 512 + F.tid; i < T_TOK; i += F.G * 512) stg<unsigned long long>((unsigned long long*)(ws + WS_ROWSS) + i, 0ull);
    if (F.bid < 10) {
        const int b = F.bid / 5, h = F.bid % 5; const float* LOGF = (const float*)(ws + WS_LOGF); float* CB = (float*)(ws + WS_CB) + (size_t)F.bid * 4096;
        double* sd = (double*)F.lds;
        double loc[8]; double run = 0.0;
#pragma unroll
        for (int i = 0; i < 8; ++i) { run += (double)ldg<float>(LOGF + (size_t)(b * 4096 + F.tid * 8 + i) * 8 + h); loc[i] = run; }
        sd[F.tid] = run; __syncthreads();
        if (F.tid < 64) { double acc = 0.0;
#pragma unroll
            for (int i = 0; i < 8; ++i) { const double v = sd[F.tid * 8 + i]; sd[F.tid * 8 + i] = acc; acc += v; }
            sd[512 + F.tid] = acc; }
        __syncthreads();
        if (F.tid == 0) { double acc = 0.0; for (int i = 0; i < 64; ++i) { const double v = sd[512 + i]; sd[512 + i] = acc; acc += v; } }
        __syncthreads();
        const double base = sd[F.tid] + sd[512 + (F.tid >> 3)];
#pragma unroll
        for (int i = 0; i < 8; ++i) stg<float>(CB + F.tid * 8 + i, (float)(base + loc[i]));
        __syncthreads();
    }
}

constexpr int ATT_ITEMS = 44 * 16;
__device__ __forceinline__ float att_thresh(const float* gq, const float* gk, int lane) {
    float a = fmaxf(fabsf(ldg<float>(gq + lane)), fabsf(ldg<float>(gq + 64 + lane))), b = fmaxf(fabsf(ldg<float>(gk + lane)), fabsf(ldg<float>(gk + 64 + lane)));
    a = fmaxf(a, shx<1>(a)); a = fmaxf(a, shx<2>(a)); a = fmaxf(a, shx<4>(a)); a = fmaxf(a, shx<8>(a)); a = fmaxf(a, shx<16>(a)); a = fmaxf(a, shx32(a, lane >= 32));
    b = fmaxf(b, shx<1>(b)); b = fmaxf(b, shx<2>(b)); b = fmaxf(b, shx<4>(b)); b = fmaxf(b, shx<8>(b)); b = fmaxf(b, shx<16>(b)); b = fmaxf(b, shx32(b, lane >= 32));
    return __int_as_float(__builtin_amdgcn_readfirstlane(__float_as_int(2.f * (16.65f * a * b) + 40.f)));
}
__device__ __forceinline__ int att_jlo(const float* cb, int P0, float thresh, int) {
    int lane = threadIdx.x; asm volatile("" : "+v"(lane)); lane &= 63;
    const int nt0 = P0 / 64;
    bool need = true;
    if (lane < nt0) need = (ldg<float>(cb + P0) - ldg<float>(cb + lane * 64 + 63)) * LOG2E >= -thresh;
    const unsigned long long m = __ballot(need);
    return __builtin_amdgcn_readfirstlane((int)__builtin_ctzll(m));
}
__device__ __forceinline__ att::BlockRef att_item(unsigned char* ws, unsigned char* lds, int idx, int lane) {
    asm volatile("" : "+s"(ws));
    int qb, c; if (idx < 34 * 16) { qb = 15 - idx / 34; c = idx % 34; } else { const int j = idx - 34 * 16; qb = 15 - j / 10; c = 34 + j % 10; }
    att::BlockRef r; r.P0 = qb * 256; r.cb = nullptr; r.jlo = 0;
    r.kp = 128;
    if (c < 24) { const int b = c / 12, hs = c % 12; const size_t ho = ((size_t)(b * 12 + hs) * 4096) * 64; r.kp = 64;
        r.Q = (const bf16_t*)(ws + WS_QA) + ho + (size_t)r.P0 * 64; r.K = (const bf16_t*)(ws + WS_KA) + ho; r.V = (const bf16_t*)(ws + WS_VA) + ((size_t)(b * 6 + hs / 2) * 4096) * 128;
        r.O = (bf16_t*)(ws + WS_OA) + (size_t)(hs & 1) * T_TOK * 768 + ((size_t)b * 4096 + r.P0) * 768 + (hs / 2) * 128; r.ldo = 768; r.mode = 0;
    } else if (c < 34) { const int b = (c - 24) / 5, h = (c - 24) % 5; const size_t ho = ((size_t)(b * 5 + h) * 4096) * 128;
        r.Q = (const bf16_t*)(ws + WS_QB) + ho + (size_t)r.P0 * 128; r.K = (const bf16_t*)(ws + WS_KB) + ho; r.V = (const bf16_t*)(ws + WS_VB) + ho;
        r.O = (bf16_t*)(ws + WS_YCAT) + ((size_t)b * 4096 + r.P0) * 2048 + 768 + h * 128; r.ldo = 2048; r.mode = 1;
        if (*(volatile int*)(lds + att::OFF_MISC + 24)) { r.o8 = 1; r.O = (bf16_t*)(ws + WS_YCAT + ((size_t)b * 4096 + r.P0) * 2048 + 768 + h * 128); }     r.cb = (const float*)(ws + WS_KSUM) + (size_t)(b * 5 + h) * 16 * 128;
    } else { const int b = (c - 34) / 5, h = (c - 34) % 5; const size_t ho = ((size_t)(b * 5 + h) * 4096) * 128;
        r.Q = (const bf16_t*)(ws + WS_QC) + ho + (size_t)r.P0 * 128; r.K = (const bf16_t*)(ws + WS_KC) + ho; r.V = (const bf16_t*)(ws + WS_VC) + ho;
        r.O = (bf16_t*)(ws + WS_YCAT) + ((size_t)b * 4096 + r.P0) * 2048 + 1408 + h * 128; r.ldo = 2048; r.mode = 2;
        if (*(volatile int*)(lds + att::OFF_MISC + 24)) { r.o8 = 1; r.O = (bf16_t*)(ws + WS_YCAT + ((size_t)b * 4096 + r.P0) * 2048 + 1408 + h * 128); } r.cb = (const float*)(ws + WS_CB) + (size_t)(b * 5 + h) * 4096; r.jlo = att_jlo(r.cb, r.P0, *(volatile float*)(lds + att::OFF_MISC + 16), lane);
    }
    return r;
}
__device__ __forceinline__ int queue_fetch(const Frame& F, unsigned* ctr) {
    volatile int* slot = (volatile int*)(F.lds + att::OFF_MISC);
    int tid = threadIdx.x; asm volatile("" : "+v"(tid));
    if (tid == 0) *slot = (int)atomicAdd(ctr, 1u);
    __syncthreads();
    const int v = __builtin_amdgcn_readfirstlane(*slot);
    __syncthreads();
    return v;
}
__device__ __forceinline__ void phase_attention(const Frame& F, int slot, const float* gq, const float* gk, int y8) {
    unsigned* ctr = (unsigned*)(F.ws + WS_CTL) + 16 + slot;
    { const float th_ = att_thresh(gq, gk, F.lane); if (F.tid == 0) { *(volatile float*)(F.lds + att::OFF_MISC + 16) = th_; *(volatile int*)(F.lds + att::OFF_MISC + 24) = y8; } }
    __syncthreads();
    int ci, ni = 0;
    if (F.G <= ATT_ITEMS) ci = F.bid; else { ci = queue_fetch(F, ctr); if (ci >= ATT_ITEMS) return; }
    const int qbase = (F.G <= ATT_ITEMS) ? F.G : 0;
    att::Seam S;
    { const att::BlockRef cur = att_item(F.ws, F.lds, ci, F.lane); att::attn_prime(cur, (char*)F.lds, S); }
    for (;;) {
        const att::BlockRef cur = att_item(F.ws, F.lds, ci, F.lane);
        att::attn_block(cur, [&]() { ni = qbase + queue_fetch(F, ctr); return att_item(F.ws, F.lds, ni < ATT_ITEMS ? ni : ci, 0); }, (char*)F.lds, S);
        if (ni >= ATT_ITEMS) break;
        ci = ni;
    }
}

__device__ __forceinline__ void phase_postA(const Frame& F, int l, int y8) {
    const float lam_init = l == 0 ? 0.2f : 0.35550906759931f;
    const float* lq1 = arg_in(F, I_LQ1) + l * 64; const float* lk1 = arg_in(F, I_LK1) + l * 64; const float* lq2 = arg_in(F, I_LQ2) + l * 64; const float* lk2 = arg_in(F, I_LK2) + l * 64;
    const float d1 = wave_sum(ldg<float>(lq1 + F.lane) * ldg<float>(lk1 + F.lane)), d2 = wave_sum(ldg<float>(lq2 + F.lane) * ldg<float>(lk2 + F.lane));
    const float lam = __expf(d1) - __expf(d2) + lam_init;
    const float* gon = arg_in(F, I_AON) + l * 128;
    const bf16_t* O1 = (const bf16_t*)(F.ws + WS_OA); const bf16_t* O2 = O1 + (size_t)T_TOK * 768; bf16_t* Y = (bf16_t*)(F.ws + WS_YCAT);
    const int li = F.lane & 15, gq = F.lane >> 4;
    const f32x4 g0 = ldg<f32x4>(gon + li * 8), g1 = ldg<f32x4>(gon + li * 8 + 4);
    for (int ub = F.gw * 4; ub < T_TOK * 6; ub += F.GW * 4 * 6) {
      u32x4 ra[6], rc[6];
#pragma unroll
      for (int q = 0; q < 6; ++q) { const int u0 = ub + q * F.GW * 4; if (u0 < T_TOK * 6) { const int u = u0 + gq, t = u / 6, h = u % 6;
          ra[q] = ldg_nt<u32x4>(O1 + (size_t)t * 768 + h * 128 + li * 8); rc[q] = ldg_nt<u32x4>(O2 + (size_t)t * 768 + h * 128 + li * 8); } }
#pragma unroll
      for (int q = 0; q < 6; ++q) { const int u0 = ub + q * F.GW * 4; if (u0 >= T_TOK * 6) break;
        const int u = u0 + gq, t = u / 6, h = u % 6;
        float a[8], c[8]; unpack8(ra[q], a); unpack8(rc[q], c);
        float ss = 0.f;
#pragma unroll
        for (int e = 0; e < 8; ++e) { a[e] = a[e] - lam * c[e]; ss += a[e] * a[e]; }
        ss += shx<1>(ss); ss += shx<2>(ss); ss += shx<4>(ss); ss += shx<8>(ss);
        const float sc = rsqrtf(ss * (1.f / 128) + NORM_EPS) * (1.f - lam_init);
        a[0] *= sc * g0[0]; a[1] *= sc * g0[1]; a[2] *= sc * g0[2]; a[3] *= sc * g0[3]; a[4] *= sc * g1[0]; a[5] *= sc * g1[1]; a[6] *= sc * g1[2]; a[7] *= sc * g1[3];
        if (y8) { int o0 = 0, o1 = 0;
            o0 = __builtin_amdgcn_cvt_pk_fp8_f32(a[0] * Y8_SCALE, a[1] * Y8_SCALE, o0, false); o0 = __builtin_amdgcn_cvt_pk_fp8_f32(a[2] * Y8_SCALE, a[3] * Y8_SCALE, o0, true);
            o1 = __builtin_amdgcn_cvt_pk_fp8_f32(a[4] * Y8_SCALE, a[5] * Y8_SCALE, o1, false); o1 = __builtin_amdgcn_cvt_pk_fp8_f32(a[6] * Y8_SCALE, a[7] * Y8_SCALE, o1, true);
            stg<u32x2>((unsigned char*)Y + (size_t)t * 2048 + h * 128 + li * 8, (u32x2){(unsigned)o0, (unsigned)o1}); }
        else stg<u32x4>(Y + (size_t)t * 2048 + h * 128 + li * 8, pack8u(a));
      }
    }
}

__device__ __forceinline__ int f2sort(float f) { const int b = __float_as_int(f); return b ^ ((b >> 31) & 0x7fffffff); }
__device__ __forceinline__ float sort2f(int s) { return __int_as_float(s ^ ((s >> 31) & 0x7fffffff)); }
__device__ __forceinline__ void ce_desc(int& a, int& b) { const int hi = max(a, b), lo = min(a, b); a = hi; b = lo; }
template <int N> __device__ __forceinline__ void bitonic_sort_desc(int* a) {
#pragma unroll
    for (int k = 2; k <= N; k <<= 1)
#pragma unroll
        for (int j = k >> 1; j > 0; j >>= 1)
#pragma unroll
            for (int i = 0; i < N; ++i) { const int l = i ^ j; if (l > i) { if ((i & k) == 0) ce_desc(a[i], a[l]); else ce_desc(a[l], a[i]); } }
}
template <int N> __device__ __forceinline__ void bitonic_merge_desc(int* c) {
#pragma unroll
    for (int j = N >> 1; j > 0; j >>= 1)
#pragma unroll
        for (int i = 0; i < N; ++i) { const int l = i ^ j; if (l > i) ce_desc(c[i], c[l]); }
}
__device__ __forceinline__ void top16_merge(int* a, const int* b) {
#pragma unroll
    for (int i = 0; i < 16; ++i) a[i] = max(a[i], b[15 - i]);
    bitonic_merge_desc<16>(a);
}
__device__ __forceinline__ void top16_of_64(int* key) {
    bitonic_sort_desc<16>(key); bitonic_sort_desc<16>(key + 16); bitonic_sort_desc<16>(key + 32); bitonic_sort_desc<16>(key + 48);
    top16_merge(key, key + 16); top16_merge(key + 32, key + 48); top16_merge(key, key + 32);
}
__device__ __forceinline__ void phase_topk(const Frame& F, const unsigned char* wl) {
    const bf16_t* QP = (const bf16_t*)(F.ws + WS_QP); const bf16_t* SK = (const bf16_t*)(wl + WO_SK);
    int* PIDX = (int*)(F.ws + WS_PIDX); float* PGATE = (float*)(F.ws + WS_PGATE);
    const int r32 = F.lane & 31, hi = F.lane >> 5;
    const int IMIN = (int)0x80000000;
    pg8::TileOrder ord; ord.init(T_TOK, 2048, F.G, F.bid);
    for (int it = 0;; ++it) {
        int tt, h; if (!ord.tile(it, tt, h)) break;
        const int t = tt * 256 + F.wave * 32 + r32;
        __syncthreads();
#pragma unroll
        for (int i = 0; i < 8; ++i) { const int cidx = F.tid + 512 * i;
            const int pp = cidx >> 11, n = (cidx >> 4) & 127, ch = cidx & 15;
            const u32x4 w = ldg<u32x4>(SK + ((size_t)((h * 2 + pp) * 128 + n)) * 128 + ch * 8);
            *(u32x4*)(F.lds + pp * 32768 + n * 256 + ((ch ^ (n & 15)) << 4)) = w; }
        __syncthreads();
        int kk[2][16];
#pragma unroll
        for (int p = 0; p < 2; ++p) {
            bf16x8 qf[8];
#pragma unroll
            for (int ks = 0; ks < 8; ++ks) qf[ks] = ldg<bf16x8>(QP + (size_t)(tt * 8 + h) * 65536 + (size_t)(((((F.wave * 2 + p) * 8 + ks) * 2 + hi) * 32 + r32) * 8));
            f32x16 acc[4];
#pragma unroll
            for (int nb = 0; nb < 4; ++nb) { acc[nb] = f32x16{};
#pragma unroll
                for (int ks = 0; ks < 8; ++ks) { const int n = nb * 32 + r32; const bf16x8 kf = *(const bf16x8*)(F.lds + p * 32768 + n * 256 + (((ks * 2 + hi) ^ (n & 15)) << 4));
                    acc[nb] = __builtin_amdgcn_mfma_f32_32x32x16_bf16(kf, qf[ks], acc[nb], 0, 0, 0); } }
            int key[64];
#pragma unroll
            for (int nb = 0; nb < 4; ++nb)
#pragma unroll
                for (int r = 0; r < 16; ++r) { const int n = nb * 32 + (r & 3) + 8 * (r >> 2) + 4 * hi; key[nb * 16 + r] = (f2sort(acc[nb][r]) & ~127) | n; }
            top16_of_64(key);
            { int other[16];
#pragma unroll
              for (int i = 0; i < 16; ++i) { auto rr = __builtin_amdgcn_permlane32_swap((unsigned)key[i], (unsigned)key[i], false, false); other[i] = hi ? (int)rr[0] : (int)rr[1]; }
              top16_merge(key, other); }
#pragma unroll
            for (int i = 0; i < 16; ++i) kk[p][i] = key[i];
        }
        float vA[16], vB[16];
#pragma unroll
        for (int i = 0; i < 16; ++i) { vA[i] = sort2f(kk[0][i] & ~127); vB[i] = sort2f(kk[1][i] & ~127); }
        int cand[64]; int cnt = 0;
#pragma unroll
        for (int i = 0; i < 16; ++i)
#pragma unroll
            for (int j = 0; j < 16; ++j) if ((i + 1) * (j + 1) <= 16) { cand[cnt] = (f2sort(vA[i] + vB[j]) & ~255) | (i * 16 + j); ++cnt; }
#pragma unroll
        for (int i = 50; i < 64; ++i) cand[i] = IMIN;
        top16_of_64(cand);
        int top[16];
#pragma unroll
        for (int i = 0; i < 16; ++i) top[i] = cand[i];
        int ex[16]; float ev[16]; float esum = 0.f;
        const float vmax = sort2f(top[0] & ~255);
#pragma unroll
        for (int k = 0; k < 16; ++k) {
            const int ij = top[k] & 255, i = ij >> 4, j = ij & 15;
            int na = 0, nbv = 0;
#pragma unroll
            for (int q = 0; q < 16; ++q) { na = (i == q) ? kk[0][q] : na; nbv = (j == q) ? kk[1][q] : nbv; }
            ex[k] = (na & 127) * 128 + (nbv & 127);
            ev[k] = __expf(sort2f(top[k] & ~255) - vmax); esum += ev[k];
        }
        const float inv = 1.f / esum;
        int oi[8]; float og[8];
#pragma unroll
        for (int k = 0; k < 8; ++k) { oi[k] = hi ? ex[8 + k] : ex[k]; og[k] = (hi ? ev[8 + k] : ev[k]) * inv; }
        int* pi = PIDX + (size_t)t * 128 + h * 16 + hi * 8; float* pg = PGATE + (size_t)t * 128 + h * 16 + hi * 8;
        stg<u32x4>(pi, (u32x4){(unsigned)oi[0], (unsigned)oi[1], (unsigned)oi[2], (unsigned)oi[3]}); stg<u32x4>(pi + 4, (u32x4){(unsigned)oi[4], (unsigned)oi[5], (unsigned)oi[6], (unsigned)oi[7]});
        stg<f32x4>(pg, (f32x4){og[0], og[1], og[2], og[3]}); stg<f32x4>(pg + 4, (f32x4){og[4], og[5], og[6], og[7]});
    }
}

__device__ __forceinline__ float dot8(const u32x4 a, const u32x4 b, float c) {
#pragma unroll
    for (int i = 0; i < 4; ++i) { c = fmaf(bflo(a[i]), bflo(b[i]), c); c = fmaf(bfhi(a[i]), bfhi(b[i]), c); }
    return c;
}
template <int M> __device__ __forceinline__ int xchg_i(int v, bool upper) {
    if constexpr (M < 32) return __builtin_amdgcn_ds_swizzle(v, (M << 10) | 0x1f);
    else { auto rr = __builtin_amdgcn_permlane32_swap((unsigned)v, (unsigned)v, false, false); return (int)(upper ? rr[0] : rr[1]); } }
template <int M> __device__ __forceinline__ float xchg_f(float v, bool upper) { return __int_as_float(xchg_i<M>(__float_as_int(v), upper)); }
__device__ __forceinline__ void phase_gather(const Frame& F, const float* xres, float* xout, const unsigned char* wl, const float* nxt_g1, const float* nxt_bf, const float* nxt_wf) {
    const bf16_t* H = (const bf16_t*)(F.ws + WS_HG); const unsigned long long* ROWSS = (const unsigned long long*)(F.ws + WS_ROWSS); const unsigned char* U = wl + WO_U; const unsigned char* V = wl + WO_V;
    const float* USC = (const float*)(wl + WO_USC); const float* VSC = (const float*)(wl + WO_VSC);
    const int* PIDX = (const int*)(F.ws + WS_PIDX); const float* PGATE = (const float*)(F.ws + WS_PGATE);
    const int lane = F.lane; const bool b5 = (lane >> 5) & 1, b4 = (lane >> 4) & 1;
    const float* wfl = (const float*)F.lds;
    if (nxt_bf) { for (int i = F.tid; i < 5 * 2048 / 4; i += 512) *(f32x4*)(F.lds + i * 16) = ldg<f32x4>(nxt_wf + i * 4); __syncthreads(); }
    u32x2 nxw[8]; int nid0, nid1; float ngg0, ngg1; unsigned long long nss;
#define GT_PREF(tt_) do { _Pragma("unroll") for (int i = 0; i < 8; ++i) nxw[i] = ldg_nt<u32x2>(H + (size_t)(tt_) * DM + i * 256 + lane * 4); \
        nid0 = ldg_nt<int>(PIDX + (size_t)(tt_) * 128 + lane); nid1 = ldg_nt<int>(PIDX + (size_t)(tt_) * 128 + 64 + lane); \
        ngg0 = ldg_nt<float>(PGATE + (size_t)(tt_) * 128 + lane); ngg1 = ldg_nt<float>(PGATE + (size_t)(tt_) * 128 + 64 + lane); nss = ldg<unsigned long long>(ROWSS + (tt_)); } while (0)
    if (F.gw < T_TOK) GT_PREF(F.gw);
    for (int t = F.gw; t < T_TOK; t += F.GW) {
        float x[32];
#pragma unroll
        for (int i = 0; i < 8; ++i) { const u32x2 w = nxw[i];
            x[i * 4 + 0] = bflo(w[0]); x[i * 4 + 1] = bfhi(w[0]); x[i * 4 + 2] = bflo(w[1]); x[i * 4 + 3] = bfhi(w[1]); }
        int id0 = nid0, id1 = nid1;
        float gg0 = ngg0, gg1 = ngg1;
        const float rs_t = rsqrtf((float)nss * (1.f / 16777216.f) * (1.f / DM) + NORM_EPS);
        { const int tn_ = t + F.GW < T_TOK ? t + F.GW : t; GT_PREF(tn_); }
        float y[32];
#pragma unroll
        for (int i = 0; i < 32; ++i) y[i] = 0.f;
        { int k0 = id0 * 128 + lane, k1 = id1 * 128 + 64 + lane; float g0 = gg0, g1 = gg1; const bool up32 = lane >= 32;
#define GS_CE(M, UP0, UP1) { const int q0 = xchg_i<M>(k0, up32), q1 = xchg_i<M>(k1, up32); const float h0 = xchg_f<M>(g0, up32), h1 = xchg_f<M>(g1, up32); const bool lo_ = (lane & M) == 0; \
            const bool t0 = (lo_ == (UP0)) ? (q0 < k0) : (q0 > k0), t1 = (lo_ == (UP1)) ? (q1 < k1) : (q1 > k1); \
            k0 = t0 ? q0 : k0; g0 = t0 ? h0 : g0; k1 = t1 ? q1 : k1; g1 = t1 ? h1 : g1; }
#define GS_UP(K) ((lane & (K)) == 0)
          GS_CE(1, GS_UP(2), GS_UP(2))
          GS_CE(2, GS_UP(4), GS_UP(4)) GS_CE(1, GS_UP(4), GS_UP(4))
          GS_CE(4, GS_UP(8), GS_UP(8)) GS_CE(2, GS_UP(8), GS_UP(8)) GS_CE(1, GS_UP(8), GS_UP(8))
          GS_CE(8, GS_UP(16), GS_UP(16)) GS_CE(4, GS_UP(16), GS_UP(16)) GS_CE(2, GS_UP(16), GS_UP(16)) GS_CE(1, GS_UP(16), GS_UP(16))
          GS_CE(16, GS_UP(32), GS_UP(32)) GS_CE(8, GS_UP(32), GS_UP(32)) GS_CE(4, GS_UP(32), GS_UP(32)) GS_CE(2, GS_UP(32), GS_UP(32)) GS_CE(1, GS_UP(32), GS_UP(32))
          GS_CE(32, true, false) GS_CE(16, true, false) GS_CE(8, true, false) GS_CE(4, true, false) GS_CE(2, true, false) GS_CE(1, true, false)
          { const bool sw = k0 > k1; const int tk = sw ? k1 : k0; k1 = sw ? k0 : k1; k0 = tk; const float tg = sw ? g1 : g0; g1 = sw ? g0 : g1; g0 = tg; }
          GS_CE(32, true, true) GS_CE(16, true, true) GS_CE(8, true, true) GS_CE(4, true, true) GS_CE(2, true, true) GS_CE(1, true, true)
#undef GS_CE
#undef GS_UP
          id0 = k0 >> 7; id1 = k1 >> 7; gg0 = g0; gg1 = g1; }
        for (int g = 0; g < 32; ++g) {
            const int src = (g & 15) * 4; const int idv = g < 16 ? id0 : id1; const float ggv = g < 16 ? gg0 : gg1;
            int e[4]; int gt[4];
#pragma unroll
            for (int k = 0; k < 4; ++k) { e[k] = __builtin_amdgcn_readlane(idv, src + k); gt[k] = __builtin_amdgcn_readlane(__float_as_int(ggv), src + k); }
            float us[4], vs[4]; float d[4];
#if XFMT == 4
            u32x4 ur[4], vr[4];
#pragma unroll
            for (int k = 0; k < 4; ++k) { ur[k] = ldg<u32x4>(U + (size_t)e[k] * XROW + lane * 16); us[k] = ldg<float>(USC + e[k]); }
#pragma unroll
            for (int k = 0; k < 4; ++k) { vr[k] = ldg<u32x4>(V + (size_t)e[k] * XROW + lane * 16); vs[k] = ldg<float>(VSC + e[k]); }
#pragma unroll
            for (int k = 0; k < 4; ++k) { f32x2 s2 = {0.f, 0.f};
#pragma unroll
                for (int dd = 0; dd < 4; ++dd) {
#define D4(b) { const f32x2 r = __builtin_amdgcn_cvt_scalef32_pk_f32_fp4(ur[k][dd], 1.0f, b); s2 = (f32x2){x[8 * dd + 2 * (b)], x[8 * dd + 2 * (b) + 1]} * r + s2; }
                    D4(0) D4(1) D4(2) D4(3)
#undef D4
                }
                d[k] = s2[0] + s2[1]; }
#else
            u32x2 ur[4][3], vr[4][3];
#pragma unroll
            for (int k = 0; k < 4; ++k) {
#pragma unroll
                for (int c = 0; c < 3; ++c) ur[k][c] = ldg<u32x2>(U + (size_t)e[k] * XROW + lane * 24 + c * 8);
                us[k] = ldg<float>(USC + e[k]); }
#pragma unroll
            for (int k = 0; k < 4; ++k) {
#pragma unroll
                for (int c = 0; c < 3; ++c) vr[k][c] = ldg<u32x2>(V + (size_t)e[k] * XROW + lane * 24 + c * 8);
                vs[k] = ldg<float>(VSC + e[k]); }
#pragma unroll
            for (int k = 0; k < 4; ++k) { const f32x32 uf = __builtin_amdgcn_cvt_scalef32_pk32_f32_fp6((u32x6){ur[k][0][0], ur[k][0][1], ur[k][1][0], ur[k][1][1], ur[k][2][0], ur[k][2][1]}, 1.0f);
                float s = 0.f;
#pragma unroll
                for (int q = 0; q < 32; ++q) s = fmaf(x[q], uf[q], s);
                d[k] = s; }
#endif
            float k0 = b5 ? d[2] : d[0], k1 = b5 ? d[3] : d[1];
            const float s0 = b5 ? d[0] : d[2], s1 = b5 ? d[1] : d[3];
            k0 += shx32(s0, b5); k1 += shx32(s1, b5);
            float kept = b4 ? k1 : k0; const float snd = b4 ? k0 : k1;
            kept += shx<16>(snd);
            kept += shx<8>(kept); kept += shx<4>(kept); kept += shx<2>(kept); kept += shx<1>(kept);
            const float ga = __int_as_float(b5 ? (b4 ? gt[3] : gt[2]) : (b4 ? gt[1] : gt[0]));
            const float usel = b5 ? (b4 ? us[3] : us[2]) : (b4 ? us[1] : us[0]);
            const float vsel = b5 ? (b4 ? vs[3] : vs[2]) : (b4 ? vs[1] : vs[0]);
            const float w = ga * gelu_exact(kept * usel * rs_t) * vsel;
            float wk[4];
#pragma unroll
            for (int k = 0; k < 4; ++k) wk[k] = __int_as_float(__builtin_amdgcn_readlane(__float_as_int(w), k * 16));
#if XFMT == 4
#pragma unroll
            for (int k = 0; k < 4; ++k)
#pragma unroll
                for (int dd = 0; dd < 4; ++dd) {
#define D4(b) { const f32x2 r = __builtin_amdgcn_cvt_scalef32_pk_f32_fp4(vr[k][dd], 1.0f, b); y[8 * dd + 2 * (b)] = fmaf(wk[k], r[0], y[8 * dd + 2 * (b)]); y[8 * dd + 2 * (b) + 1] = fmaf(wk[k], r[1], y[8 * dd + 2 * (b) + 1]); }
                    D4(0) D4(1) D4(2) D4(3)
#undef D4
                }
#else
#pragma unroll
            for (int k = 0; k < 4; ++k) { const f32x32 vf = __builtin_amdgcn_cvt_scalef32_pk32_f32_fp6((u32x6){vr[k][0][0], vr[k][0][1], vr[k][1][0], vr[k][1][1], vr[k][2][0], vr[k][2][1]}, 1.0f);
#pragma unroll
                for (int q = 0; q < 32; ++q) y[q] = fmaf(wk[k], vf[q], y[q]); }
#endif
        }
        float ss = 0.f;
#pragma unroll
        for (int i = 0; i < 32; ++i) { y[i] += x[i]; ss += y[i] * y[i]; }
        if (!nxt_bf) {
#pragma unroll
            for (int i = 0; i < 8; ++i) stg_nt<f32x4>(xout + (size_t)t * DM + i * 256 + lane * 4, (f32x4){y[i * 4 + 0], y[i * 4 + 1], y[i * 4 + 2], y[i * 4 + 3]});
        } else {
            ss = wave_sum(ss); const float rstd = rsqrtf(ss * (1.f / DM) + NORM_EPS);
            bf16_t* Hn = (bf16_t*)(F.ws + WS_H); float* LOGF = (float*)(F.ws + WS_LOGF);
#pragma unroll
            for (int i = 0; i < 8; ++i) stg<u32x2>(Hn + (size_t)t * DM + i * 256 + lane * 4, (u32x2){cvtpk(y[i * 4 + 0], y[i * 4 + 1]), cvtpk(y[i * 4 + 2], y[i * 4 + 3])});
            float am = 1e-30f;
#pragma unroll
            for (int i = 0; i < 32; ++i) am = fmaxf(am, fabsf(y[i]));
            am = wave_max(am); const float inv = 127.0f / am;
#pragma unroll
            for (int i = 0; i < 8; ++i) stg<unsigned>(F.ws + WS_H8 + (size_t)t * DM + i * 256 + lane * 4, q8x4(y[i * 4 + 0], y[i * 4 + 1], y[i * 4 + 2], y[i * 4 + 3], inv));
            if (lane == 0) stg<float>(LOGF + t * 8 + 5, rstd * am * (1.0f / 127.0f));
#pragma unroll 1
            for (int c5 = 0; c5 < 5; ++c5) { float d = 0.f;
#pragma unroll
                for (int i = 0; i < 8; ++i) { const f32x4 wv = *(const f32x4*)(wfl + c5 * 2048 + i * 256 + lane * 4);
                    d += y[i * 4 + 0] * wv[0] + y[i * 4 + 1] * wv[1] + y[i * 4 + 2] * wv[2] + y[i * 4 + 3] * wv[3]; }
                d = wave_sum(d) * rstd;
                if (lane == 0) { const float z = d + ldg<float>(nxt_bf + c5); stg<float>(LOGF + t * 8 + c5, fminf(z, 0.f) - log1pf(__expf(-fabsf(z)))); } }
        }
    }
}

#ifdef DUP_PH
constexpr int NSEQ_TOTAL = 1 + 9 * DEPTH;
#else
constexpr int NSEQ_TOTAL = 1 + 8 * DEPTH;
#endif
#ifndef ONLY_PH
#define PHSEL(k) (ph == (k))
#else
#define PHSEL(k) (ONLY_PH == (k) && ph == (k))
#endif
__global__ void __launch_bounds__(512, 2) mega_fwd(const Args args) {
    extern __shared__ __attribute__((aligned(16))) unsigned char lds[];
    cg::grid_group grid = cg::this_grid();
    LAS unsigned char* ldsl = (LAS unsigned char*)lds;
    if (threadIdx.x == 0) { LAS unsigned long long* la = (LAS unsigned long long*)(ldsl + ARG_OFF);
#pragma unroll
        for (int j = 0; j < 25; ++j) la[j] = (unsigned long long)(uintptr_t)args.in[j];
        la[25] = (unsigned long long)(uintptr_t)args.out; la[26] = (unsigned long long)(uintptr_t)args.ws;
        la[64] = 0ull;
#pragma unroll
        for (int j = 0; j < 16; ++j) la[27 + j] = (unsigned long long)__double_as_longlong(args.invrev[j]); }
    __syncthreads();
    const int ph_lo = args.ph_lo, ph_hi = args.ph_hi;
    (void)xcd_barrier_post((unsigned*)(args.ws + WS_CTL + 4096), (volatile LAS unsigned*)(ldsl + ARG_OFF + 512));
    for (int p = ph_lo; p < ph_hi; ++p) {
        asm volatile("" ::: "memory");
#define FRAME() Frame F; { int tid_ = threadIdx.x; asm volatile("" : "+v"(tid_)); int bid_ = blockIdx.x; asm volatile("" : "+s"(bid_)); \
        F.tid = tid_; F.lane = F.tid & 63; F.wave = __builtin_amdgcn_readfirstlane(F.tid >> 6); F.G = gridDim.x; F.bid = bid_; F.lds = lds; F.ws = ws; F.gw = F.bid * 8 + F.wave; F.GW = F.G * 8; }
        unsigned char* ws; { Frame F0; F0.lds = lds; ws = (unsigned char*)arg_in(F0, 26); }
        Frame FA; FA.lds = lds;
        int pp_ = p; asm volatile("" : "+s"(pp_));
#ifdef DUP_PH
        const int l = pp_ < 1 ? 0 : (pp_ - 1) / 9; int k_ = pp_ < 1 ? -1 : (pp_ - 1) - l * 9;
        bool dup2 = false; { constexpr int pos = DUP_PH < 7 ? DUP_PH - 1 : (DUP_PH == 8 ? 6 : 7); dup2 = (k_ == pos + 1); if (k_ > pos) --k_; }
#else
        const int l = pp_ < 1 ? 0 : (pp_ - 1) / 8; const int k_ = pp_ < 1 ? -1 : (pp_ - 1) - l * 8;
#endif
        const int ph = pp_ == 0 ? 0 : (k_ < 6 ? k_ + 1 : (k_ == 6 ? 8 : 10));
        const unsigned char* wl = ws + WS_W0 + (size_t)l * WL_SIZE;
        float* xout = (float*)arg_in(FA, 25);
        if (PHSEL(0)) {
            FRAME();
            phase_convert(F);
            __syncthreads();
            { FRAME(); phase_norm(F, arg_in(FA, I_X), arg_in(FA, I_BFORGET), arg_in(FA, I_WIN), arg_in(FA, I_NORM1)); }
        } else if (PHSEL(1)) {
            FRAME();
            SchedPlain S; S.ord.init(T_TOK, 12288, F.G, F.bid); S.A = (const char*)(ws + WS_H8); S.Bt = (const char*)(wl + WO_WIN8); S.arow = (size_t)256 * 2048; S.brow = (size_t)256 * 2048;
            for (int i_ = F.bid * 512 + F.tid; i_ < 10 * 16 * 128; i_ += F.G * 512) stg<int>((int*)(ws + WS_KSUM) + i_, 0);
            EpiProj E{(bf16_t*)(ws + WS_PROJ), (bf16_t*)(ws + WS_GATES), arg_in(FA, I_BGATE) + (size_t)l * 3 * DM, ws, (const float*)(ws + WS_LOGF) + 5, (const float*)(wl + WO_WSC)};
#if defined(DUP_PH) && defined(DUP_DRY)
            E.dry = dup2;
#endif
#ifdef STAGGER
            { const int d_ = (F.bid >> 3) & 3; for (int i_ = 0; i_ < d_ * STAGGER; ++i_) __builtin_amdgcn_s_sleep(127); }
#endif
            pg8::gemm_phase<EpiProj, SchedPlain, 2>(ldsl, 2048, 2048, 2048, S, E);
        } else if (PHSEL(2)) {
            FRAME();
            phase_prep(F, l);
        } else if (PHSEL(3)) {
            FRAME();
            phase_attention(F, pp_, arg_in(FA, I_CQN) + l * 128, arg_in(FA, I_CKN) + l * 128, MF8_LAYER(l));
        } else if (PHSEL(4)) {
            FRAME();
            phase_postA(F, l, MF8_LAYER(l));
        } else if (PHSEL(5)) {
            FRAME();
            SchedMerge S; S.ord.init(T_TOK, 2048, F.G, F.bid); S.Y = (const char*)(ws + WS_YCAT); S.W = (const char*)(wl + WO_WBR_T);
            EpiMerge E{(bf16_t*)(ws + WS_MERGED), (const bf16_t*)(ws + WS_GATES)};
            if (MF8_LAYER(l)) { S.f8 = 1; E.fin = 1.f / (255.f * Y8_SCALE * WO8_SCALE); pg8::gemm_phase<EpiMerge, SchedMerge, 1>(ldsl, 2048, 768, 768, S, E); }
            else pg8::gemm_phase<EpiMerge, SchedMerge>(ldsl, 2048, 768, 768, S, E);
        } else if (PHSEL(6)) {
            FRAME();
            SchedPlain S; S.ord.init(T_TOK, 2048, F.G, F.bid); S.A = (const char*)(ws + WS_MERGED); S.Bt = (const char*)(wl + WO_WOUT_T); S.arow = (size_t)256 * 2048; S.brow = (size_t)256 * 2048;
            EpiRes3 E{(bf16_t*)(ws + WS_HG), arg_in(FA, I_X), l == 0 ? nullptr : (const bf16_t*)(ws + WS_H), (unsigned long long*)(ws + WS_ROWSS), ws + WS_HG8};
            pg8::gemm_phase<EpiRes3, SchedPlain, 1>(ldsl, 2048, 2048, 2048, S, E);
        } else if (PHSEL(8)) {
            FRAME();
            if (QF8_LAYER(l)) {
                SchedPlain S; S.ord.init(T_TOK, 2048, F.G, F.bid); S.A = (const char*)(ws + WS_HG8); S.Bt = (const char*)(wl + WO_WQ_T); S.arow = (size_t)256 * 2048; S.brow = (size_t)256 * 2048;
                EpiBf16S E{(bf16_t*)(ws + WS_QP), 2048, (const unsigned long long*)(ws + WS_ROWSS), 1.0f / (X8_SCALE * WO8_SCALE)};
                pg8::gemm_phase<EpiBf16S, SchedPlain, 1>(ldsl, 2048, 2048, 2048, S, E);
            } else {
                SchedPlain S; S.ord.init(T_TOK, 2048, F.G, F.bid); S.A = (const char*)(ws + WS_HG); S.Bt = (const char*)(wl + WO_WQ_T); S.arow = (size_t)256 * 2048 * 2; S.brow = (size_t)256 * 2048 * 2;
                EpiBf16S E{(bf16_t*)(ws + WS_QP), 2048, (const unsigned long long*)(ws + WS_ROWSS), 1.0f};
                pg8::gemm_phase<EpiBf16S, SchedPlain>(ldsl, 2048, 2048, 2048, S, E);
            }
            __builtin_amdgcn_fence(__ATOMIC_ACQUIRE, "agent");
            { FRAME(); phase_topk(F, wl); }
        } else if (PHSEL(10)) {
            FRAME();
            const bool more = l + 1 < DEPTH;
            phase_gather(F, nullptr, xout, wl, nullptr, more ? arg_in(FA, I_BFORGET) + (l + 1) * 5 : nullptr, more ? (const float*)(wl + WL_SIZE + WO_WF) : nullptr);
        }
        if (p + 1 < ph_hi) { if (p == ph_lo) grid.sync();
            else { XcdBarrier xb; xb.bar = (unsigned*)(ws + WS_CTL + 4096); xb.x = xb_xcc_id(); int so = ARG_OFF + 512; asm volatile("" : "+v"(so)); xb.st = (volatile LAS unsigned*)(ldsl + so); xcd_barrier(xb); } }
    }
}

#ifndef MK_PER_PHASE
#define MK_PER_PHASE 0
#endif
extern "C" void kernel_launch(void* const* d_in, const int* in_sizes, int n_in, void* d_out, int out_size, void* d_ws, size_t ws_size, hipStream_t stream) {
    static int grid = 0;
    if (grid == 0) {
        if (n_in != 25 || in_sizes[0] != T_TOK * DM || out_size != T_TOK * DM || ws_size < WS_END) {
            fprintf(stderr, "kernel_launch: unexpected shapes: n_in %d in0 %d out %d ws %zu (need %zu)\n", n_in, n_in > 0 ? in_sizes[0] : -1, out_size, ws_size, (size_t)WS_END); grid = -1; return; }
        int dev = 0, cus = 0, per_cu = 0;
        if (hipGetDevice(&dev) != hipSuccess || hipDeviceGetAttribute(&cus, hipDeviceAttributeMultiprocessorCount, dev) != hipSuccess) { grid = -1; return; }
        if (hipFuncSetAttribute((const void*)mega_fwd, hipFuncAttributeMaxDynamicSharedMemorySize, LDS_BYTES) != hipSuccess) { fprintf(stderr, "kernel_launch: hipFuncSetAttribute failed\n"); grid = -1; return; }
        if (hipOccupancyMaxActiveBlocksPerMultiprocessor(&per_cu, (const void*)mega_fwd, 512, LDS_BYTES) != hipSuccess || per_cu < 1) { fprintf(stderr, "kernel_launch: occupancy query says %d blocks per CU\n", per_cu); grid = -1; return; }
        (void)hipGetLastError();
        grid = cus;
    }
    if (grid < 0) return;
    (void)hipMemsetAsync((char*)d_ws + WS_CTL, 0, 32768, stream);
    Args a{};
    for (int i = 0; i < 25; ++i) a.in[i] = (const float*)d_in[i];
    a.out = (float*)d_out; a.ws = (unsigned char*)d_ws;
    for (int j = 0; j < 16; ++j) a.invrev[j] = pow(500000.0, -(double)j / 16.0) / 6.283185307179586476925286766559;
    const int total = NSEQ_TOTAL;
#if MK_PER_PHASE
    for (int p = 0; p < total; ++p) { a.ph_lo = p; a.ph_hi = p + 1; void* kargs[] = {&a};
        hipError_t e = hipLaunchCooperativeKernel((const void*)mega_fwd, dim3(grid), dim3(512), kargs, LDS_BYTES, stream);
        if (e != hipSuccess) { fprintf(stderr, "kernel_launch: launch %d failed: %s\n", p, hipGetErrorString(e)); break; } }
#else
    a.ph_lo = 0; a.ph_hi = total; void* kargs[] = {&a};
    hipError_t e = hipLaunchCooperativeKernel((const void*)mega_fwd, dim3(grid), dim3(512), kargs, LDS_BYTES, stream);
    if (e != hipSuccess) fprintf(stderr, "kernel_launch: cooperative launch failed: %s (grid %d)\n", hipGetErrorString(e), grid);
#endif
}
```

```cpp
#define XFMT 4
#include <hip/hip_runtime.h>
#include <hip/hip_cooperative_groups.h>
#include <cstdio>
#include <cstdint>
#include <cmath>
namespace cg = cooperative_groups;

#define LAS __attribute__((address_space(3)))
typedef unsigned short bf16_t;
typedef short bf16x8 __attribute__((ext_vector_type(8)));
typedef short s16x4 __attribute__((ext_vector_type(4)));
typedef float f32x2 __attribute__((ext_vector_type(2)));
typedef float f32x4 __attribute__((ext_vector_type(4)));
typedef float f32x16 __attribute__((ext_vector_type(16)));
typedef unsigned u32x2 __attribute__((ext_vector_type(2)));
typedef unsigned u32x4 __attribute__((ext_vector_type(4)));
typedef __bf16 bf16v2 __attribute__((ext_vector_type(2)));
typedef float f32x32 __attribute__((ext_vector_type(32)));
typedef unsigned u32x6 __attribute__((ext_vector_type(6)));
#ifndef XFMT
#define XFMT 6
#endif
constexpr int XROW = XFMT == 6 ? 1536 : 1024;
constexpr int XLB = XROW / 64;

constexpr int T_TOK = 8192, DM = 2048, SEQ = 4096, NBATCH = 2, DEPTH = 2, INCOLS = 12293;
constexpr int PQ = 6144;
constexpr float NORM_EPS = 1e-6f;
constexpr float LOG2E = 1.4426950408889634f;
constexpr float X8_SCALE = 4.0f;
constexpr float M8_SCALE = 4.0f, WO8_SCALE = 128.0f;

constexpr size_t AL(size_t x) { return (x + 255) & ~(size_t)255; }
constexpr size_t WS_CTL = 0;
constexpr size_t WO_WIN_T = 0;
constexpr size_t WO_WBR_T = WO_WIN_T + AL((size_t)12288 * 2048 * 2);
constexpr size_t WO_WOUT_T = WO_WBR_T + AL((size_t)3 * 2048 * 768 * 2);
constexpr size_t WO_WQ_T = WO_WOUT_T + AL((size_t)2048 * 2048 * 2);
constexpr size_t WO_SK = WO_WQ_T + AL((size_t)2048 * 2048 * 2);
constexpr size_t WO_U = WO_SK + AL((size_t)8 * 2 * 128 * 128 * 2);
constexpr size_t WO_V = WO_U + AL((size_t)16384 * 2048);
constexpr size_t WO_WF = WO_V + AL((size_t)16384 * 2048);
constexpr size_t WO_USC = WO_WF + AL((size_t)8 * 2048 * 4);
constexpr size_t WO_VSC = WO_USC + AL((size_t)16384 * 4);
constexpr size_t WO_WIN8 = WO_VSC + AL((size_t)16384 * 4);
constexpr size_t WO_WSC = WO_WIN8 + AL((size_t)12288 * 2048);
constexpr size_t WL_SIZE = WO_WSC + AL((size_t)12288 * 4);
constexpr size_t WS_W0 = 65536;
constexpr size_t WS_XA = WS_W0 + DEPTH * WL_SIZE;
constexpr size_t WS_H8 = WS_XA;
constexpr size_t WS_XB = WS_XA + AL((size_t)T_TOK * DM * 4);
constexpr size_t WS_HG8 = WS_XB;
constexpr size_t WS_H = WS_XB + AL((size_t)T_TOK * DM * 4);
constexpr size_t WS_PROJ = WS_H + AL((size_t)T_TOK * DM * 2);
constexpr size_t WS_MERGED = WS_PROJ;
constexpr size_t WS_QP = WS_MERGED + AL((size_t)T_TOK * DM * 2);
constexpr size_t WS_HG = WS_QP + AL((size_t)T_TOK * DM * 2);
constexpr size_t WS_GATES = WS_PROJ + AL((size_t)T_TOK * PQ * 2);
constexpr size_t WS_LOGF = WS_GATES + AL((size_t)T_TOK * PQ * 2);
constexpr size_t WS_QA = WS_LOGF + AL((size_t)T_TOK * 8 * 4);
constexpr size_t WS_KA = WS_QA + AL((size_t)2 * 12 * 4096 * 128 * 2);
constexpr size_t WS_VA = WS_KA + AL((size_t)2 * 12 * 4096 * 128 * 2);
constexpr size_t WS_QB = WS_VA + AL((size_t)2 * 6 * 4096 * 128 * 2);
constexpr size_t SZ_H5 = AL((size_t)2 * 5 * 4096 * 128 * 2);
constexpr size_t WS_KB = WS_QB + SZ_H5;
constexpr size_t WS_VB = WS_KB + SZ_H5;
constexpr size_t WS_QC = WS_VB + SZ_H5;
constexpr size_t WS_KC = WS_QC + SZ_H5;
constexpr size_t WS_VC = WS_KC + SZ_H5;
constexpr size_t WS_CB = WS_VC + SZ_H5;
constexpr size_t WS_OA = WS_CB + AL((size_t)2 * 5 * 4096 * 4);
constexpr size_t WS_YCAT = WS_OA + AL((size_t)2 * T_TOK * 768 * 2);
constexpr size_t WS_PIDX = WS_YCAT + AL((size_t)T_TOK * DM * 2);
constexpr size_t WS_PGATE = WS_PIDX + AL((size_t)T_TOK * 128 * 4);
constexpr size_t WS_ROWSS = WS_PGATE + AL((size_t)T_TOK * 128 * 4);
constexpr size_t WS_KSUM = WS_ROWSS + AL((size_t)T_TOK * 8);
constexpr size_t WS_END = WS_KSUM + AL((size_t)10 * 16 * 128 * 4);
static_assert(3 * AL((size_t)T_TOK * DM * 2) <= AL((size_t)T_TOK * PQ * 2), "aliases fit in PROJ");

constexpr int LDS_BYTES = 159744 + 1024;

__device__ __forceinline__ int lane_id_() { return (int)__builtin_amdgcn_mbcnt_hi(~0u, __builtin_amdgcn_mbcnt_lo(~0u, 0u)); }
__device__ __forceinline__ int tid_of(int wid) { int t = wid * 64 + lane_id_(); asm volatile("" : "+v"(t)); return t; }
#define GAS __attribute__((address_space(1)))
template <class T> __device__ __forceinline__ T ldg(const void* p) { return *(const GAS T*)p; }
template <class T> __device__ __forceinline__ void stg(void* p, const T v) { *(GAS T*)p = v; }
template <class T> __device__ __forceinline__ T ldg_nt(const void* p) { return __builtin_nontemporal_load((const GAS T*)p); }
template <class T> __device__ __forceinline__ void stg_nt(void* p, const T v) { __builtin_nontemporal_store(v, (GAS T*)p); }
__device__ __forceinline__ u32x4 zero4() { unsigned z = 0u; asm volatile("" : "+v"(z)); return (u32x4){z, z, z, z}; }
__device__ __forceinline__ unsigned cvtpk(float lo, float hi) { unsigned r; asm volatile("v_cvt_pk_bf16_f32 %0, %1, %2" : "=v"(r) : "v"(lo), "v"(hi)); return r; }
__device__ __forceinline__ float bflo(unsigned u) { return __uint_as_float(u << 16); }
__device__ __forceinline__ float bfhi(unsigned u) { return __uint_as_float(u & 0xffff0000u); }
__device__ __forceinline__ bf16x8 pack8(f32x4 a, f32x4 b) {
    u32x4 w = {cvtpk(a[0], a[1]), cvtpk(a[2], a[3]), cvtpk(b[0], b[1]), cvtpk(b[2], b[3])};
    return *reinterpret_cast<bf16x8*>(&w);
}
template <int M> __device__ __forceinline__ float shx(float v) { static_assert(M >= 1 && M < 32, "xor mask"); return __int_as_float(__builtin_amdgcn_ds_swizzle(__float_as_int(v), (M << 10) | 0x1f)); }
__device__ __forceinline__ float shx32(float v, bool upper) { auto rr = __builtin_amdgcn_permlane32_swap(__float_as_uint(v), __float_as_uint(v), false, false); return __uint_as_float(upper ? rr[0] : rr[1]); }
__device__ __forceinline__ float sum32(float v) { auto rr = __builtin_amdgcn_permlane32_swap(__float_as_uint(v), __float_as_uint(v), false, false); return __uint_as_float(rr[0]) + __uint_as_float(rr[1]); }
__device__ __forceinline__ float wave_sum(float v) {
    v += shx<1>(v); v += shx<2>(v); v += shx<4>(v); v += shx<8>(v); v += shx<16>(v);
    return sum32(v);
}
__device__ __forceinline__ float sigmoidf_(float x) { return __builtin_amdgcn_rcpf(1.f + __expf(-x)); }
__device__ __forceinline__ float gelu_exact(float v) {
    const float av = fabsf(v), d = av * 0.2316418882f + 1.0f;
    const float t = __builtin_amdgcn_rcpf(d);
    float q = t * 0.5307027145f + (-0.7265760135f); q = q * t + 0.7107068705f; q = q * t + (-0.142248368f); q = q * t + 0.127414796f; q = q * t;
    const float e = __builtin_amdgcn_exp2f((v * v) * (-0.72134752044f));
    const float m = v * (q * e);
    return v < 0.f ? m : v - m;
}

__device__ __forceinline__ unsigned q8x4(float a, float b, float c, float d, float inv) {
    const unsigned ua = __float_as_uint(fmaf(a, inv, 12582912.0f)), ub = __float_as_uint(fmaf(b, inv, 12582912.0f)), uc = __float_as_uint(fmaf(c, inv, 12582912.0f)), ud = __float_as_uint(fmaf(d, inv, 12582912.0f));
    return __builtin_amdgcn_perm(ub, ua, 0x0c0c0400u) | __builtin_amdgcn_perm(ud, uc, 0x04000c0cu);
}
__device__ __forceinline__ float wave_max(float v) {
    v = fmaxf(v, shx<1>(v)); v = fmaxf(v, shx<2>(v)); v = fmaxf(v, shx<4>(v)); v = fmaxf(v, shx<8>(v)); v = fmaxf(v, shx<16>(v));
    auto rr = __builtin_amdgcn_permlane32_swap(__float_as_uint(v), __float_as_uint(v), false, false); return fmaxf(__uint_as_float(rr[0]), __uint_as_float(rr[1]));
}

namespace pg8 {
constexpr int BM = 256, BK = 64, HALF = 128, HTB = HALF * BK * 2, STAGE_BYTES = 8 * HTB, NXCD = 8, WGM = 8;
__device__ __forceinline__ int lds_byte(int r, int c) { const int st = (r >> 4) * 2 + (c >> 5), rr = r & 15, cc = c & 31, ob = rr * 64 + cc * 2; return st * 1024 + (ob ^ (((ob >> 9) & 1) << 5)); }
__device__ __forceinline__ void stage_rc(int b, int& R, int& C) { const int st = b / 1024, sb = b % 1024, swz = sb ^ (((sb >> 9) & 1) << 5); R = (st >> 1) * 16 + swz / 64; C = (st & 1) * 32 + (swz % 64) / 2; }
__device__ __forceinline__ int perm32(int rho) { const int n = rho >> 4, i = rho & 15; return 8 * (i >> 2) + 4 * n + (i & 3); }

typedef int i32x8 __attribute__((ext_vector_type(8)));
typedef int i32x4 __attribute__((ext_vector_type(4)));
typedef short s16x16 __attribute__((ext_vector_type(16)));
__device__ __forceinline__ i32x8 cat8(bf16x8 lo, bf16x8 hi) { return __builtin_bit_cast(i32x8, __builtin_shufflevector(lo, hi, 0, 1, 2, 3, 4, 5, 6, 7, 8, 9, 10, 11, 12, 13, 14, 15)); }
constexpr int F8SC = 0x7f7f7f7f;
struct Unit { const char* a; const char* b; int pm, pn, aux, nt = 0; };

template <class Epi> __device__ __forceinline__ auto epi_keep(const Epi& e, const Unit& u, int) -> decltype(e.keep(u)) { return e.keep(u); }
template <class Epi> __device__ __forceinline__ bool epi_keep(const Epi&, const Unit&, long) { return false; }
struct TileOrder {
    int nM, nN, nwg, G, c;
    __device__ void init(int M, int N, int G_, int c_) { nM = M / BM; nN = N / BM; nwg = nM * nN; G = G_; c = c_; }
    __device__ bool tile(int i, int& pm, int& pn) const {
        const long L = (long)i * G + c; if (L >= nwg) return false;
        int wgid = (int)L; { const int q = nwg / NXCD, r = nwg % NXCD, xcd = wgid % NXCD, off = wgid / NXCD; wgid = (xcd < r ? xcd * (q + 1) : r * (q + 1) + (xcd - r) * q) + off; }
        const int nig = WGM * nN, gid = wgid / nig, fm = gid * WGM, gsz = (nM - fm) < WGM ? (nM - fm) : WGM;
        pm = fm + ((wgid % nig) % gsz); pn = (wgid % nig) / gsz; return true;
    }
};

template <class Epi, class Sched, int MODE = 0>
__device__ __forceinline__ void gemm_phase(LAS unsigned char* lds, const int lda, const int ldb, const int K, const Sched& S, const Epi& E) {
    int tid = threadIdx.x; asm volatile("" : "+v"(tid));
    const int wid = __builtin_amdgcn_readfirstlane(tid >> 6), lane = tid & 63, wr = wid >> 2, wc = wid & 3, fr = lane & 15, fq = lane >> 4;
    constexpr bool F8 = MODE == 1;
    constexpr int EB = MODE ? 1 : 2;
    const int nt = K / (MODE ? 128 : BK);
    unsigned voffA[2], voffB[2];
#pragma unroll
    for (int i = 0; i < 2; ++i) { int R, C; stage_rc(tid * 16 + i * 8192, R, C); const int Rb = Epi::PERM ? ((R & ~31) + perm32(R & 31)) : R;
        voffA[i] = (unsigned)(R * lda * EB + C * 2); voffB[i] = (unsigned)(Rb * ldb * EB + C * 2); }
    const size_t kstep = (size_t)(BK * 2);
    const size_t hstepA = (size_t)HALF * lda * EB, hstepB = (size_t)HALF * ldb * EB;
    const unsigned ldsw = (unsigned)wid * 1024u;
    const int fcol = F8 ? ((fq >> 1) * 32 + (fq & 1) * 16) : fq * 8;
    constexpr int KOFF = F8 ? 16 : 1024;
    const int aoff = lds_byte(wr * 64 + fr, fcol), boff = lds_byte(wc * 32 + fr, fcol);
#define PG8_SA(b, h) (((b) * 2 + (h)) * HTB)
#define PG8_SB(b, h) ((4 + (b) * 2 + (h)) * HTB)
#define PG8_STAGE(bufoff, gbase, voff) do { _Pragma("unroll") for (int _i = 0; _i < 2; ++_i) \
        __builtin_amdgcn_global_load_lds((const unsigned*)((const char*)(gbase) + (voff)[_i]), (LAS unsigned*)(lds + (bufoff) + ldsw + _i * 8192), 16, 0, 0); } while (0)
#define PG8_LDA(dst, b, h) do { _Pragma("unroll") for (int m = 0; m < 4; ++m) _Pragma("unroll") for (int k = 0; k < 2; ++k) dst[m][k] = *(const LAS bf16x8*)(lds + PG8_SA(b, h) + aoff + m * 2048 + k * KOFF); } while (0)
#define PG8_LDB(dst, b, h) do { _Pragma("unroll") for (int n = 0; n < 2; ++n) _Pragma("unroll") for (int k = 0; k < 2; ++k) dst[n][k] = *(const LAS bf16x8*)(lds + PG8_SB(b, h) + boff + n * 2048 + k * KOFF); } while (0)
#define PG8_MMA(ai, bj, At, Bt) do { __builtin_amdgcn_s_setprio(1); _Pragma("unroll") for (int m = 0; m < 4; ++m) _Pragma("unroll") for (int n = 0; n < 2; ++n) { \
        if constexpr (F8) { const i32x8 b8_ = cat8(Bt[n][0], Bt[n][1]), a8_ = cat8(At[m][0], At[m][1]); \
            asm volatile("s_nop 1\n\tv_mfma_f32_16x16x128_f8f6f4 %0, %1, %2, %0" : "+v"(acc[ai][bj][m][n]) : "v"(b8_), "v"(a8_)); } \
        else if constexpr (MODE == 2) { _Pragma("unroll") for (int k = 0; k < 2; ++k) acc[ai][bj][m][n] = __builtin_bit_cast(f32x4, __builtin_amdgcn_mfma_i32_16x16x64_i8(__builtin_bit_cast(i32x4, Bt[n][k]), __builtin_bit_cast(i32x4, At[m][k]), __builtin_bit_cast(i32x4, acc[ai][bj][m][n]), 0, 0, 0)); } \
        else { _Pragma("unroll") for (int k = 0; k < 2; ++k) acc[ai][bj][m][n] = __builtin_amdgcn_mfma_f32_16x16x32_bf16(Bt[n][k], At[m][k], acc[ai][bj][m][n], 0, 0, 0); } } __builtin_amdgcn_s_setprio(0); } while (0)
#define PG8_WAIT_V(n) asm volatile("s_waitcnt vmcnt(" #n ")" ::: "memory")
#define PG8_WAIT_L(n) asm volatile("s_waitcnt lgkmcnt(" #n ")" ::: "memory")
#define PG8_BAR __builtin_amdgcn_s_barrier()
#define PG8_SCHED __builtin_amdgcn_sched_barrier(0)
    Unit cur, nxt; int ui = 0;
    if (!S.next(0, cur)) return;
    f32x4 acc[2][2][4][2];
#pragma unroll
    for (int a = 0; a < 2; ++a)
#pragma unroll
        for (int b = 0; b < 2; ++b)
#pragma unroll
            for (int m = 0; m < 4; ++m)
#pragma unroll
                for (int n = 0; n < 2; ++n) acc[a][b][m][n] = (f32x4){0.f, 0.f, 0.f, 0.f};
    bf16x8 At[4][2], B0[2][2], B1[2][2];
    const char* cA = cur.a; const char* cB = cur.b;
    PG8_STAGE(PG8_SB(0, 0), cB, voffB); PG8_STAGE(PG8_SA(0, 0), cA, voffA); PG8_STAGE(PG8_SB(0, 1), cB + hstepB, voffB); PG8_STAGE(PG8_SA(0, 1), cA + hstepA, voffA);
    if (wr == 1) PG8_BAR;
    PG8_WAIT_V(4); PG8_BAR;
    PG8_STAGE(PG8_SB(1, 0), cB + kstep, voffB); PG8_STAGE(PG8_SA(1, 0), cA + kstep, voffA); PG8_STAGE(PG8_SB(1, 1), cB + hstepB + kstep, voffB);
    PG8_WAIT_V(6); PG8_BAR;
    for (;;) {
        const bool has_next = S.next(ui + 1, nxt);
        const char* nA = has_next ? nxt.a : cA; const char* nB = has_next ? nxt.b : cB;
        const int ntu = cur.nt ? cur.nt : nt;
        for (int t = 0; t < ntu; t += 2) {
            const bool last = (t == ntu - 2);
            const char* a1 = cA + (size_t)(t + 1) * kstep;
            const char* a2 = last ? nA : cA + (size_t)(t + 2) * kstep; const char* b2 = last ? nB : cB + (size_t)(t + 2) * kstep;
            const char* a3 = a2 + kstep; const char* b3 = b2 + kstep;
            PG8_LDB(B0, 0, 0); PG8_SCHED; PG8_LDA(At, 0, 0); PG8_STAGE(PG8_SA(1, 1), a1 + hstepA, voffA);
            PG8_WAIT_L(8); PG8_BAR; PG8_WAIT_L(0); PG8_MMA(0, 0, At, B0); PG8_BAR; PG8_SCHED;
            PG8_LDB(B1, 0, 1); PG8_STAGE(PG8_SB(0, 0), b2, voffB);
            PG8_BAR; PG8_WAIT_L(0); PG8_MMA(0, 1, At, B1); PG8_BAR;
            PG8_LDA(At, 0, 1); PG8_STAGE(PG8_SA(0, 0), a2, voffA);
            PG8_BAR; PG8_WAIT_L(0); PG8_MMA(1, 0, At, B0); PG8_BAR; PG8_SCHED;
            PG8_STAGE(PG8_SB(0, 1), b2 + hstepB, voffB);
            PG8_WAIT_V(6); PG8_BAR; PG8_MMA(1, 1, At, B1); PG8_BAR;
            PG8_LDB(B0, 1, 0); PG8_SCHED; PG8_LDA(At, 1, 0); PG8_STAGE(PG8_SA(0, 1), a2 + hstepA, voffA);
            PG8_WAIT_L(8); PG8_BAR; PG8_WAIT_L(0); PG8_MMA(0, 0, At, B0); PG8_BAR; PG8_SCHED;
            PG8_LDB(B1, 1, 1); PG8_STAGE(PG8_SB(1, 0), b3, voffB);
            PG8_BAR; PG8_WAIT_L(0); PG8_MMA(0, 1, At, B1); PG8_BAR;
            PG8_LDA(At, 1, 1); PG8_STAGE(PG8_SA(1, 0), a3, voffA);
            PG8_BAR; PG8_WAIT_L(0); PG8_MMA(1, 0, At, B0); PG8_BAR; PG8_SCHED;
            PG8_STAGE(PG8_SB(1, 1), b3 + hstepB, voffB);
            PG8_WAIT_V(6); PG8_BAR; PG8_MMA(1, 1, At, B1); PG8_BAR;
        }
        if constexpr (F8) { asm volatile("s_nop 15\n\ts_nop 15" ::: "memory"); __builtin_amdgcn_sched_barrier(0); }
        E(acc, cur, wr, wc, fr, fq);
        if (!has_next) break;
        if (!epi_keep(E, cur, 0)) {
#pragma unroll
        for (int a = 0; a < 2; ++a)
#pragma unroll
            for (int b = 0; b < 2; ++b)
#pragma unroll
                for (int m = 0; m < 4; ++m)
#pragma unroll
                    for (int n = 0; n < 2; ++n) acc[a][b][m][n] = (f32x4){0.f, 0.f, 0.f, 0.f}; }
        cur = nxt; cA = nA; cB = nB; ++ui;
    }
    PG8_WAIT_V(0);
    if (wr == 0) PG8_BAR;
    PG8_BAR;
#undef PG8_SA
#undef PG8_SB
#undef PG8_STAGE
#undef PG8_LDA
#undef PG8_LDB
#undef PG8_MMA
#undef PG8_WAIT_V
#undef PG8_WAIT_L
#undef PG8_BAR
#undef PG8_SCHED
}
}

struct SchedPlain {
    pg8::TileOrder ord; const char* A; const char* Bt; size_t arow, brow;
    __device__ bool next(int i, pg8::Unit& u) const { int pm, pn; if (!ord.tile(i, pm, pn)) return false; u.pm = pm; u.pn = pn; u.aux = 0; u.a = A + (size_t)pm * arow; u.b = Bt + (size_t)pn * brow; return true; }
};
struct SchedMerge {
    pg8::TileOrder ord; const char* Y; const char* W;
    __device__ bool next(int i, pg8::Unit& u) const {
        const int r = i / 3, br = i - r * 3; int pm, pn; if (!ord.tile(r, pm, pn)) return false;
        u.pm = pm; u.pn = pn; u.aux = br; u.nt = br == 0 ? 12 : 10;
        const int acol = br == 0 ? 0 : (br == 1 ? 768 : 1408);
        u.a = Y + ((size_t)pm * 256 * 2048 + acol) * 2; u.b = W + ((size_t)br * 2048 * 768 + (size_t)pn * 256 * 768) * 2; return true;
    }
};

typedef int i32x4_ __attribute__((ext_vector_type(4)));
struct EpiProj {
    static constexpr bool PERM = true;
    bf16_t* proj; bf16_t* gates; const float* bgate; unsigned char* ws; const float* rstd1; const float* wsc;
    bool dry = false;
    __device__ __forceinline__ void operator()(const f32x4 (&acc)[2][2][4][2], const pg8::Unit& u, int wr, int wc, int fr, int fq) const {
        if (dry) return;
        const bool isg = u.pn >= 24;
        const int row0 = u.pm * 256 + wr * 64 + fr, col0 = (isg ? u.pn - 24 : u.pn) * 256 + wc * 32 + 8 * fq;
        bf16_t* base = isg ? gates : proj;
        f32x4 bv[2][2], cs[2][2];
#pragma unroll
        for (int bj = 0; bj < 2; ++bj)
#pragma unroll
            for (int n = 0; n < 2; ++n) { bv[bj][n] = isg ? ldg<f32x4>(bgate + col0 + bj * 128 + 4 * n) : (f32x4){0.f, 0.f, 0.f, 0.f}; cs[bj][n] = ldg<f32x4>(wsc + u.pn * 256 + wc * 32 + 8 * fq + bj * 128 + 4 * n); }
        bf16_t* vdst[2]; int vH[2]; bool isv[2];
#pragma unroll
        for (int bj = 0; bj < 2; ++bj) { const int un = 2 * u.pn + bj; isv[bj] = false; vdst[bj] = nullptr; vH[bj] = 1;
            if (!isg) {
                if (un >= 12 && un < 18) { isv[bj] = true; vH[bj] = 6; vdst[bj] = (bf16_t*)(ws + WS_VA) + (size_t)(un - 12) * 4096 * 128; }
                else if (un >= 28 && un < 33) { isv[bj] = true; vH[bj] = 5; vdst[bj] = (bf16_t*)(ws + WS_VB) + (size_t)(un - 28) * 4096 * 128; }
                else if (un >= 43) { isv[bj] = true; vH[bj] = 5; vdst[bj] = (bf16_t*)(ws + WS_VC) + (size_t)(un - 43) * 4096 * 128; } } }
        const int cin = wc * 32 + 8 * fq;
        float rs[8];
#pragma unroll
        for (int g = 0; g < 8; ++g) rs[g] = ldg<float>(rstd1 + (size_t)(row0 + (g >> 2) * 128 + (g & 3) * 16) * 8);
        if (isg) {
#pragma unroll
            for (int g = 0; g < 8; ++g) rs[g] *= -LOG2E;
#pragma unroll
            for (int bj = 0; bj < 2; ++bj)
#pragma unroll
                for (int n = 0; n < 2; ++n) bv[bj][n] = bv[bj][n] * -LOG2E; }
#pragma unroll
        for (int ai = 0; ai < 2; ++ai)
#pragma unroll
            for (int m = 0; m < 4; ++m) { const int r = row0 + ai * 128 + m * 16; bf16_t* rowp = base + (size_t)r * PQ + col0;
#pragma unroll
                for (int bj = 0; bj < 2; ++bj) {
                    const i32x4_ i0 = __builtin_bit_cast(i32x4_, acc[ai][bj][m][0]), i1 = __builtin_bit_cast(i32x4_, acc[ai][bj][m][1]);
                    f32x4 v0 = (f32x4){(float)i0[0], (float)i0[1], (float)i0[2], (float)i0[3]} * rs[ai * 4 + m] * cs[bj][0] + bv[bj][0], v1 = (f32x4){(float)i1[0], (float)i1[1], (float)i1[2], (float)i1[3]} * rs[ai * 4 + m] * cs[bj][1] + bv[bj][1];
                    if (isg) {
                        f32x4 e0, e1;
#pragma unroll
                        for (int j = 0; j < 4; ++j) { e0[j] = __builtin_amdgcn_exp2f(v0[j]); e1[j] = __builtin_amdgcn_exp2f(v1[j]); }
                        e0 = e0 + 1.0f; e1 = e1 + 1.0f;
#pragma unroll
                        for (int j = 0; j < 4; ++j) { v0[j] = __builtin_amdgcn_fmed3f(__builtin_amdgcn_rcpf(e0[j]), 1.f / 255.f, 1.0f); v1[j] = __builtin_amdgcn_fmed3f(__builtin_amdgcn_rcpf(e1[j]), 1.f / 255.f, 1.0f); } }
                    if (isg) stg<u32x2>((unsigned char*)gates + (size_t)(u.pm * 24 + (u.pn - 24)) * 65536 + (size_t)((((wr * 4 + wc) * 16 + ai * 8 + m * 2 + bj) * 64 + fq * 16 + fr) * 8),
                                        (u32x2){q8x4(v0[0], v0[1], v0[2], v0[3], 255.f), q8x4(v1[0], v1[1], v1[2], v1[3], 255.f)});
                    else if (isv[bj]) stg<bf16x8>(vdst[bj] + ((size_t)((r >> 12) * vH[bj]) * 4096 + (r & 4095)) * 128 + cin, pack8(v0, v1));
                    else stg<bf16x8>(rowp + bj * 128, pack8(v0, v1)); } }
    }
};
struct EpiBf16 {
    static constexpr bool PERM = true;
    bf16_t* O; int ldc;
    __device__ __forceinline__ void operator()(const f32x4 (&acc)[2][2][4][2], const pg8::Unit& u, int wr, int wc, int fr, int fq) const {
        const int row0 = u.pm * 256 + wr * 64 + fr, col0 = u.pn * 256 + wc * 32 + 8 * fq;
#pragma unroll
        for (int ai = 0; ai < 2; ++ai)
#pragma unroll
            for (int m = 0; m < 4; ++m) { bf16_t* rowp = O + (size_t)(row0 + ai * 128 + m * 16) * ldc + col0;
#pragma unroll
                for (int bj = 0; bj < 2; ++bj) stg<bf16x8>(rowp + bj * 128, pack8(acc[ai][bj][m][0], acc[ai][bj][m][1])); }
    }
};
struct EpiMerge {
    static constexpr bool PERM = true;
    bf16_t* merged; const bf16_t* gates;
    __device__ __forceinline__ bool keep(const pg8::Unit& u) const { return u.aux < 2; }
    __device__ __forceinline__ void operator()(f32x4 (&acc)[2][2][4][2], const pg8::Unit& u, int wr, int wc, int fr, int fq) const {
        const int br = u.aux, row0 = u.pm * 256 + wr * 64 + fr, col0 = u.pn * 256 + wc * 32 + 8 * fq;
        u32x2 ga[8][2], ha[8][2];
#define EM_LOAD(G, H, grp) do { const unsigned char* g_ = (const unsigned char*)gates + (size_t)(u.pm * 24 + br * 8 + u.pn) * 65536 + (size_t)((((wr * 4 + wc) * 16 + (grp) * 2) * 64 + fq * 16 + fr) * 8);     \
            G[0] = ldg_nt<u32x2>(g_); G[1] = ldg_nt<u32x2>(g_ + 512); \
            if (br < 2) { H[0] = ldg<u32x2>(g_ + (size_t)8 * 65536); H[1] = ldg<u32x2>(g_ + (size_t)8 * 65536 + 512); } } while (0)
#pragma unroll
        for (int grp = 0; grp < 8; ++grp) EM_LOAD(ga[grp], ha[grp], grp);
#pragma unroll
        for (int grp = 0; grp < 8; ++grp) { const int ai = grp >> 2, m = grp & 3; const size_t r = (size_t)(row0 + ai * 128 + m * 16);
#pragma unroll
            for (int bj = 0; bj < 2; ++bj) { const int c = col0 + bj * 128; const u32x2 g = ga[grp][bj];
                float f[8];
#pragma unroll
                for (int q = 0; q < 8; ++q) f[q] = (float)((g[q >> 2] >> (8 * (q & 3))) & 0xffu);
                if (br < 2) { const u32x2 h = ha[grp][bj];
#pragma unroll
                    for (int q = 0; q < 8; ++q) f[q] *= __builtin_amdgcn_rcpf((float)((h[q >> 2] >> (8 * (q & 3))) & 0xffu)); }
                else {
#pragma unroll
                    for (int q = 0; q < 8; ++q) f[q] *= 1.f / 255.f; }
                f32x4 v0 = acc[ai][bj][m][0], v1 = acc[ai][bj][m][1];
                v0[0] *= f[0]; v0[1] *= f[1]; v0[2] *= f[2]; v0[3] *= f[3]; v1[0] *= f[4]; v1[1] *= f[5]; v1[2] *= f[6]; v1[3] *= f[7];
                if (br < 2) { acc[ai][bj][m][0] = v0; acc[ai][bj][m][1] = v1; }
                else { int o0 = 0, o1 = 0;
                    o0 = __builtin_amdgcn_cvt_pk_fp8_f32(v0[0] * M8_SCALE, v0[1] * M8_SCALE, o0, false); o0 = __builtin_amdgcn_cvt_pk_fp8_f32(v0[2] * M8_SCALE, v0[3] * M8_SCALE, o0, true);
                    o1 = __builtin_amdgcn_cvt_pk_fp8_f32(v1[0] * M8_SCALE, v1[1] * M8_SCALE, o1, false); o1 = __builtin_amdgcn_cvt_pk_fp8_f32(v1[2] * M8_SCALE, v1[3] * M8_SCALE, o1, true);
                    stg<u32x2>((unsigned char*)merged + r * 2048 + c, (u32x2){(unsigned)o0, (unsigned)o1}); } } }
#undef EM_LOAD
    }
};
struct EpiRes {
    static constexpr bool PERM = false;
    float* out; const float* res;
    __device__ __forceinline__ void operator()(const f32x4 (&acc)[2][2][4][2], const pg8::Unit& u, int wr, int wc, int fr, int fq) const {
        const int row0 = u.pm * 256 + wr * 64 + fr, col0 = u.pn * 256 + wc * 32 + 4 * fq;
#pragma unroll
        for (int ai = 0; ai < 2; ++ai)
#pragma unroll
            for (int m = 0; m < 4; ++m) { const size_t off = (size_t)(row0 + ai * 128 + m * 16) * DM + col0;
#pragma unroll
                for (int bj = 0; bj < 2; ++bj)
#pragma unroll
                    for (int n = 0; n < 2; ++n) { const f32x4 rv = ldg<f32x4>(res + off + bj * 128 + n * 16); stg<f32x4>(out + off + bj * 128 + n * 16, rv + acc[ai][bj][m][n]); }
                asm volatile("" ::: "memory"); }
    }
};

struct EpiRes2 {
    static constexpr bool PERM = true;
    float* out; const float* res; bf16_t* hg; const float* g2; unsigned long long* rowss;
    __device__ __forceinline__ void operator()(const f32x4 (&acc)[2][2][4][2], const pg8::Unit& u, int wr, int wc, int fr, int fq) const {
        const int row0 = u.pm * 256 + wr * 64 + fr, col0 = u.pn * 256 + wc * 32 + 8 * fq;
        f32x4 gv[2][2];
#pragma unroll
        for (int bj = 0; bj < 2; ++bj)
#pragma unroll
            for (int n = 0; n < 2; ++n) gv[bj][n] = ldg<f32x4>(g2 + col0 + bj * 128 + 4 * n);
        f32x4 rc[4], rn[4];
#define ER_LOAD(R, grp) do { const size_t o_ = (size_t)(row0 + ((grp) >> 2) * 128 + ((grp) & 3) * 16) * DM + col0; \
            R[0] = ldg_nt<f32x4>(res + o_); R[1] = ldg_nt<f32x4>(res + o_ + 4); R[2] = ldg_nt<f32x4>(res + o_ + 128); R[3] = ldg_nt<f32x4>(res + o_ + 132); } while (0)
        ER_LOAD(rc, 0);
#pragma unroll
        for (int grp = 0; grp < 8; ++grp) { const int ai = grp >> 2, m = grp & 3; const int r = row0 + ai * 128 + m * 16; const size_t off = (size_t)r * DM + col0; float ss = 0.f;
            if (grp + 1 < 8) ER_LOAD(rn, grp + 1);
#pragma unroll
            for (int bj = 0; bj < 2; ++bj) {
                const f32x4 v0 = acc[ai][bj][m][0] + rc[2 * bj], v1 = acc[ai][bj][m][1] + rc[2 * bj + 1];
                stg<f32x4>(out + off + bj * 128, v0); stg<f32x4>(out + off + bj * 128 + 4, v1);
                ss += v0[0] * v0[0] + v0[1] * v0[1] + v0[2] * v0[2] + v0[3] * v0[3] + v1[0] * v1[0] + v1[1] * v1[1] + v1[2] * v1[2] + v1[3] * v1[3];
                stg<bf16x8>(hg + off + bj * 128, pack8(v0 * gv[bj][0], v1 * gv[bj][1])); }
            ss += shx<16>(ss); ss = sum32(ss);
            if (fq == 0) atomicAdd(rowss + r, (unsigned long long)(ss * 16777216.f + 0.5f));
#pragma unroll
            for (int q = 0; q < 4; ++q) rc[q] = rn[q]; }
#undef ER_LOAD
#undef ER_Q4
    }
};
__device__ __forceinline__ float rstd_of(const unsigned long long* rowss, int r) { const unsigned long long v = ldg<unsigned long long>(rowss + r); return rsqrtf((float)v * (1.f / 16777216.f) * (1.f / DM) + NORM_EPS); }
struct EpiBf16S {
    static constexpr bool PERM = true;
    bf16_t* O; int ldc; const unsigned long long* rowss;
    __device__ __forceinline__ void operator()(const f32x4 (&acc)[2][2][4][2], const pg8::Unit& u, int wr, int wc, int fr, int fq) const {
        const int row0 = u.pm * 256 + wr * 64 + fr, col0 = u.pn * 256 + wc * 32 + 8 * fq;
        float rs[8];
#pragma unroll
        for (int grp = 0; grp < 8; ++grp) rs[grp] = rstd_of(rowss, row0 + (grp >> 2) * 128 + (grp & 3) * 16) * (1.0f / (X8_SCALE * WO8_SCALE));
        int fo = fq, ro = fr; asm volatile("" : "+v"(fo), "+v"(ro));
        const unsigned lb = (unsigned)((((2 * wc + (fo >> 1)) * 2 + (fo & 1)) * 32 + ro) * 8);
        bf16_t* tile = O + (size_t)(u.pm * 8 + u.pn) * 65536;
#pragma unroll
        for (int ai = 0; ai < 2; ++ai)
#pragma unroll
            for (int m = 0; m < 4; ++m) {
                const unsigned so = (unsigned)((4 * ai + 2 * wr + (m >> 1)) * 2 * 4096 + 16 * (m & 1) * 8);
#pragma unroll
                for (int bj = 0; bj < 2; ++bj) stg<bf16x8>(tile + so + bj * 4096 + lb, pack8(acc[ai][bj][m][0] * rs[ai * 4 + m], acc[ai][bj][m][1] * rs[ai * 4 + m])); }
    }
};

struct EpiRes3 {
    static constexpr bool PERM = true;
    bf16_t* out; const float* res; const bf16_t* res16; unsigned long long* rowss; unsigned char* out8;
    const unsigned char* res8 = nullptr; const float* rsc8 = nullptr;
    __device__ __forceinline__ void operator()(const f32x4 (&acc)[2][2][4][2], const pg8::Unit& u, int wr, int wc, int fr, int fq) const {
        const int row0 = u.pm * 256 + wr * 64 + fr, col0 = u.pn * 256 + wc * 32 + 8 * fq;
        f32x4 rc[4];
        float rq[8];
#pragma unroll
        for (int g = 0; g < 8; ++g) rq[g] = res8 ? ldg<float>(rsc8 + (size_t)(row0 + (g >> 2) * 128 + (g & 3) * 16) * 8) : 0.f;
#define ER_Q4(w_, s_) (f32x4){fmaf((float)(((w_) ^ 0x80808080u) & 0xffu), s_, -128.f * (s_)), fmaf((float)((((w_) ^ 0x80808080u) >> 8) & 0xffu), s_, -128.f * (s_)), fmaf((float)((((w_) ^ 0x80808080u) >> 16) & 0xffu), s_, -128.f * (s_)), fmaf((float)(((w_) ^ 0x80808080u) >> 24), s_, -128.f * (s_))}
#pragma unroll
        for (int hb = 0; hb < 2; ++hb) {
        u32x4 ra[4], rb[4];
#pragma unroll
        for (int g4 = 0; g4 < 4; ++g4) { const int grp = hb * 4 + g4; const size_t o_ = (size_t)(row0 + (grp >> 2) * 128 + (grp & 3) * 16) * DM + col0;
            if (res8) { const u32x2 a_ = ldg_nt<u32x2>(res8 + o_), b_ = ldg_nt<u32x2>(res8 + o_ + 128); ra[g4] = (u32x4){a_[0], a_[1], 0u, 0u}; rb[g4] = (u32x4){b_[0], b_[1], 0u, 0u}; }
            else { ra[g4] = ldg_nt<u32x4>(res16 + o_); rb[g4] = ldg_nt<u32x4>(res16 + o_ + 128); } }
#pragma unroll
        for (int g4 = 0; g4 < 4; ++g4) { const int grp = hb * 4 + g4; const int ai = grp >> 2, m = grp & 3; const int r = row0 + ai * 128 + m * 16; const size_t off = (size_t)r * DM + col0; float ss = 0.f;
            if (res8) { const float s_ = rq[grp]; rc[0] = ER_Q4(ra[g4][0], s_); rc[1] = ER_Q4(ra[g4][1], s_); rc[2] = ER_Q4(rb[g4][0], s_); rc[3] = ER_Q4(rb[g4][1], s_); }
            else { const u32x4 a_ = ra[g4], b_ = rb[g4];
                rc[0] = (f32x4){bflo(a_[0]), bfhi(a_[0]), bflo(a_[1]), bfhi(a_[1])}; rc[1] = (f32x4){bflo(a_[2]), bfhi(a_[2]), bflo(a_[3]), bfhi(a_[3])};
                rc[2] = (f32x4){bflo(b_[0]), bfhi(b_[0]), bflo(b_[1]), bfhi(b_[1])}; rc[3] = (f32x4){bflo(b_[2]), bfhi(b_[2]), bflo(b_[3]), bfhi(b_[3])}; }
#pragma unroll
            for (int bj = 0; bj < 2; ++bj) {
                const f32x4 v0 = acc[ai][bj][m][0] * (1.0f / (M8_SCALE * WO8_SCALE)) + rc[2 * bj], v1 = acc[ai][bj][m][1] * (1.0f / (M8_SCALE * WO8_SCALE)) + rc[2 * bj + 1];
                ss += v0[0] * v0[0] + v0[1] * v0[1] + v0[2] * v0[2] + v0[3] * v0[3] + v1[0] * v1[0] + v1[1] * v1[1] + v1[2] * v1[2] + v1[3] * v1[3];
                stg<bf16x8>(out + off + bj * 128, pack8(v0, v1));
                { int o0 = 0, o1 = 0;
                  o0 = __builtin_amdgcn_cvt_pk_fp8_f32(v0[0] * X8_SCALE, v0[1] * X8_SCALE, o0, false); o0 = __builtin_amdgcn_cvt_pk_fp8_f32(v0[2] * X8_SCALE, v0[3] * X8_SCALE, o0, true);
                  o1 = __builtin_amdgcn_cvt_pk_fp8_f32(v1[0] * X8_SCALE, v1[1] * X8_SCALE, o1, false); o1 = __builtin_amdgcn_cvt_pk_fp8_f32(v1[2] * X8_SCALE, v1[3] * X8_SCALE, o1, true);
                  stg<u32x2>(out8 + off + bj * 128, (u32x2){(unsigned)o0, (unsigned)o1}); } }
            ss += shx<16>(ss); ss = sum32(ss);
            if (fq == 0) atomicAdd(rowss + r, (unsigned long long)(ss * 16777216.f + 0.5f)); }
        }
    }
};

namespace att {
constexpr int D = 128, NW = 8, QBLK = 32, KVBLK = 64, QB = NW * QBLK;
constexpr int SHM_V = KVBLK * D * 2, SHM_K = KVBLK * D * 2;
constexpr int OFF_WS = 2 * SHM_V + 2 * SHM_K;
constexpr int OFF_BIAS = OFF_WS + NW * 64 * 4;
constexpr int OFF_KM = OFF_BIAS + 4096 * 4;
constexpr int OFF_MISC = OFF_KM + 32 * 128 * 2;
constexpr int OFF_Q = 94208;
constexpr float THR2 = 8.f * LOG2E;

#define KSWZ(row, colB) ((row) * 256 + ((colB) ^ (((row) & 7) << 4)))
#define SBAR() __builtin_amdgcn_sched_barrier(0)
__device__ __forceinline__ int v_st(int k, int c) { const int kk = (k & ~0xC) | ((k & 4) << 1) | ((k & 8) >> 1); return ((kk >> 3) * 4 + (c >> 5)) * 512 + ((kk & 7) * 32 + (c & 31)) * 2; }
__device__ __forceinline__ int v_rd_base(int lane) { return ((lane & 3) << 3) | (((lane >> 2) & 3) << 6) | (((lane >> 4) & 1) << 5) | (((lane >> 5) & 1) << 8); }
constexpr int v_rd_off(int d0, int ks, int half) { return d0 * 512 + ks * 4096 + half * 2048; }
__device__ __forceinline__ int crow(int r, int hi) { return (r & 3) + 8 * (r >> 2) + 4 * hi; }
__device__ __forceinline__ bf16x8 load8(const bf16_t* p) { return ldg<bf16x8>(p); }

__device__ __forceinline__ void mask_tile(f32x16& p0, f32x16& p1, int dq) {
    const float NEG = -__builtin_inff();
#pragma unroll
    for (int r = 0; r < 16; ++r) {
        const int c = (r & 3) + 8 * (r >> 2);
        if (dq - c < 0) p0[r] = NEG;
        if (dq - c - 32 < 0) p1[r] = NEG;
    }
}
__device__ __forceinline__ void kill_tile(f32x16& p0, f32x16& p1, bool dead) {
    const float NEG = -__builtin_inff();
#pragma unroll
    for (int r = 0; r < 16; ++r) { p0[r] = dead ? NEG : p0[r]; p1[r] = dead ? NEG : p1[r]; }
}
__device__ __forceinline__ void bias_tile(f32x16& p0, f32x16& p1, const float* bl, int hi) {
#pragma unroll
    for (int g = 0; g < 4; ++g) {
        const f32x4 b0 = *(const f32x4*)(bl + 8 * g + 4 * hi), b1 = *(const f32x4*)(bl + 32 + 8 * g + 4 * hi);
#pragma unroll
        for (int j = 0; j < 4; ++j) { p0[4 * g + j] += b0[j]; p1[4 * g + j] += b1[j]; }
        asm volatile("" ::: "memory");
    }
}
__device__ __forceinline__ void partialSM(f32x16& p0, f32x16& p1, float& m_reg, float& mn, float& alpha, bool dead) {
    float pmax = p0[0];
#pragma unroll
    for (int r = 1; r < 16; ++r) pmax = fmaxf(pmax, p0[r]);
#pragma unroll
    for (int r = 0; r < 16; ++r) pmax = fmaxf(pmax, p1[r]);
    { auto rr = __builtin_amdgcn_permlane32_swap(__float_as_uint(pmax), __float_as_uint(pmax), false, false);
      pmax = fmaxf(__uint_as_float(rr[0]), __uint_as_float(rr[1])); }
    pmax = dead ? -1e30f : pmax;
    if (__builtin_expect(__all((pmax - m_reg) <= THR2), 1)) { mn = m_reg; alpha = 1.f; }
    else { mn = fmaxf(m_reg, pmax); alpha = __builtin_amdgcn_exp2f(m_reg - mn); m_reg = mn; }
    const float mne = dead ? __builtin_inff() : mn;
#pragma unroll
    for (int r = 0; r < 16; ++r) p0[r] = p0[r] - mne;
#pragma unroll
    for (int r = 0; r < 16; ++r) p1[r] = p1[r] - mne;
#pragma unroll
    for (int r = 0; r < 16; ++r) p0[r] = __builtin_amdgcn_exp2f(p0[r]);
}
__device__ __forceinline__ void finishSM(f32x16& p0, f32x16& p1, float alpha, float& l_reg, bf16x8& pa0, bf16x8& pa1, bf16x8& pa2, bf16x8& pa3) {
#pragma unroll
    for (int r = 0; r < 16; ++r) p1[r] = __builtin_amdgcn_exp2f(p1[r]);
    float ps = 0;
#pragma unroll
    for (int r = 0; r < 16; ++r) ps += p0[r];
#pragma unroll
    for (int r = 0; r < 16; ++r) ps += p1[r];
    { auto rr = __builtin_amdgcn_permlane32_swap(__float_as_uint(ps), __float_as_uint(ps), false, false);
      ps = __uint_as_float(rr[0]) + __uint_as_float(rr[1]); }
    l_reg = l_reg * alpha + ps;
#define PK4(P, B_, OUT) do { unsigned a0 = cvtpk(P[B_+0], P[B_+1]), a1 = cvtpk(P[B_+2], P[B_+3]);                          \
        unsigned b0 = cvtpk(P[B_+4], P[B_+5]), b1 = cvtpk(P[B_+6], P[B_+7]);                                             \
        auto r0 = __builtin_amdgcn_permlane32_swap(a0, b0, false, false); auto r1 = __builtin_amdgcn_permlane32_swap(a1, b1, false, false); \
        u32x4 w = {r0[0], r1[0], r0[1], r1[1]}; OUT = *reinterpret_cast<bf16x8*>(&w); } while (0)
    PK4(p0, 0, pa0); PK4(p0, 8, pa1); PK4(p1, 0, pa2); PK4(p1, 8, pa3);
#undef PK4
}
template <int KB, int ND>
__device__ __forceinline__ void qkt_(f32x16& p0, f32x16& p1, const char* K_lds, int r32, int hi, const char* qr) {
    p0 = f32x16{}; p1 = f32x16{};
    const char* kb[4];
#pragma unroll
    for (int dd = 0; dd < 4; ++dd) kb[dd] = K_lds + KB * SHM_K + KSWZ(r32, (dd * 16 + hi * 8) * 2);
#pragma unroll
    for (int d0 = 0; d0 < ND; ++d0) { const char* a = kb[d0 & 3] + (d0 >> 2) * 128;
        bf16x8 b0 = *reinterpret_cast<const bf16x8*>(a);
        bf16x8 b1 = *reinterpret_cast<const bf16x8*>(a + 32 * 256);
        const bf16x8 q = *reinterpret_cast<const bf16x8*>(qr + d0 * 1024);
        p0 = __builtin_amdgcn_mfma_f32_32x32x16_bf16(b0, q, p0, 0, 0, 0);
        p1 = __builtin_amdgcn_mfma_f32_32x32x16_bf16(b1, q, p1, 0, 0, 0); }
}
template <int KB>
__device__ __forceinline__ void qkt(f32x16& p0, f32x16& p1, const char* K_lds, int r32, int hi, const char* qr, bool d64) {
    if (d64) qkt_<KB, 4>(p0, p1, K_lds, r32, hi, qr); else qkt_<KB, 8>(p0, p1, K_lds, r32, hi, qr);
}
template <int VB>
__device__ __forceinline__ void pv_tile(f32x16* o, int vb0, bf16x8 pa0, bf16x8 pa1, bf16x8 pa2, bf16x8 pa3) {
#define TRRD(dst, off) asm volatile("ds_read_b64_tr_b16 %0, %1 offset:%2" : "=&v"(dst) : "v"(vb0), "i"(off) : "memory")
#define PV_D0(d0) do { s16x4 l0, l1, l2, l3, h0, h1, h2, h3; constexpr int b_ = VB * SHM_V + v_rd_off(d0, 0, 0); \
        TRRD(l0, b_); TRRD(h0, b_ + 2048); TRRD(l1, b_ + 4096); TRRD(h1, b_ + 6144); TRRD(l2, b_ + 8192); TRRD(h2, b_ + 10240); TRRD(l3, b_ + 12288); TRRD(h3, b_ + 14336); \
        asm volatile("s_waitcnt lgkmcnt(0)" ::: "memory"); SBAR();   \
        o[d0] = __builtin_amdgcn_mfma_f32_32x32x16_bf16(pa0, (bf16x8){l0[0], l0[1], l0[2], l0[3], h0[0], h0[1], h0[2], h0[3]}, o[d0], 0, 0, 0);   \
        o[d0] = __builtin_amdgcn_mfma_f32_32x32x16_bf16(pa1, (bf16x8){l1[0], l1[1], l1[2], l1[3], h1[0], h1[1], h1[2], h1[3]}, o[d0], 0, 0, 0);   \
        o[d0] = __builtin_amdgcn_mfma_f32_32x32x16_bf16(pa2, (bf16x8){l2[0], l2[1], l2[2], l2[3], h2[0], h2[1], h2[2], h2[3]}, o[d0], 0, 0, 0);   \
        o[d0] = __builtin_amdgcn_mfma_f32_32x32x16_bf16(pa3, (bf16x8){l3[0], l3[1], l3[2], l3[3], h3[0], h3[1], h3[2], h3[3]}, o[d0], 0, 0, 0); } while (0)
    PV_D0(0); PV_D0(1); PV_D0(2); PV_D0(3);
#undef PV_D0
#undef TRRD
}

struct BlockRef { const bf16_t* Q; const bf16_t* K; const bf16_t* V; bf16_t* O; const float* cb; int P0, ldo, mode, jlo, kp; };
struct Seam { bf16x8 qr[8]; bf16x8 st_v0, st_v1, st_k0, st_k1; };

#define ROW(p, k0, rr) ((p) + (size_t)((k0) + (rr)) * D + sc)
#define VMW() asm volatile("s_waitcnt vmcnt(0)" ::: "memory")
#define VMWN(n) asm volatile("s_waitcnt vmcnt(%0)" :: "i"(n) : "memory")
#define SLOAD_H(Kp, Vp, k0, kp_) do { S.st_v0 = load8(ROW(Vp, k0, sr)); S.st_v1 = load8(ROW(Vp, k0, 32 + sr));              \
                         if (sc < (kp_)) { S.st_k0 = load8((Kp) + (size_t)((k0) + sr) * (kp_) + sc); S.st_k1 = load8((Kp) + (size_t)((k0) + 32 + sr) * (kp_) + sc); } } while (0)
#define SWRITE_HK(bf) do { *(bf16x8*)(K_lds + (bf) * SHM_K + kws) = S.st_k0; *(bf16x8*)(K_lds + (bf) * SHM_K + kws + 32 * 256) = S.st_k1; } while (0)
#define SWRITE_HV(bf) do { *(bf16x8*)(V_lds + (bf) * SHM_V + vst0) = S.st_v0; *(bf16x8*)(V_lds + (bf) * SHM_V + vst1) = S.st_v1; } while (0)
#define SWRITE_H(bf) do { SWRITE_HV(bf); SWRITE_HK(bf); } while (0)

__device__ __forceinline__ void attn_prime(const BlockRef& cur, char* lds, Seam& S) {
    int tid = threadIdx.x; asm volatile("" : "+v"(tid));
    const int wid = __builtin_amdgcn_readfirstlane(tid >> 6), lane = tid & 63, r32 = lane & 31, hi = lane >> 5;
    const int sr = tid >> 4, sc = (tid & 15) * 8, kws = KSWZ(sr, sc * 2); char* K_lds = lds + 2 * SHM_V;
#pragma unroll
    for (int d0 = 0; d0 < 8; ++d0) { S.qr[d0] = bf16x8{}; if (d0 * 16 < cur.kp) S.qr[d0] = load8(cur.Q + (size_t)(wid * QBLK + r32) * cur.kp + d0 * 16 + hi * 8); }
    S.st_k0 = bf16x8{}; S.st_k1 = bf16x8{};
    SLOAD_H(cur.K, cur.V, cur.jlo * KVBLK, cur.kp); VMW(); SWRITE_HK(0);
    __syncthreads();
}

__device__ __forceinline__ unsigned attn_item_setup(const BlockRef& cur, char* lds, const Seam& S) {
    int tid = threadIdx.x; asm volatile("" : "+v"(tid));
    const int lane = tid & 63, r32 = lane & 31, hi = lane >> 5;
    unsigned sel = 0u;
    if (cur.mode == 2) {
        float* bl = (float*)(lds + OFF_BIAS);
        const float cref = ldg<float>(cur.cb + cur.P0);
        for (int k = cur.jlo * KVBLK + tid; k < cur.P0 + QB; k += NW * 64) bl[k] = (cref - ldg<float>(cur.cb + k)) * LOG2E;
    } else if (cur.mode == 1) {
        const int own = cur.P0 >> 8;
        bf16_t* km = (bf16_t*)(lds + OFF_KM);
        { const int n = tid >> 4;
          u32x4 w = zero4();
          if (n < own) { typedef int i32x4s __attribute__((ext_vector_type(4))); const int* ks = (const int*)cur.cb + tid * 8; const i32x4s a = ldg<i32x4s>(ks), b = ldg<i32x4s>(ks + 4); const float sc = 1.f / (256.f * 262144.f);
              w = (u32x4){cvtpk((float)a[0] * sc, (float)a[1] * sc), cvtpk((float)a[2] * sc, (float)a[3] * sc), cvtpk((float)b[0] * sc, (float)b[1] * sc), cvtpk((float)b[2] * sc, (float)b[3] * sc)}; }
          *(u32x4*)(km + tid * 8) = w; }
        __syncthreads();
        f32x16 g = f32x16{};
#pragma unroll
        for (int d0 = 0; d0 < 8; ++d0) { const bf16x8 a = *(const bf16x8*)(km + r32 * 128 + d0 * 16 + hi * 8); g = __builtin_amdgcn_mfma_f32_32x32x16_bf16(a, S.qr[d0], g, 0, 0, 0); }
        float gv[16];
#pragma unroll
        for (int r = 0; r < 8; ++r) { const float mine = g[r], other = shx32(mine, hi != 0);
            const int nm = (r & 3) + 8 * (r >> 2);
            gv[nm] = hi ? other : mine; gv[nm + 4] = hi ? mine : other; }
#pragma unroll
        for (int pass = 0; pass < 3; ++pass) { float best = -__builtin_inff(); int bi = -1;
#pragma unroll
            for (int n = 0; n < 16; ++n) { const bool ok = (n < own) && !((sel >> n) & 1u) && (gv[n] > best); best = ok ? gv[n] : best; bi = ok ? n : bi; }
            if (bi >= 0) sel |= 1u << bi; }
    }
    __syncthreads();
    return sel;
}

template <class NextFn>
__device__ __forceinline__ void attn_block(const BlockRef& cur, const NextFn& next_ref, char* lds, Seam& S) {
    int tid = threadIdx.x; asm volatile("" : "+v"(tid));
    const int wid = __builtin_amdgcn_readfirstlane(tid >> 6), lane = tid & 63, r32 = lane & 31, hi = lane >> 5;
    const unsigned sel = attn_item_setup(cur, lds, S);
    const char* Q_lds = lds + OFF_Q + wid * 8192 + lane * 16;
#pragma unroll
    for (int d0 = 0; d0 < 8; ++d0) *(bf16x8*)(lds + OFF_Q + wid * 8192 + d0 * 1024 + lane * 16) = S.qr[d0];
    const int mode = cur.mode;
    const int jlo = cur.jlo, NT = cur.P0 / KVBLK + QB / KVBLK - jlo;
    const int qlo = cur.P0 + wid * QBLK, qm = qlo + r32 - 4 * hi;
    char* V_lds = lds; char* K_lds = lds + 2 * SHM_V;
    float* ws = (float*)(lds + OFF_WS) + wid * 64; float* li_l = ws, * al_l = ws + 32;
    const float* bias_l = (const float*)(lds + OFF_BIAS);
    float m_reg = -1e30f, l_reg = 0; f32x16 o[4] = {};
    const int sr = tid >> 4, sc = (tid & 15) * 8, vst0 = v_st(sr, sc), vst1 = vst0 + 8192  , kws = KSWZ(sr, sc * 2);
    const int vb0 = (int)(uintptr_t)V_lds + v_rd_base(lane);
    const bf16_t* Kh = cur.K; const bf16_t* Vh = cur.V;
#define RESC(a) do { if (__any((a) < 1.f)) { if (hi == 0) al_l[r32] = (a); asm volatile("s_waitcnt lgkmcnt(0)" ::: "memory");              \
                     for (int d_ = 0; d_ < 4; ++d_) for (int r = 0; r < 16; ++r) o[d_][r] *= al_l[crow(r, hi)]; } } while (0)
#define KBASE(t) ((jlo + (t)) * KVBLK)
#define MASKT(P0_, P1_, t) do { const int kb_ = KBASE(t);                                                          \
        if (mode == 2) bias_tile(P0_, P1_, bias_l + kb_, hi);                                                      \
        deadv = (mode == 1 && kb_ < cur.P0) ? !((sel >> (kb_ >> 8)) & 1u) : false;                                  \
        if (kb_ + KVBLK - 1 > qlo) mask_tile(P0_, P1_, qm - kb_); } while (0)
#define SEAM_K0() do { if (nxt.kp == 64) VMWN(4); else VMWN(8); SWRITE_HK(0); SBAR(); } while (0)
    f32x16 pA0, pA1, pB0, pB1; float mnA, mnB, alA, alB; bf16x8 pa0, pa1, pa2, pa3; bool deadv = false;
    SWRITE_HV(0); SBAR();
    const int kp = cur.kp; const bool d64 = kp == 64;
    if (NT > 1) { SLOAD_H(Kh, Vh, KBASE(1), kp); }
    SBAR(); qkt<0>(pA0, pA1, K_lds, r32, hi, Q_lds, d64);
    MASKT(pA0, pA1, 0); partialSM(pA0, pA1, m_reg, mnA, alA, deadv);
    if (NT > 1) { VMW(); SWRITE_H(1); }
    __syncthreads();
#define HALF_STEP(PX0, PX1, mnX, alX, PY0, PY1, alY, t, KB, VB, SB) do {                                           \
        SBAR(); qkt<KB>(PX0, PX1, K_lds, r32, hi, Q_lds, d64);                                                      \
        finishSM(PY0, PY1, alY, l_reg, pa0, pa1, pa2, pa3); SBAR();                                                \
        if ((t) + 1 < NT) { SLOAD_H(Kh, Vh, KBASE((t) + 1), kp); SBAR(); }                                         \
        pv_tile<VB>(o, vb0, pa0, pa1, pa2, pa3); MASKT(PX0, PX1, (t)); partialSM(PX0, PX1, m_reg, mnX, alX, deadv);       \
        __syncthreads();                                                                                           \
        if ((t) + 1 < NT) { VMW(); SWRITE_H(SB); }                                                                 \
        RESC(alX); __syncthreads(); } while (0)
    for (int t = 1; t + 1 < NT; t += 2) {
        HALF_STEP(pB0, pB1, mnB, alB, pA0, pA1, alA, t, 1, 0, 0);
        HALF_STEP(pA0, pA1, mnA, alA, pB0, pB1, alB, t + 1, 0, 1, 1);
    }
    const bool even = (NT & 1) == 0;
    if (even) { SBAR(); qkt<1>(pB0, pB1, K_lds, r32, hi, Q_lds, d64); SBAR(); }
    const BlockRef nxt = next_ref();
    SLOAD_H(nxt.K, nxt.V, nxt.jlo * KVBLK, nxt.kp); SBAR();
#pragma unroll
    for (int d0 = 0; d0 < 8; ++d0) { S.qr[d0] = bf16x8{}; if (d0 * 16 < nxt.kp) S.qr[d0] = load8(nxt.Q + (size_t)(wid * QBLK + r32) * nxt.kp + d0 * 16 + hi * 8); }
    SBAR();
    finishSM(pA0, pA1, alA, l_reg, pa0, pa1, pa2, pa3); SBAR();
    pv_tile<0>(o, vb0, pa0, pa1, pa2, pa3);
    if (even) { MASKT(pB0, pB1, NT - 1); partialSM(pB0, pB1, m_reg, mnB, alB, deadv); __syncthreads(); RESC(alB);
        finishSM(pB0, pB1, alB, l_reg, pa0, pa1, pa2, pa3); SBAR(); pv_tile<1>(o, vb0, pa0, pa1, pa2, pa3); }
    SBAR(); SEAM_K0();
    if (hi == 0) li_l[r32] = l_reg; asm volatile("s_waitcnt lgkmcnt(0)" ::: "memory");
    const GAS char* Ow = (const GAS char*)(cur.O + (size_t)(wid * QBLK) * cur.ldo);
    const unsigned ob = (unsigned)((4 * hi) * cur.ldo + r32) * 2u;
#pragma unroll
    for (int r = 0; r < 16; ++r) { const unsigned orow_b = (unsigned)(((r & 3) + 8 * (r >> 2)) * cur.ldo) * 2u;
        const float rl = __builtin_amdgcn_rcpf(li_l[crow(r, hi)]);
#pragma unroll
        for (int d0 = 0; d0 < 4; ++d0) { const float v = o[d0][r] * rl;
            const float vn = shx<1>(v);
            if ((r32 & 1) == 0) *(GAS unsigned*)(Ow + (size_t)(ob + orow_b + (unsigned)(d0 * 64))) = cvtpk(v, vn); } }
    __syncthreads();
#undef RESC
#undef KBASE
#undef MASKT
#undef SEAM_K0
#undef HALF_STEP
}
#undef ROW
#undef VMW
#undef VMWN
#undef SLOAD_H
#undef SWRITE_HK
#undef SWRITE_HV
#undef SWRITE_H
}

struct Args {
    const float* in[25]; float* out; unsigned char* ws;
    double invrev[16];
    int ph_lo, ph_hi;
};
struct Frame {
    int tid, lane, wave, G, bid, gw, GW;
    unsigned char* ws; unsigned char* lds;
};
constexpr int ARG_OFF = 159744;
__device__ __forceinline__ const float* arg_in(const Frame& F, int j) {
    int off = ARG_OFF; asm volatile("" : "+v"(off));
    const LAS unsigned* la = (const LAS unsigned*)((LAS unsigned char*)F.lds + off);
    const unsigned lo = __builtin_amdgcn_readfirstlane(la[2 * j]), hi = __builtin_amdgcn_readfirstlane(la[2 * j + 1]);
    return (const float*)(((unsigned long long)hi << 32) | lo);
}
__device__ __forceinline__ const LAS double* arg_invrev(const Frame& F) { int off = ARG_OFF + 27 * 8; asm volatile("" : "+v"(off)); return (const LAS double*)((LAS unsigned char*)F.lds + off); }
enum { I_X = 0, I_NORM1, I_WIN, I_BGATE, I_BFORGET, I_AQN, I_AKN, I_LQ1, I_LK1, I_LQ2, I_LK2, I_AON, I_BQN, I_BKN, I_CQN, I_CKN, I_WBA, I_WBB, I_WBC, I_WOUT, I_NORM2, I_WPQ, I_PSK, I_PU, I_PV };

#define XB_TMO      128
#define XB_XCNT(j)  (256  + 64 * (j))
#define XB_XSUB(j)  (1280 + 64 * (j))
#define XB_XGEN(j)  (2304 + 64 * (j))
#define XB_TOP      3328
#define XB_TOPGEN   3392
#define XCD_BAR_WORDS 3456
#define XB_SPIN_CAP (1u << 22)
__device__ __forceinline__ unsigned xb_ld(unsigned* p)              { return __hip_atomic_load(p, __ATOMIC_RELAXED, __HIP_MEMORY_SCOPE_AGENT); }
__device__ __forceinline__ unsigned xb_add(unsigned* p, unsigned v) { return __hip_atomic_fetch_add(p, v, __ATOMIC_RELAXED, __HIP_MEMORY_SCOPE_AGENT); }
__device__ __forceinline__ unsigned xb_xcc_id() { return (unsigned)__builtin_amdgcn_s_getreg((3 << 11) | 20) & 0xFu; }
#define XB_SPIN(cond, bar) do { unsigned _sp = 0; while (cond) { __builtin_amdgcn_s_sleep(1); \
    if ((++_sp & 255u) == 0u) { if (xb_ld(&(bar)[XB_TMO])) break; if (_sp > XB_SPIN_CAP) { atomicAdd(&(bar)[XB_TMO], 1u); break; } } } } while (0)
struct XcdBarrier { unsigned* bar; unsigned x; volatile LAS unsigned* st; };
__device__ __forceinline__ XcdBarrier xcd_barrier_post(unsigned* bar, volatile LAS unsigned* st) {
    XcdBarrier b; b.bar = bar; b.x = xb_xcc_id(); b.st = st;
    if (threadIdx.x == 0) (void)xb_add(&bar[XB_XCNT(b.x)], 1u);
    return b;
}
__device__ __forceinline__ void xcd_barrier_complete(unsigned* bar, unsigned x, unsigned& nloc, unsigned& nx) {
    const unsigned G = gridDim.x * gridDim.y * gridDim.z;
    unsigned sum, cnt, mine, sp = 0u;
    for (;;) {
        sum = 0u; cnt = 0u; mine = 0u;
#pragma unroll
        for (unsigned j = 0; j < 16; ++j) { const unsigned c = xb_ld(&bar[XB_XCNT(j)]); sum += c; cnt += (c > 0u) ? 1u : 0u; mine = (j == x) ? c : mine; }
        if (sum == G) break;
        __builtin_amdgcn_s_sleep(1);
        if ((++sp & 255u) == 0u) { if (xb_ld(&bar[XB_TMO])) break; if (sp > XB_SPIN_CAP) { atomicAdd(&bar[XB_TMO], 1u); break; } }
    }
    nloc = mine > 0u ? mine : 1u; nx = cnt > 0u ? cnt : 1u;
}
__device__ __forceinline__ void xcd_barrier(const XcdBarrier& b) {
    asm volatile("s_waitcnt vmcnt(0)" ::: "memory");
    __syncthreads();
    if (threadIdx.x == 0) {
        unsigned* bar = b.bar;
        __builtin_amdgcn_s_waitcnt(0);
        unsigned nloc = b.st[0], nx = b.st[1];
        if (nloc == 0u) { xcd_barrier_complete(bar, b.x, nloc, nx); b.st[0] = nloc; b.st[1] = nx; }
        const unsigned old = xb_add(&bar[XB_XSUB(b.x)], 1u);
        const unsigned gen = old / nloc;
        if (old + 1u == (gen + 1u) * nloc) {
            __builtin_amdgcn_fence(__ATOMIC_RELEASE, "agent");
            asm volatile("s_waitcnt vmcnt(0)" ::: "memory");
            const unsigned og = xb_add(&bar[XB_TOP], 1u);
            const unsigned tg = og / nx;
            if (og + 1u == (tg + 1u) * nx) xb_add(&bar[XB_TOPGEN], 1u);
            else XB_SPIN(xb_ld(&bar[XB_TOPGEN]) == tg, bar);
            __builtin_amdgcn_fence(__ATOMIC_ACQUIRE, "agent");
            asm volatile("s_waitcnt vmcnt(0)" ::: "memory");
            xb_add(&bar[XB_XGEN(b.x)], 1u);
            asm volatile("s_waitcnt vmcnt(0)" ::: "memory");
        } else {
            asm volatile("buffer_inv sc1" ::: "memory");
            XB_SPIN(xb_ld(&bar[XB_XGEN(b.x)]) == gen, bar);
            asm volatile("s_waitcnt vmcnt(0)" ::: "memory");
        }
    }
    __syncthreads();
}

struct CvtTile { const float* src; bf16_t* dst; const float* gk; int ldsrc, lddst; unsigned char* dst8; };
constexpr int CVT_TILES = 32 * 6 + 32 * 5 + 32 * 5 + 32 * 16 + 32 * 16;
__device__ __forceinline__ CvtTile cvt_decode(const Frame& F, int t) {
    const int l = t / CVT_TILES; int u = t - l * CVT_TILES;
    unsigned char* wl = F.ws + WS_W0 + (size_t)l * WL_SIZE;
    const float* W; const float* gk = nullptr; int ld, nt, kt, coloff = 0, kdoff = 0, lddst; bf16_t* D; unsigned char* D8 = nullptr;
    if (u < 32 * 6) { nt = u / 6; kt = u % 6; W = arg_in(F, I_WBA) + (size_t)l * 768 * DM; ld = DM; D = (bf16_t*)(wl + WO_WBR_T); lddst = 768; }
    else if ((u -= 32 * 6) < 32 * 5) { nt = u / 5; kt = u % 5; W = arg_in(F, I_WBB) + (size_t)l * 640 * DM; ld = DM; D = (bf16_t*)(wl + WO_WBR_T) + (size_t)2048 * 768; lddst = 768; }
    else if ((u -= 32 * 5) < 32 * 5) { nt = u / 5; kt = u % 5; W = arg_in(F, I_WBC) + (size_t)l * 640 * DM; ld = DM; D = (bf16_t*)(wl + WO_WBR_T) + (size_t)2 * 2048 * 768; lddst = 768; }
    else if ((u -= 32 * 5) < 32 * 16) { nt = u / 16; kt = u % 16; W = arg_in(F, I_WOUT) + (size_t)l * DM * DM; ld = DM; D = (bf16_t*)(wl + WO_WOUT_T); lddst = 2048; D8 = wl + WO_WOUT_T + (size_t)(nt * 64) * 2048 + kt * 128; }
    else { u -= 32 * 16; nt = u / 16; kt = u % 16; W = arg_in(F, I_WPQ) + (size_t)l * DM * DM; ld = DM; D = (bf16_t*)(wl + WO_WQ_T); lddst = 2048; gk = arg_in(F, I_NORM2) + l * DM + kt * 128; D8 = wl + WO_WQ_T + (size_t)(nt * 64) * 2048 + kt * 128; }
    CvtTile c; c.src = W + (size_t)(kt * 128) * ld + nt * 64 + coloff; c.ldsrc = ld; c.dst = D + (size_t)(nt * 64) * lddst + kdoff + kt * 128; c.lddst = lddst; c.gk = gk; c.dst8 = D8; return c;
}
__device__ __forceinline__ void cvt_load(const Frame& F, const CvtTile& c, float (&r)[16]) {
    const int n = F.tid & 63, kq = F.tid >> 6;
#pragma unroll
    for (int i = 0; i < 16; ++i) r[i] = ldg_nt<float>(c.src + (size_t)(kq + 8 * i) * c.ldsrc + n);
    if (c.gk) {
#pragma unroll
        for (int i = 0; i < 16; ++i) r[i] *= ldg<float>(c.gk + kq + 8 * i); }
}
__device__ __forceinline__ void cvt_store(const Frame& F, const CvtTile& c, const float (&r)[16]) {
    bf16_t* sT = (bf16_t*)F.lds;
    const int n = F.tid & 63, kq = F.tid >> 6;
#pragma unroll
    for (int i = 0; i < 16; ++i) sT[n * 130 + kq + 8 * i] = (bf16_t)(cvtpk(r[i], 0.f) & 0xffffu);
    __syncthreads();
    if (c.dst8) {
        const int nn = F.tid >> 3, k16 = (F.tid & 7) * 16; const bf16_t* s = sT + nn * 130 + k16; u32x4 w;
#pragma unroll
        for (int q = 0; q < 4; ++q) { const unsigned a = *(const unsigned*)(s + 4 * q), b = *(const unsigned*)(s + 4 * q + 2); int o = 0;
            o = __builtin_amdgcn_cvt_pk_fp8_f32(bflo(a) * WO8_SCALE, bfhi(a) * WO8_SCALE, o, false); o = __builtin_amdgcn_cvt_pk_fp8_f32(bflo(b) * WO8_SCALE, bfhi(b) * WO8_SCALE, o, true); w[q] = (unsigned)o; }
        stg<u32x4>(c.dst8 + (size_t)nn * c.lddst + k16, w);
    } else {
    const int kc = (F.tid & 15) * 8;
#pragma unroll
    for (int j = 0; j < 2; ++j) { const int nn = (F.tid >> 4) + 32 * j; const bf16_t* s = sT + nn * 130 + kc;
        u32x4 w; w.x = *(const unsigned*)(s); w.y = *(const unsigned*)(s + 2); w.z = *(const unsigned*)(s + 4); w.w = *(const unsigned*)(s + 6);
        stg<u32x4>(c.dst + (size_t)nn * c.lddst + kc, w); }
    }
    __syncthreads();
}
__device__ __forceinline__ void cvt_row_fp6(const f32x4 (&v)[8], unsigned char* dst, float* rsc, int lane) {
    float am = 0.f;
#pragma unroll
    for (int i = 0; i < 8; ++i) am = fmaxf(am, fmaxf(fmaxf(fabsf(v[i][0]), fabsf(v[i][1])), fmaxf(fabsf(v[i][2]), fabsf(v[i][3]))));
    am = fmaxf(am, shx<1>(am)); am = fmaxf(am, shx<2>(am)); am = fmaxf(am, shx<4>(am)); am = fmaxf(am, shx<8>(am)); am = fmaxf(am, shx<16>(am));
    am = fmaxf(am, shx32(am, lane >= 32));
    am = fmaxf(am, 1e-30f);
#if XFMT == 4
    const float sc4 = 6.0f / am;
    u32x4 p4;
#define E4(d, b) w = __builtin_amdgcn_cvt_scalef32_pk_fp4_f32(w, v[(8 * (d) + 2 * (b)) >> 2][(8 * (d) + 2 * (b)) & 3] * sc4, v[(8 * (d) + 2 * (b) + 1) >> 2][(8 * (d) + 2 * (b) + 1) & 3] * sc4, 1.0f, b)
#define E4D(d) { unsigned w = 0u; E4(d, 0); E4(d, 1); E4(d, 2); E4(d, 3); p4[d] = w; }
    E4D(0) E4D(1) E4D(2) E4D(3)
#undef E4
#undef E4D
    stg_nt<u32x4>(dst + lane * 16, p4);
    if (lane == 0) stg<float>(rsc, am * (1.f / 6.0f));
    return;
#endif
    const float sc = 7.0f / am;
    f32x16 a, b;
#pragma unroll
    for (int i = 0; i < 16; ++i) { a[i] = v[(2 * i) >> 2][(2 * i) & 3] * sc; b[i] = v[(2 * i + 1) >> 2][(2 * i + 1) & 3] * sc; }
    const u32x6 p = __builtin_amdgcn_cvt_scalef32_2xpk16_fp6_f32(a, b, 1.0f);
    stg<u32x2>(dst + lane * 24, (u32x2){p[0], p[1]}); stg<u32x2>(dst + lane * 24 + 8, (u32x2){p[2], p[3]}); stg<u32x2>(dst + lane * 24 + 16, (u32x2){p[4], p[5]});
    if (lane == 0) stg<float>(rsc, am * (1.f / 7.0f));
}
__device__ __forceinline__ void phase_convert(const Frame& F) {
    { const int total = DEPTH * CVT_TILES; int t = F.bid; float ra[16], rb[16];
      if (t < total) { const CvtTile c = cvt_decode(F, t); cvt_load(F, c, ra); }
      while (t < total) {
          int t2 = t + F.G; if (t2 < total) { const CvtTile c = cvt_decode(F, t2); cvt_load(F, c, rb); }
          { const CvtTile c = cvt_decode(F, t); cvt_store(F, c, ra); }
          t = t2; if (t >= total) break;
          t2 = t + F.G; if (t2 < total) { const CvtTile c = cvt_decode(F, t2); cvt_load(F, c, ra); }
          { const CvtTile c = cvt_decode(F, t); cvt_store(F, c, rb); }
          t = t2; } }
    { constexpr int NSTRIP = 12288 / 32, SP = 2056, NS = DEPTH * NSTRIP;
      bf16_t* sT = (bf16_t*)F.lds; float* sMax = (float*)(F.lds + 32 * SP * 2); float* sG = sMax + 512;
      const int n = F.tid & 31, kq = F.tid >> 5;
      for (int i = F.tid; i < DEPTH * DM; i += 512) sG[i] = ldg<float>(arg_in(F, I_NORM1) + i);
      __syncthreads();
      float ra[16], rb[16]; float am = 0.f; int sidx = F.bid, b = 0;
      const bool xm_ = (F.G & 7) == 0 && NS % F.G == 0;
#define SMAP(v_) (xm_ ? (((v_) % F.G) & 7) * (NS / 8) + ((v_) / F.G) * (F.G >> 3) + (((v_) % F.G) >> 3) : (v_))
#define WQ_LOAD(R, sx, bx) do { const int l_ = (sx) / NSTRIP, n0_ = ((sx) % NSTRIP) * 32; const float* W_ = arg_in(F, I_WIN) + (size_t)l_ * DM * INCOLS + (size_t)((bx) * 256 + kq) * INCOLS + n0_ + (n0_ >= 6144 ? 5 : 0) + n; \
          _Pragma("unroll") for (int i = 0; i < 16; ++i) R[i] = ldg_nt<float>(W_ + (size_t)(16 * i) * INCOLS); } while (0)
#define WQ_PROC(R, sx, bx) do { const int l_ = (sx) / NSTRIP, n0_ = ((sx) % NSTRIP) * 32, kb_ = (bx) * 256 + kq; \
          _Pragma("unroll") for (int i = 0; i < 16; ++i) { const float v_ = R[i] * sG[l_ * DM + kb_ + 16 * i]; am = fmaxf(am, fabsf(v_)); sT[n * SP + kb_ + 16 * i] = (bf16_t)(cvtpk(v_, 0.f) & 0xffffu); } \
          if ((bx) == 7) { sMax[kq * 32 + n] = am; am = 0.f; __syncthreads(); \
              unsigned char* W8_ = F.ws + WS_W0 + (size_t)l_ * WL_SIZE + WO_WIN8; float* WSC_ = (float*)(F.ws + WS_W0 + (size_t)l_ * WL_SIZE + WO_WSC); \
              _Pragma("unroll 2") for (int j = 0; j < 8; ++j) { const int row = (F.tid >> 7) + 4 * j, kc = (F.tid & 127) * 16; float m_ = 1e-30f; \
                  _Pragma("unroll") for (int q = 0; q < 16; ++q) m_ = fmaxf(m_, sMax[q * 32 + row]); \
                  const float inv_ = 127.0f / m_; const u32x4 w0 = *(const u32x4*)(sT + row * SP + kc), w1 = *(const u32x4*)(sT + row * SP + kc + 8); u32x4 o; \
                  o[0] = q8x4(bflo(w0[0]), bfhi(w0[0]), bflo(w0[1]), bfhi(w0[1]), inv_); o[1] = q8x4(bflo(w0[2]), bfhi(w0[2]), bflo(w0[3]), bfhi(w0[3]), inv_); \
                  o[2] = q8x4(bflo(w1[0]), bfhi(w1[0]), bflo(w1[1]), bfhi(w1[1]), inv_); o[3] = q8x4(bflo(w1[2]), bfhi(w1[2]), bflo(w1[3]), bfhi(w1[3]), inv_); \
                  stg<u32x4>(W8_ + (size_t)(n0_ + row) * 2048 + kc, o); if ((F.tid & 127) == 0) stg<float>(WSC_ + n0_ + row, m_ * (1.0f / 127.0f)); } \
              __syncthreads(); } } while (0)
      if (sidx < NS) WQ_LOAD(ra, SMAP(sidx), 0);
      while (sidx < NS) {
          int s2 = sidx, b2 = b + 1; if (b2 == 8) { b2 = 0; s2 = sidx + F.G; }
          if (s2 < NS) WQ_LOAD(rb, SMAP(s2), b2);
          WQ_PROC(ra, SMAP(sidx), b);
          sidx = s2; b = b2; if (sidx >= NS) break;
          s2 = sidx; b2 = b + 1; if (b2 == 8) { b2 = 0; s2 = sidx + F.G; }
          if (s2 < NS) WQ_LOAD(ra, SMAP(s2), b2);
          WQ_PROC(rb, SMAP(sidx), b);
          sidx = s2; b = b2; }
#undef SMAP
#undef WQ_LOAD
#undef WQ_PROC
    }
    const size_t gt = (size_t)F.bid * 512 + F.tid, GT = (size_t)F.G * 512;
#pragma unroll 1
    for (int l = 0; l < DEPTH; ++l) {
        unsigned char* ws = F.ws + WS_W0 + (size_t)l * WL_SIZE;
        const float* w_in = arg_in(F, I_WIN) + (size_t)l * DM * INCOLS;
        for (size_t i = gt; i < (size_t)2 * 2048 * 16; i += GT) { const int which = (int)(i / (2048 * 16)), r = (int)((i / 16) % 2048), c = (int)(i % 16);
            bf16_t* p = (bf16_t*)(ws + WO_WBR_T) + (size_t)(1 + which) * 2048 * 768 + (size_t)r * 768 + 640 + c * 8;
            stg<u32x4>(p, zero4()); }
        for (size_t i = gt; i < (size_t)5 * 2048; i += GT) { const int c = (int)(i / 2048), k = (int)(i % 2048); stg<float>((float*)(ws + WO_WF) + i, ldg<float>(w_in + (size_t)k * INCOLS + 6144 + c) * ldg<float>(arg_in(F, I_NORM1) + l * DM + k)); }
        { const float* s = arg_in(F, I_PSK) + (size_t)l * 262144; bf16_t* d = (bf16_t*)(ws + WO_SK);
          for (size_t i = gt; i < (size_t)262144 / 8; i += GT) { const f32x4 a = ldg<f32x4>(s + i * 8), b = ldg<f32x4>(s + i * 8 + 4); stg<bf16x8>(d + i * 8, pack8(a, b)); } }
    }
#ifdef TAB1
    for (int R = F.gw; R < DEPTH * 2 * 16384; R += F.GW) {
        const int R2 = R; const bool two = false;
#else
    for (int R = F.gw; R < DEPTH * 2 * 16384; R += 2 * F.GW) {
        const int R2 = R + F.GW; const bool two = R2 < DEPTH * 2 * 16384;
#endif
        const int q1 = R >> 14, r1 = R & 16383, q2 = two ? (R2 >> 14) : q1, r2 = two ? (R2 & 16383) : r1;
        const float* s1 = ((q1 & 1) ? arg_in(F, I_PV) : arg_in(F, I_PU)) + ((size_t)(q1 >> 1) * 16384 + r1) * 2048;
        const float* s2 = ((q2 & 1) ? arg_in(F, I_PV) : arg_in(F, I_PU)) + ((size_t)(q2 >> 1) * 16384 + r2) * 2048;
        f32x4 va[8], vb[8];
#pragma unroll
        for (int i = 0; i < 8; ++i) va[i] = ldg_nt<f32x4>(s1 + i * 256 + F.lane * 4);
#ifndef TAB1
#pragma unroll
        for (int i = 0; i < 8; ++i) vb[i] = ldg_nt<f32x4>(s2 + i * 256 + F.lane * 4);
#endif
        if (!(q1 & 1)) { const float* g2 = arg_in(F, I_NORM2) + (q1 >> 1) * DM;
#pragma unroll
            for (int i = 0; i < 8; ++i) va[i] = va[i] * ldg<f32x4>(g2 + i * 256 + F.lane * 4); }
        if (two && !(q2 & 1)) { const float* g2 = arg_in(F, I_NORM2) + (q2 >> 1) * DM;
#pragma unroll
            for (int i = 0; i < 8; ++i) vb[i] = vb[i] * ldg<f32x4>(g2 + i * 256 + F.lane * 4); }
        { unsigned char* wl = F.ws + WS_W0 + (size_t)(q1 >> 1) * WL_SIZE; cvt_row_fp6(va, wl + ((q1 & 1) ? WO_V : WO_U) + (size_t)r1 * XROW, (float*)(wl + ((q1 & 1) ? WO_VSC : WO_USC)) + r1, F.lane); }
        if (two) { unsigned char* wl = F.ws + WS_W0 + (size_t)(q2 >> 1) * WL_SIZE; cvt_row_fp6(vb, wl + ((q2 & 1) ? WO_V : WO_U) + (size_t)r2 * XROW, (float*)(wl + ((q2 & 1) ? WO_VSC : WO_USC)) + r2, F.lane); }
    }
}

__device__ __forceinline__ void phase_norm(const Frame& F, const float* x, const float* bforget, const float* w_in, const float* g1) {
    unsigned char* H8 = F.ws + WS_H8; float* LOGF = (float*)(F.ws + WS_LOGF);
    const float* wfl = (const float*)F.lds;
    { float wv_[4][5], gv_[4];
#pragma unroll
      for (int j = 0; j < 4; ++j) { const int k = F.tid + 512 * j; gv_[j] = ldg<float>(g1 + k);
#pragma unroll
          for (int c = 0; c < 5; ++c) wv_[j][c] = ldg<float>(w_in + (size_t)k * INCOLS + 6144 + c); }
#pragma unroll
      for (int j = 0; j < 4; ++j)
#pragma unroll
          for (int c = 0; c < 5; ++c) ((float*)F.lds)[c * 2048 + F.tid + 512 * j] = wv_[j][c] * gv_[j]; }
    __syncthreads();
    for (int t = F.gw; t < T_TOK; t += F.GW) {
        const float* xr = x + (size_t)t * DM; f32x4 v[8]; float ss = 0.f;
#pragma unroll
        for (int i = 0; i < 8; ++i) { v[i] = ldg_nt<f32x4>(xr + i * 256 + F.lane * 4); ss += v[i][0] * v[i][0] + v[i][1] * v[i][1] + v[i][2] * v[i][2] + v[i][3] * v[i][3]; }
        ss = wave_sum(ss); const float rstd = rsqrtf(ss * (1.f / DM) + NORM_EPS);
        float am = 1e-30f;
#pragma unroll
        for (int i = 0; i < 8; ++i) am = fmaxf(am, fmaxf(fmaxf(fabsf(v[i][0]), fabsf(v[i][1])), fmaxf(fabsf(v[i][2]), fabsf(v[i][3]))));
        am = wave_max(am); const float inv = 127.0f / am;
#pragma unroll
        for (int i = 0; i < 8; ++i) stg<unsigned>(H8 + (size_t)t * DM + i * 256 + F.lane * 4, q8x4(v[i][0], v[i][1], v[i][2], v[i][3], inv));
        if (F.lane == 0) { stg<float>(LOGF + t * 8 + 5, rstd * am * (1.0f / 127.0f)); stg<float>(LOGF + t * 8 + 6, am * (1.0f / 127.0f)); }
#pragma unroll
        for (int c = 0; c < 5; ++c) { float d = 0.f;
#pragma unroll
            for (int i = 0; i < 8; ++i) { const f32x4 wv = *(const f32x4*)(wfl + c * 2048 + i * 256 + F.lane * 4); d += v[i][0] * wv[0] + v[i][1] * wv[1] + v[i][2] * wv[2] + v[i][3] * wv[3]; }
            d = wave_sum(d) * rstd;
            if (F.lane == 0) { const float z = d + ldg<float>(bforget + c); stg<float>(LOGF + t * 8 + c, fminf(z, 0.f) - log1pf(__expf(-fabsf(z)))); } }
    }
}

struct PrepP { const float* aqn; const float* akn; const float* bqn; const float* bkn; const float* cqn; const float* ckn; };
__device__ __forceinline__ void unpack8(const u32x4 w, float* x) { x[0] = bflo(w[0]); x[1] = bfhi(w[0]); x[2] = bflo(w[1]); x[3] = bfhi(w[1]); x[4] = bflo(w[2]); x[5] = bfhi(w[2]); x[6] = bflo(w[3]); x[7] = bfhi(w[3]); }
__device__ __forceinline__ u32x4 pack8u(const float* x) { return (u32x4){cvtpk(x[0], x[1]), cvtpk(x[2], x[3]), cvtpk(x[4], x[5]), cvtpk(x[6], x[7])}; }
template <int NDIM, bool ROPE>
__device__ __forceinline__ u32x4 qk_unit(const u32x4 raw, const float* gain, int li, int s, const LAS double* invrev, float qs) {
    float x[8]; unpack8(raw, x);
    float ss = 0.f;
#pragma unroll
    for (int e = 0; e < 8; ++e) ss += x[e] * x[e];
    ss += shx<1>(ss); ss += shx<2>(ss); ss += shx<4>(ss); if (NDIM == 128) ss += shx<8>(ss);
    const float rstd = rsqrtf(ss * (1.f / NDIM) + NORM_EPS);
    const int lu = NDIM == 128 ? li : (li & 7);
    const f32x4 g0 = ldg<f32x4>(gain + lu * 8), g1 = ldg<f32x4>(gain + lu * 8 + 4);
    x[0] *= rstd * g0[0]; x[1] *= rstd * g0[1]; x[2] *= rstd * g0[2]; x[3] *= rstd * g0[3]; x[4] *= rstd * g1[0]; x[5] *= rstd * g1[1]; x[6] *= rstd * g1[2]; x[7] *= rstd * g1[3];
    if (ROPE) {
        constexpr int PX = NDIM == 128 ? 2 : 1;
        const bool inrope = lu < 2 * PX, first = lu < PX;
#pragma unroll
        for (int e = 0; e < 8; ++e) {
            const float p = shx<PX>(x[e]);
            const double ir = NDIM == 128 ? ((lu & 1) ? invrev[8 + e] : invrev[e]) : invrev[2 * e];
            const double rev = (double)s * ir; const float fr = (float)(rev - floor(rev));
            const float c = __builtin_amdgcn_cosf(fr), sn = __builtin_amdgcn_sinf(fr);
            const float r = first ? (x[e] * c - p * sn) : (x[e] * c + p * sn);
            x[e] = inrope ? r : x[e];
        }
    }
#pragma unroll
    for (int e = 0; e < 8; ++e) x[e] *= qs;
    return pack8u(x);
}
__device__ __forceinline__ void phase_prep(const Frame& F, int l) {
    const LAS double* invrev = arg_invrev(F);
    unsigned char* ws = F.ws;
    const bf16_t* PROJ = (const bf16_t*)(ws + WS_PROJ);
    const float* aqn = arg_in(F, I_AQN) + l * 64; const float* akn = arg_in(F, I_AKN) + l * 64;
    const float* bqn = arg_in(F, I_BQN) + l * 128; const float* bkn = arg_in(F, I_BKN) + l * 128; const float* cqn = arg_in(F, I_CQN) + l * 128; const float* ckn = arg_in(F, I_CKN) + l * 128;
    const float QS64 = 0.125f * LOG2E, QS128 = 0.08838834764831845f * LOG2E;
    const int gq = F.lane >> 4, li = F.lane & 15;
    const bool wgred = F.GW * 4 == T_TOK;
    for (int t0 = F.gw * 4; t0 < T_TOK; t0 += F.GW * 4) {
        const int t = t0 + gq, b = t >> 12, s = t & 4095;
        const bf16_t* row = PROJ + (size_t)t * PQ + li * 8;
        u32x4 rawall[48];
#pragma unroll
        for (int u = 0; u < 48; ++u) { const bool isv = (u >= 12 && u < 18) || (u >= 28 && u < 33) || u >= 43;
            if (!isv) rawall[u] = ldg_nt<u32x4>(row + u * 128); }
#pragma unroll
        for (int batch = 0; batch < 4; ++batch) {
            u32x4* raw = rawall + batch * 12;
#pragma unroll
            for (int j = 0; j < 12; ++j) {
                const int u = batch * 12 + j;
                if (u < 6) {
                    const u32x4 o = qk_unit<64, true>(raw[j], aqn, li, s, invrev, QS64);
                    bf16_t* d = (bf16_t*)(ws + WS_QA) + ((size_t)(b * 12 + u * 2 + (li >> 3)) * 4096 + s) * 64 + (li & 7) * 8;
                    stg<u32x4>(d, o);
                } else if (u < 12) {
                    const u32x4 o = qk_unit<64, true>(raw[j], akn, li, s, invrev, 1.f);
                    bf16_t* d = (bf16_t*)(ws + WS_KA) + ((size_t)(b * 12 + (u - 6) * 2 + (li >> 3)) * 4096 + s) * 64 + (li & 7) * 8;
                    stg<u32x4>(d, o);
                } else if (u < 18) {
                } else if (u < 23) {
                    stg<u32x4>((bf16_t*)(ws + WS_QB) + ((size_t)(b * 5 + (u - 18)) * 4096 + s) * 128 + li * 8, qk_unit<128, true>(raw[j], bqn, li, s, invrev, QS128));
                } else if (u < 28) {
                    const u32x4 o = qk_unit<128, true>(raw[j], bkn, li, s, invrev, 1.f);
                    stg<u32x4>((bf16_t*)(ws + WS_KB) + ((size_t)(b * 5 + (u - 23)) * 4096 + s) * 128 + li * 8, o);
                    { float kv[8]; unpack8(o, kv); int* ksum = (int*)(ws + WS_KSUM) + ((size_t)(b * 5 + (u - 23)) * 16 + (s >> 8)) * 128 + li * 8;
                      float* skw = (float*)(F.lds + 8192) + (F.wave * 5 + (u - 23)) * 128 + li * 8;
#pragma unroll
                      for (int e = 0; e < 8; ++e) { float v = kv[e]; v += shx<16>(v); v = sum32(v);
                          if (F.lane < 16) { if (wgred) skw[e] = v; else atomicAdd(ksum + e, (int)rintf(v * 262144.f)); } } }
                } else if (u < 33) {
                } else if (u < 38) {
                    stg<u32x4>((bf16_t*)(ws + WS_QC) + ((size_t)(b * 5 + (u - 33)) * 4096 + s) * 128 + li * 8, qk_unit<128, false>(raw[j], cqn, li, s, invrev, QS128));
                } else if (u < 43) {
                    stg<u32x4>((bf16_t*)(ws + WS_KC) + ((size_t)(b * 5 + (u - 38)) * 4096 + s) * 128 + li * 8, qk_unit<128, false>(raw[j], ckn, li, s, invrev, 1.f));
                } else {
                }
            }
        }
    }
    if (wgred) {
        __syncthreads();
        const int tw = F.bid * 32, bb = tw >> 12, blk = (tw & 4095) >> 8; const float* sk = (const float*)(F.lds + 8192);
        for (int i = F.tid; i < 5 * 128; i += 512) { float v = 0.f;
#pragma unroll
            for (int w = 0; w < 8; ++w) v += sk[w * 640 + i];
            atomicAdd((int*)(ws + WS_KSUM) + ((size_t)(bb * 5 + i / 128) * 16 + blk) * 128 + (i & 127), (int)rintf(v * 262144.f)); }
        __syncthreads();
    }
    for (int i = F.bid * 512 + F.tid; i < T_TOK; i += F.G * 512) stg<unsigned long long>((unsigned long long*)(ws + WS_ROWSS) + i, 0ull);
    if (F.bid < 10) {
        const int b = F.bid / 5, h = F.bid % 5; const float* LOGF = (const float*)(ws + WS_LOGF); float* CB = (float*)(ws + WS_CB) + (size_t)F.bid * 4096;
        double* sd = (double*)F.lds;
        double loc[8]; double run = 0.0;
#pragma unroll
        for (int i = 0; i < 8; ++i) { run += (double)ldg<float>(LOGF + (size_t)(b * 4096 + F.tid * 8 + i) * 8 + h); loc[i] = run; }
        sd[F.tid] = run; __syncthreads();
        if (F.tid < 64) { double acc = 0.0;
#pragma unroll
            for (int i = 0; i < 8; ++i) { const double v = sd[F.tid * 8 + i]; sd[F.tid * 8 + i] = acc; acc += v; }
            sd[512 + F.tid] = acc; }
        __syncthreads();
        if (F.tid == 0) { double acc = 0.0; for (int i = 0; i < 64; ++i) { const double v = sd[512 + i]; sd[512 + i] = acc; acc += v; } }
        __syncthreads();
        const double base = sd[F.tid] + sd[512 + (F.tid >> 3)];
#pragma unroll
        for (int i = 0; i < 8; ++i) stg<float>(CB + F.tid * 8 + i, (float)(base + loc[i]));
        __syncthreads();
    }
}

constexpr int ATT_ITEMS = 44 * 16;
__device__ __forceinline__ float att_thresh(const float* gq, const float* gk, int lane) {
    float a = fmaxf(fabsf(ldg<float>(gq + lane)), fabsf(ldg<float>(gq + 64 + lane))), b = fmaxf(fabsf(ldg<float>(gk + lane)), fabsf(ldg<float>(gk + 64 + lane)));
    a = fmaxf(a, shx<1>(a)); a = fmaxf(a, shx<2>(a)); a = fmaxf(a, shx<4>(a)); a = fmaxf(a, shx<8>(a)); a = fmaxf(a, shx<16>(a)); a = fmaxf(a, shx32(a, lane >= 32));
    b = fmaxf(b, shx<1>(b)); b = fmaxf(b, shx<2>(b)); b = fmaxf(b, shx<4>(b)); b = fmaxf(b, shx<8>(b)); b = fmaxf(b, shx<16>(b)); b = fmaxf(b, shx32(b, lane >= 32));
    return __int_as_float(__builtin_amdgcn_readfirstlane(__float_as_int(2.f * (16.65f * a * b) + 40.f)));
}
__device__ __forceinline__ int att_jlo(const float* cb, int P0, float thresh, int) {
    int lane = threadIdx.x; asm volatile("" : "+v"(lane)); lane &= 63;
    const int nt0 = P0 / 64;
    bool need = true;
    if (lane < nt0) need = (ldg<float>(cb + P0) - ldg<float>(cb + lane * 64 + 63)) * LOG2E >= -thresh;
    const unsigned long long m = __ballot(need);
    return __builtin_amdgcn_readfirstlane((int)__builtin_ctzll(m));
}
__device__ __forceinline__ att::BlockRef att_item(unsigned char* ws, unsigned char* lds, int idx, int lane) {
    asm volatile("" : "+s"(ws));
    int qb, c; if (idx < 34 * 16) { qb = 15 - idx / 34; c = idx % 34; } else { const int j = idx - 34 * 16; qb = 15 - j / 10; c = 34 + j % 10; }
    att::BlockRef r; r.P0 = qb * 256; r.cb = nullptr; r.jlo = 0;
    r.kp = 128;
    if (c < 24) { const int b = c / 12, hs = c % 12; const size_t ho = ((size_t)(b * 12 + hs) * 4096) * 64; r.kp = 64;
        r.Q = (const bf16_t*)(ws + WS_QA) + ho + (size_t)r.P0 * 64; r.K = (const bf16_t*)(ws + WS_KA) + ho; r.V = (const bf16_t*)(ws + WS_VA) + ((size_t)(b * 6 + hs / 2) * 4096) * 128;
        r.O = (bf16_t*)(ws + WS_OA) + (size_t)(hs & 1) * T_TOK * 768 + ((size_t)b * 4096 + r.P0) * 768 + (hs / 2) * 128; r.ldo = 768; r.mode = 0;
    } else if (c < 34) { const int b = (c - 24) / 5, h = (c - 24) % 5; const size_t ho = ((size_t)(b * 5 + h) * 4096) * 128;
        r.Q = (const bf16_t*)(ws + WS_QB) + ho + (size_t)r.P0 * 128; r.K = (const bf16_t*)(ws + WS_KB) + ho; r.V = (const bf16_t*)(ws + WS_VB) + ho;
        r.O = (bf16_t*)(ws + WS_YCAT) + ((size_t)b * 4096 + r.P0) * 2048 + 768 + h * 128; r.ldo = 2048; r.mode = 1; r.cb = (const float*)(ws + WS_KSUM) + (size_t)(b * 5 + h) * 16 * 128;
    } else { const int b = (c - 34) / 5, h = (c - 34) % 5; const size_t ho = ((size_t)(b * 5 + h) * 4096) * 128;
        r.Q = (const bf16_t*)(ws + WS_QC) + ho + (size_t)r.P0 * 128; r.K = (const bf16_t*)(ws + WS_KC) + ho; r.V = (const bf16_t*)(ws + WS_VC) + ho;
        r.O = (bf16_t*)(ws + WS_YCAT) + ((size_t)b * 4096 + r.P0) * 2048 + 1408 + h * 128; r.ldo = 2048; r.mode = 2; r.cb = (const float*)(ws + WS_CB) + (size_t)(b * 5 + h) * 4096; r.jlo = att_jlo(r.cb, r.P0, *(volatile float*)(lds + att::OFF_MISC + 16), lane);
    }
    return r;
}
__device__ __forceinline__ int queue_fetch(const Frame& F, unsigned* ctr) {
    volatile int* slot = (volatile int*)(F.lds + att::OFF_MISC);
    int tid = threadIdx.x; asm volatile("" : "+v"(tid));
    if (tid == 0) *slot = (int)atomicAdd(ctr, 1u);
    __syncthreads();
    const int v = __builtin_amdgcn_readfirstlane(*slot);
    __syncthreads();
    return v;
}
__device__ __forceinline__ void phase_attention(const Frame& F, int slot, const float* gq, const float* gk) {
    unsigned* ctr = (unsigned*)(F.ws + WS_CTL) + 16 + slot;
    { const float th_ = att_thresh(gq, gk, F.lane); if (F.tid == 0) *(volatile float*)(F.lds + att::OFF_MISC + 16) = th_; }
    __syncthreads();
    int ci, ni = 0;
    if (F.G <= ATT_ITEMS) ci = F.bid; else { ci = queue_fetch(F, ctr); if (ci >= ATT_ITEMS) return; }
    const int qbase = (F.G <= ATT_ITEMS) ? F.G : 0;
    att::Seam S;
    { const att::BlockRef cur = att_item(F.ws, F.lds, ci, F.lane); att::attn_prime(cur, (char*)F.lds, S); }
    for (;;) {
        const att::BlockRef cur = att_item(F.ws, F.lds, ci, F.lane);
        att::attn_block(cur, [&]() { ni = qbase + queue_fetch(F, ctr); return att_item(F.ws, F.lds, ni < ATT_ITEMS ? ni : ci, 0); }, (char*)F.lds, S);
        if (ni >= ATT_ITEMS) break;
        ci = ni;
    }
}

__device__ __forceinline__ void phase_postA(const Frame& F, int l) {
    const float lam_init = l == 0 ? 0.2f : 0.35550906759931f;
    const float* lq1 = arg_in(F, I_LQ1) + l * 64; const float* lk1 = arg_in(F, I_LK1) + l * 64; const float* lq2 = arg_in(F, I_LQ2) + l * 64; const float* lk2 = arg_in(F, I_LK2) + l * 64;
    const float d1 = wave_sum(ldg<float>(lq1 + F.lane) * ldg<float>(lk1 + F.lane)), d2 = wave_sum(ldg<float>(lq2 + F.lane) * ldg<float>(lk2 + F.lane));
    const float lam = __expf(d1) - __expf(d2) + lam_init;
    const float* gon = arg_in(F, I_AON) + l * 128;
    const bf16_t* O1 = (const bf16_t*)(F.ws + WS_OA); const bf16_t* O2 = O1 + (size_t)T_TOK * 768; bf16_t* Y = (bf16_t*)(F.ws + WS_YCAT);
    const int li = F.lane & 15, gq = F.lane >> 4;
    const f32x4 g0 = ldg<f32x4>(gon + li * 8), g1 = ldg<f32x4>(gon + li * 8 + 4);
    for (int ub = F.gw * 4; ub < T_TOK * 6; ub += F.GW * 4 * 6) {
      u32x4 ra[6], rc[6];
#pragma unroll
      for (int q = 0; q < 6; ++q) { const int u0 = ub + q * F.GW * 4; if (u0 < T_TOK * 6) { const int u = u0 + gq, t = u / 6, h = u % 6;
          ra[q] = ldg_nt<u32x4>(O1 + (size_t)t * 768 + h * 128 + li * 8); rc[q] = ldg_nt<u32x4>(O2 + (size_t)t * 768 + h * 128 + li * 8); } }
#pragma unroll
      for (int q = 0; q < 6; ++q) { const int u0 = ub + q * F.GW * 4; if (u0 >= T_TOK * 6) break;
        const int u = u0 + gq, t = u / 6, h = u % 6;
        float a[8], c[8]; unpack8(ra[q], a); unpack8(rc[q], c);
        float ss = 0.f;
#pragma unroll
        for (int e = 0; e < 8; ++e) { a[e] = a[e] - lam * c[e]; ss += a[e] * a[e]; }
        ss += shx<1>(ss); ss += shx<2>(ss); ss += shx<4>(ss); ss += shx<8>(ss);
        const float sc = rsqrtf(ss * (1.f / 128) + NORM_EPS) * (1.f - lam_init);
        a[0] *= sc * g0[0]; a[1] *= sc * g0[1]; a[2] *= sc * g0[2]; a[3] *= sc * g0[3]; a[4] *= sc * g1[0]; a[5] *= sc * g1[1]; a[6] *= sc * g1[2]; a[7] *= sc * g1[3];
        stg<u32x4>(Y + (size_t)t * 2048 + h * 128 + li * 8, pack8u(a));
      }
    }
}

__device__ __forceinline__ int f2sort(float f) { const int b = __float_as_int(f); return b ^ ((b >> 31) & 0x7fffffff); }
__device__ __forceinline__ float sort2f(int s) { return __int_as_float(s ^ ((s >> 31) & 0x7fffffff)); }
__device__ __forceinline__ void ce_desc(int& a, int& b) { const int hi = max(a, b), lo = min(a, b); a = hi; b = lo; }
template <int N> __device__ __forceinline__ void bitonic_sort_desc(int* a) {
#pragma unroll
    for (int k = 2; k <= N; k <<= 1)
#pragma unroll
        for (int j = k >> 1; j > 0; j >>= 1)
#pragma unroll
            for (int i = 0; i < N; ++i) { const int l = i ^ j; if (l > i) { if ((i & k) == 0) ce_desc(a[i], a[l]); else ce_desc(a[l], a[i]); } }
}
template <int N> __device__ __forceinline__ void bitonic_merge_desc(int* c) {
#pragma unroll
    for (int j = N >> 1; j > 0; j >>= 1)
#pragma unroll
        for (int i = 0; i < N; ++i) { const int l = i ^ j; if (l > i) ce_desc(c[i], c[l]); }
}
__device__ __forceinline__ void top16_merge(int* a, const int* b) {
#pragma unroll
    for (int i = 0; i < 16; ++i) a[i] = max(a[i], b[15 - i]);
    bitonic_merge_desc<16>(a);
}
__device__ __forceinline__ void top16_of_64(int* key) {
    bitonic_sort_desc<16>(key); bitonic_sort_desc<16>(key + 16); bitonic_sort_desc<16>(key + 32); bitonic_sort_desc<16>(key + 48);
    top16_merge(key, key + 16); top16_merge(key + 32, key + 48); top16_merge(key, key + 32);
}
__device__ __forceinline__ void phase_topk(const Frame& F, const unsigned char* wl) {
    const bf16_t* QP = (const bf16_t*)(F.ws + WS_QP); const bf16_t* SK = (const bf16_t*)(wl + WO_SK);
    int* PIDX = (int*)(F.ws + WS_PIDX); float* PGATE = (float*)(F.ws + WS_PGATE);
    const int r32 = F.lane & 31, hi = F.lane >> 5;
    const int IMIN = (int)0x80000000;
    pg8::TileOrder ord; ord.init(T_TOK, 2048, F.G, F.bid);
    for (int it = 0;; ++it) {
        int tt, h; if (!ord.tile(it, tt, h)) break;
        const int t = tt * 256 + F.wave * 32 + r32;
        __syncthreads();
#pragma unroll
        for (int i = 0; i < 8; ++i) { const int cidx = F.tid + 512 * i;
            const int pp = cidx >> 11, n = (cidx >> 4) & 127, ch = cidx & 15;
            const u32x4 w = ldg<u32x4>(SK + ((size_t)((h * 2 + pp) * 128 + n)) * 128 + ch * 8);
            *(u32x4*)(F.lds + pp * 32768 + n * 256 + ((ch ^ (n & 15)) << 4)) = w; }
        __syncthreads();
        int kk[2][16];
#pragma unroll
        for (int p = 0; p < 2; ++p) {
            bf16x8 qf[8];
#pragma unroll
            for (int ks = 0; ks < 8; ++ks) qf[ks] = ldg<bf16x8>(QP + (size_t)(tt * 8 + h) * 65536 + (size_t)(((((F.wave * 2 + p) * 8 + ks) * 2 + hi) * 32 + r32) * 8));
            f32x16 acc[4];
#pragma unroll
            for (int nb = 0; nb < 4; ++nb) { acc[nb] = f32x16{};
#pragma unroll
                for (int ks = 0; ks < 8; ++ks) { const int n = nb * 32 + r32; const bf16x8 kf = *(const bf16x8*)(F.lds + p * 32768 + n * 256 + (((ks * 2 + hi) ^ (n & 15)) << 4));
                    acc[nb] = __builtin_amdgcn_mfma_f32_32x32x16_bf16(kf, qf[ks], acc[nb], 0, 0, 0); } }
            int key[64];
#pragma unroll
            for (int nb = 0; nb < 4; ++nb)
#pragma unroll
                for (int r = 0; r < 16; ++r) { const int n = nb * 32 + (r & 3) + 8 * (r >> 2) + 4 * hi; key[nb * 16 + r] = (f2sort(acc[nb][r]) & ~127) | n; }
            top16_of_64(key);
            { int other[16];
#pragma unroll
              for (int i = 0; i < 16; ++i) { auto rr = __builtin_amdgcn_permlane32_swap((unsigned)key[i], (unsigned)key[i], false, false); other[i] = hi ? (int)rr[0] : (int)rr[1]; }
              top16_merge(key, other); }
#pragma unroll
            for (int i = 0; i < 16; ++i) kk[p][i] = key[i];
        }
        float vA[16], vB[16];
#pragma unroll
        for (int i = 0; i < 16; ++i) { vA[i] = sort2f(kk[0][i] & ~127); vB[i] = sort2f(kk[1][i] & ~127); }
        int cand[64]; int cnt = 0;
#pragma unroll
        for (int i = 0; i < 16; ++i)
#pragma unroll
            for (int j = 0; j < 16; ++j) if ((i + 1) * (j + 1) <= 16) { cand[cnt] = (f2sort(vA[i] + vB[j]) & ~255) | (i * 16 + j); ++cnt; }
#pragma unroll
        for (int i = 50; i < 64; ++i) cand[i] = IMIN;
        top16_of_64(cand);
        int top[16];
#pragma unroll
        for (int i = 0; i < 16; ++i) top[i] = cand[i];
        int ex[16]; float ev[16]; float esum = 0.f;
        const float vmax = sort2f(top[0] & ~255);
#pragma unroll
        for (int k = 0; k < 16; ++k) {
            const int ij = top[k] & 255, i = ij >> 4, j = ij & 15;
            int na = 0, nbv = 0;
#pragma unroll
            for (int q = 0; q < 16; ++q) { na = (i == q) ? kk[0][q] : na; nbv = (j == q) ? kk[1][q] : nbv; }
            ex[k] = (na & 127) * 128 + (nbv & 127);
            ev[k] = __expf(sort2f(top[k] & ~255) - vmax); esum += ev[k];
        }
        const float inv = 1.f / esum;
        int oi[8]; float og[8];
#pragma unroll
        for (int k = 0; k < 8; ++k) { oi[k] = hi ? ex[8 + k] : ex[k]; og[k] = (hi ? ev[8 + k] : ev[k]) * inv; }
        int* pi = PIDX + (size_t)t * 128 + h * 16 + hi * 8; float* pg = PGATE + (size_t)t * 128 + h * 16 + hi * 8;
        stg<u32x4>(pi, (u32x4){(unsigned)oi[0], (unsigned)oi[1], (unsigned)oi[2], (unsigned)oi[3]}); stg<u32x4>(pi + 4, (u32x4){(unsigned)oi[4], (unsigned)oi[5], (unsigned)oi[6], (unsigned)oi[7]});
        stg<f32x4>(pg, (f32x4){og[0], og[1], og[2], og[3]}); stg<f32x4>(pg + 4, (f32x4){og[4], og[5], og[6], og[7]});
    }
}

__device__ __forceinline__ float dot8(const u32x4 a, const u32x4 b, float c) {
#pragma unroll
    for (int i = 0; i < 4; ++i) { c = fmaf(bflo(a[i]), bflo(b[i]), c); c = fmaf(bfhi(a[i]), bfhi(b[i]), c); }
    return c;
}
template <int M> __device__ __forceinline__ int xchg_i(int v, bool upper) {
    if constexpr (M < 32) return __builtin_amdgcn_ds_swizzle(v, (M << 10) | 0x1f);
    else { auto rr = __builtin_amdgcn_permlane32_swap((unsigned)v, (unsigned)v, false, false); return (int)(upper ? rr[0] : rr[1]); } }
template <int M> __device__ __forceinline__ float xchg_f(float v, bool upper) { return __int_as_float(xchg_i<M>(__float_as_int(v), upper)); }
__device__ __forceinline__ void phase_gather(const Frame& F, const float* xres, float* xout, const unsigned char* wl, const float* nxt_g1, const float* nxt_bf, const float* nxt_wf) {
    const bf16_t* H = (const bf16_t*)(F.ws + WS_HG); const unsigned long long* ROWSS = (const unsigned long long*)(F.ws + WS_ROWSS); const unsigned char* U = wl + WO_U; const unsigned char* V = wl + WO_V;
    const float* USC = (const float*)(wl + WO_USC); const float* VSC = (const float*)(wl + WO_VSC);
    const int* PIDX = (const int*)(F.ws + WS_PIDX); const float* PGATE = (const float*)(F.ws + WS_PGATE);
    const int lane = F.lane; const bool b5 = (lane >> 5) & 1, b4 = (lane >> 4) & 1;
    const float* wfl = (const float*)F.lds;
    if (nxt_bf) { for (int i = F.tid; i < 5 * 2048 / 4; i += 512) *(f32x4*)(F.lds + i * 16) = ldg<f32x4>(nxt_wf + i * 4); __syncthreads(); }
    u32x2 nxw[8]; int nid0, nid1; float ngg0, ngg1; unsigned long long nss;
#define GT_PREF(tt_) do { _Pragma("unroll") for (int i = 0; i < 8; ++i) nxw[i] = ldg_nt<u32x2>(H + (size_t)(tt_) * DM + i * 256 + lane * 4); \
        nid0 = ldg_nt<int>(PIDX + (size_t)(tt_) * 128 + lane); nid1 = ldg_nt<int>(PIDX + (size_t)(tt_) * 128 + 64 + lane); \
        ngg0 = ldg_nt<float>(PGATE + (size_t)(tt_) * 128 + lane); ngg1 = ldg_nt<float>(PGATE + (size_t)(tt_) * 128 + 64 + lane); nss = ldg<unsigned long long>(ROWSS + (tt_)); } while (0)
    if (F.gw < T_TOK) GT_PREF(F.gw);
    for (int t = F.gw; t < T_TOK; t += F.GW) {
        float x[32];
#pragma unroll
        for (int i = 0; i < 8; ++i) { const u32x2 w = nxw[i];
            x[i * 4 + 0] = bflo(w[0]); x[i * 4 + 1] = bfhi(w[0]); x[i * 4 + 2] = bflo(w[1]); x[i * 4 + 3] = bfhi(w[1]); }
        int id0 = nid0, id1 = nid1;
        float gg0 = ngg0, gg1 = ngg1;
        const float rs_t = rsqrtf((float)nss * (1.f / 16777216.f) * (1.f / DM) + NORM_EPS);
        { const int tn_ = t + F.GW < T_TOK ? t + F.GW : t; GT_PREF(tn_); }
        float y[32];
#pragma unroll
        for (int i = 0; i < 32; ++i) y[i] = 0.f;
        { int k0 = id0 * 128 + lane, k1 = id1 * 128 + 64 + lane; float g0 = gg0, g1 = gg1; const bool up32 = lane >= 32;
#define GS_CE(M, UP0, UP1) { const int q0 = xchg_i<M>(k0, up32), q1 = xchg_i<M>(k1, up32); const float h0 = xchg_f<M>(g0, up32), h1 = xchg_f<M>(g1, up32); const bool lo_ = (lane & M) == 0; \
            const bool t0 = (lo_ == (UP0)) ? (q0 < k0) : (q0 > k0), t1 = (lo_ == (UP1)) ? (q1 < k1) : (q1 > k1); \
            k0 = t0 ? q0 : k0; g0 = t0 ? h0 : g0; k1 = t1 ? q1 : k1; g1 = t1 ? h1 : g1; }
#define GS_UP(K) ((lane & (K)) == 0)
          GS_CE(1, GS_UP(2), GS_UP(2))
          GS_CE(2, GS_UP(4), GS_UP(4)) GS_CE(1, GS_UP(4), GS_UP(4))
          GS_CE(4, GS_UP(8), GS_UP(8)) GS_CE(2, GS_UP(8), GS_UP(8)) GS_CE(1, GS_UP(8), GS_UP(8))
          GS_CE(8, GS_UP(16), GS_UP(16)) GS_CE(4, GS_UP(16), GS_UP(16)) GS_CE(2, GS_UP(16), GS_UP(16)) GS_CE(1, GS_UP(16), GS_UP(16))
          GS_CE(16, GS_UP(32), GS_UP(32)) GS_CE(8, GS_UP(32), GS_UP(32)) GS_CE(4, GS_UP(32), GS_UP(32)) GS_CE(2, GS_UP(32), GS_UP(32)) GS_CE(1, GS_UP(32), GS_UP(32))
          GS_CE(32, true, false) GS_CE(16, true, false) GS_CE(8, true, false) GS_CE(4, true, false) GS_CE(2, true, false) GS_CE(1, true, false)
          { const bool sw = k0 > k1; const int tk = sw ? k1 : k0; k1 = sw ? k0 : k1; k0 = tk; const float tg = sw ? g1 : g0; g1 = sw ? g0 : g1; g0 = tg; }
          GS_CE(32, true, true) GS_CE(16, true, true) GS_CE(8, true, true) GS_CE(4, true, true) GS_CE(2, true, true) GS_CE(1, true, true)
#undef GS_CE
#undef GS_UP
          id0 = k0 >> 7; id1 = k1 >> 7; gg0 = g0; gg1 = g1; }
        for (int g = 0; g < 32; ++g) {
            const int src = (g & 15) * 4; const int idv = g < 16 ? id0 : id1; const float ggv = g < 16 ? gg0 : gg1;
            int e[4]; int gt[4];
#pragma unroll
            for (int k = 0; k < 4; ++k) { e[k] = __builtin_amdgcn_readlane(idv, src + k); gt[k] = __builtin_amdgcn_readlane(__float_as_int(ggv), src + k); }
            float us[4], vs[4]; float d[4];
#if XFMT == 4
            u32x4 ur[4], vr[4];
#pragma unroll
            for (int k = 0; k < 4; ++k) { ur[k] = ldg<u32x4>(U + (size_t)e[k] * XROW + lane * 16); us[k] = ldg<float>(USC + e[k]); }
#pragma unroll
            for (int k = 0; k < 4; ++k) { vr[k] = ldg<u32x4>(V + (size_t)e[k] * XROW + lane * 16); vs[k] = ldg<float>(VSC + e[k]); }
#pragma unroll
            for (int k = 0; k < 4; ++k) { f32x2 s2 = {0.f, 0.f};
#pragma unroll
                for (int dd = 0; dd < 4; ++dd) {
#define D4(b) { const f32x2 r = __builtin_amdgcn_cvt_scalef32_pk_f32_fp4(ur[k][dd], 1.0f, b); s2 = (f32x2){x[8 * dd + 2 * (b)], x[8 * dd + 2 * (b) + 1]} * r + s2; }
                    D4(0) D4(1) D4(2) D4(3)
#undef D4
                }
                d[k] = s2[0] + s2[1]; }
#else
            u32x2 ur[4][3], vr[4][3];
#pragma unroll
            for (int k = 0; k < 4; ++k) {
#pragma unroll
                for (int c = 0; c < 3; ++c) ur[k][c] = ldg<u32x2>(U + (size_t)e[k] * XROW + lane * 24 + c * 8);
                us[k] = ldg<float>(USC + e[k]); }
#pragma unroll
            for (int k = 0; k < 4; ++k) {
#pragma unroll
                for (int c = 0; c < 3; ++c) vr[k][c] = ldg<u32x2>(V + (size_t)e[k] * XROW + lane * 24 + c * 8);
                vs[k] = ldg<float>(VSC + e[k]); }
#pragma unroll
            for (int k = 0; k < 4; ++k) { const f32x32 uf = __builtin_amdgcn_cvt_scalef32_pk32_f32_fp6((u32x6){ur[k][0][0], ur[k][0][1], ur[k][1][0], ur[k][1][1], ur[k][2][0], ur[k][2][1]}, 1.0f);
                float s = 0.f;
#pragma unroll
                for (int q = 0; q < 32; ++q) s = fmaf(x[q], uf[q], s);
                d[k] = s; }
#endif
            float k0 = b5 ? d[2] : d[0], k1 = b5 ? d[3] : d[1];
            const float s0 = b5 ? d[0] : d[2], s1 = b5 ? d[1] : d[3];
            k0 += shx32(s0, b5); k1 += shx32(s1, b5);
            float kept = b4 ? k1 : k0; const float snd = b4 ? k0 : k1;
            kept += shx<16>(snd);
            kept += shx<8>(kept); kept += shx<4>(kept); kept += shx<2>(kept); kept += shx<1>(kept);
            const float ga = __int_as_float(b5 ? (b4 ? gt[3] : gt[2]) : (b4 ? gt[1] : gt[0]));
            const float usel = b5 ? (b4 ? us[3] : us[2]) : (b4 ? us[1] : us[0]);
            const float vsel = b5 ? (b4 ? vs[3] : vs[2]) : (b4 ? vs[1] : vs[0]);
            const float w = ga * gelu_exact(kept * usel * rs_t) * vsel;
            float wk[4];
#pragma unroll
            for (int k = 0; k < 4; ++k) wk[k] = __int_as_float(__builtin_amdgcn_readlane(__float_as_int(w), k * 16));
#if XFMT == 4
#pragma unroll
            for (int k = 0; k < 4; ++k)
#pragma unroll
                for (int dd = 0; dd < 4; ++dd) {
#define D4(b) { const f32x2 r = __builtin_amdgcn_cvt_scalef32_pk_f32_fp4(vr[k][dd], 1.0f, b); y[8 * dd + 2 * (b)] = fmaf(wk[k], r[0], y[8 * dd + 2 * (b)]); y[8 * dd + 2 * (b) + 1] = fmaf(wk[k], r[1], y[8 * dd + 2 * (b) + 1]); }
                    D4(0) D4(1) D4(2) D4(3)
#undef D4
                }
#else
#pragma unroll
            for (int k = 0; k < 4; ++k) { const f32x32 vf = __builtin_amdgcn_cvt_scalef32_pk32_f32_fp6((u32x6){vr[k][0][0], vr[k][0][1], vr[k][1][0], vr[k][1][1], vr[k][2][0], vr[k][2][1]}, 1.0f);
#pragma unroll
                for (int q = 0; q < 32; ++q) y[q] = fmaf(wk[k], vf[q], y[q]); }
#endif
        }
        float ss = 0.f;
#pragma unroll
        for (int i = 0; i < 32; ++i) { y[i] += x[i]; ss += y[i] * y[i]; }
        if (!nxt_bf) {
#pragma unroll
            for (int i = 0; i < 8; ++i) stg_nt<f32x4>(xout + (size_t)t * DM + i * 256 + lane * 4, (f32x4){y[i * 4 + 0], y[i * 4 + 1], y[i * 4 + 2], y[i * 4 + 3]});
        } else {
            ss = wave_sum(ss); const float rstd = rsqrtf(ss * (1.f / DM) + NORM_EPS);
            bf16_t* Hn = (bf16_t*)(F.ws + WS_H); float* LOGF = (float*)(F.ws + WS_LOGF);
#pragma unroll
            for (int i = 0; i < 8; ++i) stg<u32x2>(Hn + (size_t)t * DM + i * 256 + lane * 4, (u32x2){cvtpk(y[i * 4 + 0], y[i * 4 + 1]), cvtpk(y[i * 4 + 2], y[i * 4 + 3])});
            float am = 1e-30f;
#pragma unroll
            for (int i = 0; i < 32; ++i) am = fmaxf(am, fabsf(y[i]));
            am = wave_max(am); const float inv = 127.0f / am;
#pragma unroll
            for (int i = 0; i < 8; ++i) stg<unsigned>(F.ws + WS_H8 + (size_t)t * DM + i * 256 + lane * 4, q8x4(y[i * 4 + 0], y[i * 4 + 1], y[i * 4 + 2], y[i * 4 + 3], inv));
            if (lane == 0) stg<float>(LOGF + t * 8 + 5, rstd * am * (1.0f / 127.0f));
#pragma unroll 1
            for (int c5 = 0; c5 < 5; ++c5) { float d = 0.f;
#pragma unroll
                for (int i = 0; i < 8; ++i) { const f32x4 wv = *(const f32x4*)(wfl + c5 * 2048 + i * 256 + lane * 4);
                    d += y[i * 4 + 0] * wv[0] + y[i * 4 + 1] * wv[1] + y[i * 4 + 2] * wv[2] + y[i * 4 + 3] * wv[3]; }
                d = wave_sum(d) * rstd;
                if (lane == 0) { const float z = d + ldg<float>(nxt_bf + c5); stg<float>(LOGF + t * 8 + c5, fminf(z, 0.f) - log1pf(__expf(-fabsf(z)))); } }
        }
    }
}

#ifdef DUP_PH
constexpr int NSEQ_TOTAL = 1 + 9 * DEPTH;
#else
constexpr int NSEQ_TOTAL = 1 + 8 * DEPTH;
#endif
#ifndef ONLY_PH
#define PHSEL(k) (ph == (k))
#else
#define PHSEL(k) (ONLY_PH == (k) && ph == (k))
#endif
__global__ void __launch_bounds__(512, 2) mega_fwd(const Args args) {
    extern __shared__ __attribute__((aligned(16))) unsigned char lds[];
    cg::grid_group grid = cg::this_grid();
    LAS unsigned char* ldsl = (LAS unsigned char*)lds;
    if (threadIdx.x == 0) { LAS unsigned long long* la = (LAS unsigned long long*)(ldsl + ARG_OFF);
#pragma unroll
        for (int j = 0; j < 25; ++j) la[j] = (unsigned long long)(uintptr_t)args.in[j];
        la[25] = (unsigned long long)(uintptr_t)args.out; la[26] = (unsigned long long)(uintptr_t)args.ws;
        la[64] = 0ull;
#pragma unroll
        for (int j = 0; j < 16; ++j) la[27 + j] = (unsigned long long)__double_as_longlong(args.invrev[j]); }
    __syncthreads();
    const int ph_lo = args.ph_lo, ph_hi = args.ph_hi;
    (void)xcd_barrier_post((unsigned*)(args.ws + WS_CTL + 4096), (volatile LAS unsigned*)(ldsl + ARG_OFF + 512));
    for (int p = ph_lo; p < ph_hi; ++p) {
        asm volatile("" ::: "memory");
#define FRAME() Frame F; { int tid_ = threadIdx.x; asm volatile("" : "+v"(tid_)); int bid_ = blockIdx.x; asm volatile("" : "+s"(bid_)); \
        F.tid = tid_; F.lane = F.tid & 63; F.wave = __builtin_amdgcn_readfirstlane(F.tid >> 6); F.G = gridDim.x; F.bid = bid_; F.lds = lds; F.ws = ws; F.gw = F.bid * 8 + F.wave; F.GW = F.G * 8; }
        unsigned char* ws; { Frame F0; F0.lds = lds; ws = (unsigned char*)arg_in(F0, 26); }
        Frame FA; FA.lds = lds;
        int pp_ = p; asm volatile("" : "+s"(pp_));
#ifdef DUP_PH
        const int l = pp_ < 1 ? 0 : (pp_ - 1) / 9; int k_ = pp_ < 1 ? -1 : (pp_ - 1) - l * 9;
        bool dup2 = false; { constexpr int pos = DUP_PH < 7 ? DUP_PH - 1 : (DUP_PH == 8 ? 6 : 7); dup2 = (k_ == pos + 1); if (k_ > pos) --k_; }
#else
        const int l = pp_ < 1 ? 0 : (pp_ - 1) / 8; const int k_ = pp_ < 1 ? -1 : (pp_ - 1) - l * 8;
#endif
        const int ph = pp_ == 0 ? 0 : (k_ < 6 ? k_ + 1 : (k_ == 6 ? 8 : 10));
        const unsigned char* wl = ws + WS_W0 + (size_t)l * WL_SIZE;
        float* xout = (float*)arg_in(FA, 25);
        if (PHSEL(0)) {
            FRAME();
            phase_convert(F);
            __syncthreads();
            { FRAME(); phase_norm(F, arg_in(FA, I_X), arg_in(FA, I_BFORGET), arg_in(FA, I_WIN), arg_in(FA, I_NORM1)); }
        } else if (PHSEL(1)) {
            FRAME();
            SchedPlain S; S.ord.init(T_TOK, 12288, F.G, F.bid); S.A = (const char*)(ws + WS_H8); S.Bt = (const char*)(wl + WO_WIN8); S.arow = (size_t)256 * 2048; S.brow = (size_t)256 * 2048;
            for (int i_ = F.bid * 512 + F.tid; i_ < 10 * 16 * 128; i_ += F.G * 512) stg<int>((int*)(ws + WS_KSUM) + i_, 0);
            EpiProj E{(bf16_t*)(ws + WS_PROJ), (bf16_t*)(ws + WS_GATES), arg_in(FA, I_BGATE) + (size_t)l * 3 * DM, ws, (const float*)(ws + WS_LOGF) + 5, (const float*)(wl + WO_WSC)};
#if defined(DUP_PH) && defined(DUP_DRY)
            E.dry = dup2;
#endif
#ifdef STAGGER
            { const int d_ = (F.bid >> 3) & 3; for (int i_ = 0; i_ < d_ * STAGGER; ++i_) __builtin_amdgcn_s_sleep(127); }
#endif
            pg8::gemm_phase<EpiProj, SchedPlain, 2>(ldsl, 2048, 2048, 2048, S, E);
        } else if (PHSEL(2)) {
            FRAME();
            phase_prep(F, l);
        } else if (PHSEL(3)) {
            FRAME();
            phase_attention(F, pp_, arg_in(FA, I_CQN) + l * 128, arg_in(FA, I_CKN) + l * 128);
        } else if (PHSEL(4)) {
            FRAME();
            phase_postA(F, l);
        } else if (PHSEL(5)) {
            FRAME();
            SchedMerge S; S.ord.init(T_TOK, 2048, F.G, F.bid); S.Y = (const char*)(ws + WS_YCAT); S.W = (const char*)(wl + WO_WBR_T);
            EpiMerge E{(bf16_t*)(ws + WS_MERGED), (const bf16_t*)(ws + WS_GATES)};
            pg8::gemm_phase<EpiMerge, SchedMerge>(ldsl, 2048, 768, 768, S, E);
        } else if (PHSEL(6)) {
            FRAME();
            SchedPlain S; S.ord.init(T_TOK, 2048, F.G, F.bid); S.A = (const char*)(ws + WS_MERGED); S.Bt = (const char*)(wl + WO_WOUT_T); S.arow = (size_t)256 * 2048; S.brow = (size_t)256 * 2048;
            EpiRes3 E{(bf16_t*)(ws + WS_HG), arg_in(FA, I_X), l == 0 ? nullptr : (const bf16_t*)(ws + WS_H), (unsigned long long*)(ws + WS_ROWSS), ws + WS_HG8};
            if (l == 0) { E.res8 = ws + WS_H8; E.rsc8 = (const float*)(ws + WS_LOGF) + 6; }
            pg8::gemm_phase<EpiRes3, SchedPlain, 1>(ldsl, 2048, 2048, 2048, S, E);
        } else if (PHSEL(8)) {
            FRAME();
            SchedPlain S; S.ord.init(T_TOK, 2048, F.G, F.bid); S.A = (const char*)(ws + WS_HG8); S.Bt = (const char*)(wl + WO_WQ_T); S.arow = (size_t)256 * 2048; S.brow = (size_t)256 * 2048;
            EpiBf16S E{(bf16_t*)(ws + WS_QP), 2048, (const unsigned long long*)(ws + WS_ROWSS)};
            pg8::gemm_phase<EpiBf16S, SchedPlain, 1>(ldsl, 2048, 2048, 2048, S, E);
            asm volatile("" ::: "memory");
            { FRAME(); phase_topk(F, wl); }
        } else if (PHSEL(10)) {
            FRAME();
            const bool more = l + 1 < DEPTH;
            phase_gather(F, nullptr, xout, wl, nullptr, more ? arg_in(FA, I_BFORGET) + (l + 1) * 5 : nullptr, more ? (const float*)(wl + WL_SIZE + WO_WF) : nullptr);
        }
        if (p + 1 < ph_hi) { if (p == ph_lo) grid.sync();
            else { XcdBarrier xb; xb.bar = (unsigned*)(ws + WS_CTL + 4096); xb.x = xb_xcc_id(); int so = ARG_OFF + 512; asm volatile("" : "+v"(so)); xb.st = (volatile LAS unsigned*)(ldsl + so); xcd_barrier(xb); } }
    }
}

#ifndef MK_PER_PHASE
#define MK_PER_PHASE 0
#endif
extern "C" void kernel_launch(void* const* d_in, const int* in_sizes, int n_in, void* d_out, int out_size, void* d_ws, size_t ws_size, hipStream_t stream) {
    static int grid = 0;
    if (grid == 0) {
        if (n_in != 25 || in_sizes[0] != T_TOK * DM || out_size != T_TOK * DM || ws_size < WS_END) {
            fprintf(stderr, "kernel_launch: unexpected shapes: n_in %d in0 %d out %d ws %zu (need %zu)\n", n_in, n_in > 0 ? in_sizes[0] : -1, out_size, ws_size, (size_t)WS_END); grid = -1; return; }
        int dev = 0, cus = 0, per_cu = 0;
        if (hipGetDevice(&dev) != hipSuccess || hipDeviceGetAttribute(&cus, hipDeviceAttributeMultiprocessorCount, dev) != hipSuccess) { grid = -1; return; }
        if (hipFuncSetAttribute((const void*)mega_fwd, hipFuncAttributeMaxDynamicSharedMemorySize, LDS_BYTES) != hipSuccess) { fprintf(stderr, "kernel_launch: hipFuncSetAttribute failed\n"); grid = -1; return; }
        if (hipOccupancyMaxActiveBlocksPerMultiprocessor(&per_cu, (const void*)mega_fwd, 512, LDS_BYTES) != hipSuccess || per_cu < 1) { fprintf(stderr, "kernel_launch: occupancy query says %d blocks per CU\n", per_cu); grid = -1; return; }
        (void)hipGetLastError();
        grid = cus;
    }
    if (grid < 0) return;
    (void)hipMemsetAsync((char*)d_ws + WS_CTL, 0, 32768, stream);
    Args a{};
    for (int i = 0; i < 25; ++i) a.in[i] = (const float*)d_in[i];
    a.out = (float*)d_out; a.ws = (unsigned char*)d_ws;
    for (int j = 0; j < 16; ++j) a.invrev[j] = pow(500000.0, -(double)j / 16.0) / 6.283185307179586476925286766559;
    const int total = NSEQ_TOTAL;
#if MK_PER_PHASE
    for (int p = 0; p < total; ++p) { a.ph_lo = p; a.ph_hi = p + 1; void* kargs[] = {&a};
        hipError_t e = hipLaunchCooperativeKernel((const void*)mega_fwd, dim3(grid), dim3(512), kargs, LDS_BYTES, stream);
        if (e != hipSuccess) { fprintf(stderr, "kernel_launch: launch %d failed: %s\n", p, hipGetErrorString(e)); break; } }
#else
    a.ph_lo = 0; a.ph_hi = total; void* kargs[] = {&a};
    hipError_t e = hipLaunchCooperativeKernel((const void*)mega_fwd, dim3(grid), dim3(512), kargs, LDS_BYTES, stream);
    if (e != hipSuccess) fprintf(stderr, "kernel_launch: cooperative launch failed: %s (grid %d)\n", hipGetErrorString(e), grid);
#endif
}
```
